# Optimizing an MI355X kernel written in HIP

```python
import jax, jax.numpy as jnp
from jax import lax
import numpy as np

D_MODEL = 2048
BATCH = 1
SEQ = 16384
DEPTH = 4
DEC_BATCH = 8
DEC_SEQ = 32
PAST_LEN = 1024

CHUNK = 64
Q_BLOCK = 128
K_BLOCK = 128
SPAN = 1024
HEAD_DIM = 128
N_HEADS_A = 4
N_HEADS_B = 4
N_HEADS_C = 4
W_A = N_HEADS_A * HEAD_DIM
W_B = N_HEADS_B * HEAD_DIM
MLA_Q_RANK = 512
MLA_KV_RANK = 256
MLA_NOPE_DIM = 128
MLA_ROPE_DIM = 64
MLA_V_DIM = 128
MLA_QK_DIM = MLA_NOPE_DIM + MLA_ROPE_DIM
W_C = N_HEADS_C * MLA_V_DIM
MIX_WIDTH = W_A + W_B + W_C
ROPE_THETA = 10000.0
D_FF = ((8 * D_MODEL // 3 + 255) // 256) * 256
RMS_EPS = 1e-6
NEG_INF = -1e30
SPLIT_SIZES = (W_A, W_A, W_A, N_HEADS_A, W_B, W_B, W_B, MLA_Q_RANK, MLA_KV_RANK, MLA_ROPE_DIM)
N_IN = W_A * 3 + N_HEADS_A + W_B * 3 + MLA_Q_RANK + MLA_KV_RANK + MLA_ROPE_DIM

kernel_name = 'hymba_fox_stickbreak_mla_stream_step'


def rmsnorm(x, g):
    x32 = x.astype(jnp.float32)
    y = x32 * lax.rsqrt(jnp.mean(x32 * x32, axis=-1, keepdims=True) + RMS_EPS)
    return (y * g.astype(jnp.float32)).astype(x.dtype)


def split_columns(proj):
    parts, start = [], 0
    for size in SPLIT_SIZES:
        parts.append(proj[..., start:start + size])
        start += size
    return parts


def rope(r, pos):
    half = MLA_ROPE_DIM // 2
    inv_freq = ROPE_THETA ** (-(jnp.arange(half, dtype=jnp.float32) / half))
    ang = pos.astype(jnp.float32)[:, None] * inv_freq[None, :]
    cos = jnp.cos(ang)[:, None, :]
    sin = jnp.sin(ang)[:, None, :]
    r32 = r.astype(jnp.float32)
    r1, r2 = r32[..., :half], r32[..., half:]
    return jnp.concatenate([r1 * cos - r2 * sin, r2 * cos + r1 * sin], axis=-1).astype(r.dtype)


def rope_tail(x, pos):
    return jnp.concatenate([x[..., :MLA_NOPE_DIM], rope(x[..., MLA_NOPE_DIM:], pos)], axis=-1)


def masked_softmax_attend(s, mask, v):
    logits = jnp.where(mask, s, NEG_INF)
    e = jnp.exp(logits - jnp.max(logits, axis=-1, keepdims=True))
    denom = jnp.sum(e, axis=-1)
    out = jnp.einsum('bhqk,bkhd->bqhd', e.astype(v.dtype), v, preferred_element_type=jnp.float32)
    return (out / jnp.transpose(denom, (0, 2, 1))[..., None]).astype(v.dtype)


def fox_attend(q, fq, k, v, fk, qpos, kpos):
    s = jnp.einsum('bqhd,bkhd->bhqk', q, k, preferred_element_type=jnp.float32)
    decay = jnp.transpose(fq, (0, 2, 1))[..., :, None] - jnp.transpose(fk, (0, 2, 1))[..., None, :]
    mask = kpos[None, :] <= qpos[:, None]
    return masked_softmax_attend(s + decay, mask, v)


def rev_cumsum_keys(x):
    L = x.shape[-1]
    nk = -(-L // K_BLOCK)
    xp = jnp.pad(x, [(0, 0)] * (x.ndim - 1) + [(0, nk * K_BLOCK - L)])
    xb = xp.reshape(*x.shape[:-1], nk, K_BLOCK)
    idx = jnp.arange(K_BLOCK)
    tri = (idx[:, None] >= idx[None, :]).astype(x.dtype)
    intra = jnp.einsum('bhqnj,js->bhqns', xb, tri, precision=lax.Precision.HIGHEST)
    bidx = jnp.arange(nk)
    tri_b = (bidx[:, None] > bidx[None, :]).astype(x.dtype)
    later = jnp.einsum('bhqm,mn->bhqn', jnp.sum(xb, axis=-1), tri_b, precision=lax.Precision.HIGHEST)
    r = (intra + later[..., None]).reshape(*x.shape[:-1], nk * K_BLOCK)
    return r[..., :L]


def sb_attend(q, k, v, qpos, kpos):
    z = jnp.einsum('bqhd,bkhd->bhqk', q, k, preferred_element_type=jnp.float32)
    mask = kpos[None, :] < qpos[:, None]
    log_keep = -(jnp.maximum(z, 0.0) + jnp.log1p(jnp.exp(-jnp.abs(z))))
    r = rev_cumsum_keys(jnp.where(mask, log_keep, 0.0))
    a = jnp.where(mask, jnp.exp(z + r), 0.0)
    return jnp.einsum('bhqk,bkhd->bqhd', a.astype(v.dtype), v)


def mla_attend(q, k, v, qpos, kpos):
    s = jnp.einsum('bqhd,bkhd->bhqk', q, k, preferred_element_type=jnp.float32)
    mask = (kpos[None, :] // CHUNK) <= (qpos[:, None] // CHUNK)
    return masked_softmax_attend(s, mask, v)


def query_sweep(attend, q_args, kv_args, qpos, kpos, P):
    T = qpos.shape[0]
    if T < Q_BLOCK or T % Q_BLOCK != 0:
        return attend(*q_args, *kv_args, qpos, kpos)
    outs = []
    for a in range(0, T, SPAN):
        b = min(a + SPAN, T)
        n_keys = P + b
        kv_prefix = tuple(arr[:, :n_keys] for arr in kv_args)
        kp = kpos[:n_keys]
        nb = (b - a) // Q_BLOCK

        def to_blocks(arr):
            arr = arr[:, a:b]
            return jnp.moveaxis(arr.reshape(arr.shape[0], nb, Q_BLOCK, *arr.shape[2:]), 1, 0)

        blocks = tuple(to_blocks(arr) for arr in q_args) + (qpos[a:b].reshape(nb, Q_BLOCK),)
        out = lax.map(lambda args, kvp=kv_prefix, kpp=kp: attend(*args[:-1], *kvp, args[-1], kpp), blocks)
        out = jnp.moveaxis(out, 0, 1)
        outs.append(out.reshape(out.shape[0], b - a, *out.shape[3:]))
    return jnp.concatenate(outs, axis=1)


def trunk_layer(x, past, p):
    B, T, _ = x.shape
    P = 0 if past is None else past[0].shape[1]
    qpos = P + jnp.arange(T, dtype=jnp.int32)
    kpos = jnp.arange(P + T, dtype=jnp.int32)
    Tk = P + T

    h = rmsnorm(x, p['norm_mix'])
    proj = jnp.einsum('btd,dn->btn', h, p['w_in'])
    qa, ka, va, fa, qb, kb, vb, cq, ckv, krope = split_columns(proj)

    qa = rmsnorm(qa.reshape(B, T, N_HEADS_A, HEAD_DIM), p['fox_q_norm']) * (HEAD_DIM ** -0.5)
    ka = rmsnorm(ka.reshape(B, T, N_HEADS_A, HEAD_DIM), p['fox_k_norm'])
    va = va.reshape(B, T, N_HEADS_A, HEAD_DIM)
    logf = jax.nn.log_sigmoid(fa.astype(jnp.float32) + p['fox_f_bias'].astype(jnp.float32))
    qb = qb.reshape(B, T, N_HEADS_B, HEAD_DIM) * (HEAD_DIM ** -0.5)
    kb = kb.reshape(B, T, N_HEADS_B, HEAD_DIM)
    vb = vb.reshape(B, T, N_HEADS_B, HEAD_DIM)
    cq = rmsnorm(cq, p['mla_qa_norm'])
    q_c = jnp.einsum('btr,rn->btn', cq, p['mla_w_uq']).reshape(B, T, N_HEADS_C, MLA_QK_DIM)
    q_c = rope_tail(rmsnorm(q_c, p['mla_q_norm']), qpos) * (MLA_QK_DIM ** -0.5)
    ckv = rmsnorm(ckv, p['mla_kva_norm'])

    new_rows = (ka, va, logf, kb, vb, ckv, krope)
    if past is None:
        ka_all, va_all, logf_all, kb_all, vb_all, ckv_all, krope_all = new_rows
    else:
        ka_all, va_all, logf_all, kb_all, vb_all, ckv_all, krope_all = (
            jnp.concatenate([old.astype(new.dtype), new], axis=1) for old, new in zip(past, new_rows))

    f_all = jnp.cumsum(logf_all.astype(jnp.float32), axis=1)
    f_q = f_all[:, P:]

    kv_c = jnp.einsum('bkr,rn->bkn', ckv_all, p['mla_w_ukv']).reshape(B, Tk, N_HEADS_C, MLA_NOPE_DIM + MLA_V_DIM)
    k_nope, v_c = kv_c[..., :MLA_NOPE_DIM], kv_c[..., MLA_NOPE_DIM:]
    k_rope = jnp.broadcast_to(krope_all[:, :, None, :].astype(k_nope.dtype), (B, Tk, N_HEADS_C, MLA_ROPE_DIM))
    k_c = rope_tail(rmsnorm(jnp.concatenate([k_nope, k_rope], axis=-1), p['mla_k_norm']), kpos)

    out_a = query_sweep(fox_attend, (qa, f_q), (ka_all, va_all, f_all), qpos, kpos, P)
    out_b = query_sweep(sb_attend, (qb,), (kb_all, vb_all), qpos, kpos, P)
    out_c = query_sweep(mla_attend, (q_c,), (k_c, v_c), qpos, kpos, P)

    mix = jnp.concatenate([
        rmsnorm(out_a.reshape(B, T, W_A), p['out_norm_a']),
        rmsnorm(out_b.reshape(B, T, W_B), p['out_norm_b']),
        rmsnorm(out_c.reshape(B, T, W_C), p['out_norm_c'])], axis=-1)
    x = x + jnp.einsum('btm,md->btd', mix, p['w_out'])

    h2 = rmsnorm(x, p['norm_ffn'])
    gu = jnp.einsum('btd,df->btf', h2, p['w_gu'])
    act = jax.nn.silu(gu[..., :D_FF]) * gu[..., D_FF:]
    x = x + jnp.einsum('btf,fd->btd', act, p['w_down'])
    return x, new_rows


def setup_inputs(seed: int = 0) -> dict:
    key = jax.random.key(seed)
    ks = iter(jax.random.split(key, 32))

    def normal(shape, scale):
        return jax.random.normal(next(ks), shape, jnp.float32) * scale

    def gain(shape):
        return 1.0 + normal(shape, 0.02)

    L = DEPTH
    return {
        'x_prompt': normal((BATCH, SEQ, D_MODEL), 1.0),
        'x_sample': normal((DEC_BATCH, DEC_SEQ, D_MODEL), 1.0),
        'cache_fox_k': normal((L, DEC_BATCH, PAST_LEN, N_HEADS_A, HEAD_DIM), 1.0),
        'cache_fox_v': normal((L, DEC_BATCH, PAST_LEN, N_HEADS_A, HEAD_DIM), 1.0),
        'cache_fox_logf': jax.nn.log_sigmoid(3.0 + normal((L, DEC_BATCH, PAST_LEN, N_HEADS_A), 1.0)),
        'cache_sb_k': normal((L, DEC_BATCH, PAST_LEN, N_HEADS_B, HEAD_DIM), 1.0),
        'cache_sb_v': normal((L, DEC_BATCH, PAST_LEN, N_HEADS_B, HEAD_DIM), 1.0),
        'cache_mla_ckv': normal((L, DEC_BATCH, PAST_LEN, MLA_KV_RANK), 1.0),
        'cache_mla_krope': normal((L, DEC_BATCH, PAST_LEN, MLA_ROPE_DIM), 1.0),
        'norm_mix': gain((L, D_MODEL)),
        'w_in': normal((L, D_MODEL, N_IN), D_MODEL ** -0.5),
        'fox_f_bias': 3.0 + normal((L, N_HEADS_A), 0.1),
        'fox_q_norm': gain((L, HEAD_DIM)),
        'fox_k_norm': gain((L, HEAD_DIM)),
        'mla_qa_norm': gain((L, MLA_Q_RANK)),
        'mla_w_uq': normal((L, MLA_Q_RANK, N_HEADS_C * MLA_QK_DIM), MLA_Q_RANK ** -0.5),
        'mla_kva_norm': gain((L, MLA_KV_RANK)),
        'mla_w_ukv': normal((L, MLA_KV_RANK, N_HEADS_C * (MLA_NOPE_DIM + MLA_V_DIM)), MLA_KV_RANK ** -0.5),
        'mla_q_norm': gain((L, MLA_QK_DIM)),
        'mla_k_norm': gain((L, MLA_QK_DIM)),
        'out_norm_a': gain((L, W_A)),
        'out_norm_b': gain((L, W_B)),
        'out_norm_c': gain((L, W_C)),
        'w_out': normal((L, MIX_WIDTH, D_MODEL), MIX_WIDTH ** -0.5),
        'norm_ffn': gain((L, D_MODEL)),
        'w_gu': normal((L, D_MODEL, 2 * D_FF), D_MODEL ** -0.5),
        'w_down': normal((L, D_FF, D_MODEL), D_FF ** -0.5),
    }


def reference(x_prompt, x_sample, cache_fox_k, cache_fox_v, cache_fox_logf, cache_sb_k, cache_sb_v,
              cache_mla_ckv, cache_mla_krope, norm_mix, w_in, fox_f_bias, fox_q_norm, fox_k_norm,
              mla_qa_norm, mla_w_uq, mla_kva_norm, mla_w_ukv, mla_q_norm, mla_k_norm,
              out_norm_a, out_norm_b, out_norm_c, w_out, norm_ffn, w_gu, w_down):
    y_p, y_s = x_prompt, x_sample
    rows_p, rows_s = [], []
    for l in range(DEPTH):
        p = {
            'norm_mix': norm_mix[l], 'w_in': w_in[l], 'fox_f_bias': fox_f_bias[l],
            'fox_q_norm': fox_q_norm[l], 'fox_k_norm': fox_k_norm[l],
            'mla_qa_norm': mla_qa_norm[l], 'mla_w_uq': mla_w_uq[l], 'mla_kva_norm': mla_kva_norm[l],
            'mla_w_ukv': mla_w_ukv[l], 'mla_q_norm': mla_q_norm[l], 'mla_k_norm': mla_k_norm[l],
            'out_norm_a': out_norm_a[l], 'out_norm_b': out_norm_b[l], 'out_norm_c': out_norm_c[l],
            'w_out': w_out[l], 'norm_ffn': norm_ffn[l], 'w_gu': w_gu[l], 'w_down': w_down[l],
        }
        y_p, r_p = trunk_layer(y_p, None, p)
        past = (cache_fox_k[l], cache_fox_v[l], cache_fox_logf[l], cache_sb_k[l], cache_sb_v[l],
                cache_mla_ckv[l], cache_mla_krope[l])
        y_s, r_s = trunk_layer(y_s, past, p)
        rows_p.append(r_p)
        rows_s.append(r_s)
    fox_k_p, fox_v_p, fox_logf_p, sb_k_p, sb_v_p, mla_ckv_p, mla_krope_p = (
        jnp.stack([r[i] for r in rows_p], axis=0) for i in range(7))
    fox_k_s, fox_v_s, fox_logf_s, sb_k_s, sb_v_s, mla_ckv_s, mla_krope_s = (
        jnp.stack([r[i] for r in rows_s], axis=0) for i in range(7))
    return (y_p, y_s, fox_k_p, fox_v_p, fox_logf_p, sb_k_p, sb_v_p, mla_ckv_p, mla_krope_p,
            fox_k_s, fox_v_s, fox_logf_s, sb_k_s, sb_v_s, mla_ckv_s, mla_krope_s)
```

```cpp
#include <hip/hip_runtime.h>
#include <cstdio>
#include <cstdint>
#ifndef MK_ONE_LAUNCH
#define MK_ONE_LAUNCH 1
#endif
namespace pg8 {
#define PG8_LAS __attribute__((address_space(3)))
typedef unsigned short bf16_t;
typedef short bf16x8 __attribute__((ext_vector_type(8)));
typedef float f32x4 __attribute__((ext_vector_type(4)));
typedef unsigned u32x4 __attribute__((ext_vector_type(4)));
constexpr int BM = 256, BK = 64, HALF = 128, HTB = HALF * BK * 2  , STAGE_BYTES = 8 * HTB, NXCD = 8, WGM = 8;

__host__ __device__ __forceinline__ int lds_byte(int r, int c) { const int st = (r >> 4) * 2 + (c >> 5), rr = r & 15, cc = c & 31, ob = rr * 64 + cc * 2; return st * 1024 + (ob ^ (((ob >> 9) & 1) << 5)); }
__host__ __device__ __forceinline__ void stage_rc(int b, int& R, int& C) { const int st = b / 1024, sb = b % 1024, swz = sb ^ (((sb >> 9) & 1) << 5); R = (st >> 1) * 16 + swz / 64; C = (st & 1) * 32 + (swz % 64) / 2; }
__host__ __device__ __forceinline__ int perm32(int rho) { const int n = rho >> 4, i = rho & 15; return 8 * (i >> 2) + 4 * n + (i & 3); }

struct Unit { int pm, pn; };
struct Gemm { const bf16_t* A; const bf16_t* Bt; int M, N, K; };

struct StaticOrder {
    int nM, nN, nwg, G, c;
    __host__ __device__ void init(int M, int N, int G_, int c_) { nM = M / BM; nN = N / BM; nwg = nM * nN; G = G_; c = c_; }
    __host__ __device__ bool next(int i, Unit& u) const {
        const long L = (long)i * G + c; if (L >= nwg) return false;
        int wgid = (int)L; { const int q = nwg / NXCD, r = nwg % NXCD, xcd = wgid % NXCD, off = wgid / NXCD; wgid = (xcd < r ? xcd * (q + 1) : r * (q + 1) + (xcd - r) * q) + off; }
        const int nig = WGM * nN, gid = wgid / nig, fm = gid * WGM, gsz = (nM - fm) < WGM ? (nM - fm) : WGM;
        u.pm = fm + ((wgid % nig) % gsz); u.pn = (wgid % nig) / gsz; return true;
    }
    __device__ __forceinline__ void a_ready(const Unit&) const {}
    __device__ __forceinline__ void done(const Unit&) const {}
};

__device__ __forceinline__ unsigned cvt_pk_bf16(float lo, float hi) { unsigned r; asm volatile("v_cvt_pk_bf16_f32 %0, %1, %2" : "=v"(r) : "v"(lo), "v"(hi)); return r; }
typedef float f32x2 __attribute__((ext_vector_type(2)));

constexpr float RMS_EPS = 1e-6f;
__device__ __forceinline__ float row_rstd(const float* rowss, int row, int fq, float inv_n) {
    const f32x4 a = *(const f32x4*)(rowss + (size_t)row * 32 + fq * 8), b = *(const f32x4*)(rowss + (size_t)row * 32 + fq * 8 + 4);
    float s = ((a[0] + a[1]) + (a[2] + a[3])) + ((b[0] + b[1]) + (b[2] + b[3]));
    s += __shfl_xor(s, 16); s += __shfl_xor(s, 32);
    return 1.0f / sqrtf(s * inv_n + RMS_EPS);
}
struct EpiPlain {
    static constexpr bool PERM = true, AFTER_DRAIN = false;
    bf16_t* O; int ldc;
    __device__ __forceinline__ void operator()(const f32x4 (&acc)[2][2][4][2], const Unit& u, int wr, int wc, int fr, int fq) const {
        const int row0 = u.pm * BM + wr * 64 + fr, col0 = u.pn * BM + wc * 32 + 8 * fq;
#pragma unroll
        for (int ai = 0; ai < 2; ++ai)
#pragma unroll
            for (int m = 0; m < 4; ++m) { bf16_t* rowp = O + (size_t)(row0 + ai * HALF + m * 16) * ldc + col0;
#pragma unroll
                for (int bj = 0; bj < 2; ++bj) { const f32x4 v0 = acc[ai][bj][m][0], v1 = acc[ai][bj][m][1];
                    u32x4 w; w.x = cvt_pk_bf16(v0[0], v0[1]); w.y = cvt_pk_bf16(v0[2], v0[3]); w.z = cvt_pk_bf16(v1[0], v1[1]); w.w = cvt_pk_bf16(v1[2], v1[3]);
                    *(u32x4*)(rowp + bj * HALF) = w; } }
    }
};
struct EpiScaled {
    static constexpr bool PERM = true, AFTER_DRAIN = false;
    bf16_t* O; int ldc; const float* rowss; float inv_n;
    __device__ __forceinline__ void operator()(const f32x4 (&acc)[2][2][4][2], const Unit& u, int wr, int wc, int fr, int fq) const {
        const int row0 = u.pm * BM + wr * 64 + fr, col0 = u.pn * BM + wc * 32 + 8 * fq;
#pragma unroll
        for (int ai = 0; ai < 2; ++ai)
#pragma unroll
            for (int m = 0; m < 4; ++m) { const int row = row0 + ai * HALF + m * 16; const float rs = row_rstd(rowss, row, fq, inv_n);
                bf16_t* rowp = O + (size_t)row * ldc + col0;
#pragma unroll
                for (int bj = 0; bj < 2; ++bj) { const f32x4 v0 = acc[ai][bj][m][0] * rs, v1 = acc[ai][bj][m][1] * rs;
                    u32x4 w; w.x = cvt_pk_bf16(v0[0], v0[1]); w.y = cvt_pk_bf16(v0[2], v0[3]); w.z = cvt_pk_bf16(v1[0], v1[1]); w.w = cvt_pk_bf16(v1[2], v1[3]);
                    *(u32x4*)(rowp + bj * HALF) = w; } }
    }
};
__device__ __forceinline__ float silu_mul(float g, float u) { return g * u * __builtin_amdgcn_rcpf(1.0f + __builtin_amdgcn_exp2f(-1.4426950408889634f * g)); }
struct EpiSwiGlu {
    static constexpr bool PERM = true, AFTER_DRAIN = false;
    bf16_t* O; int ldc; const float* rowss; float inv_n;
    __device__ __forceinline__ void operator()(const f32x4 (&acc)[2][2][4][2], const Unit& u, int wr, int wc, int fr, int fq) const {
        const int row0 = u.pm * BM + wr * 64 + fr, col0 = u.pn * HALF + wc * 32 + 8 * fq;
#pragma unroll
        for (int ai = 0; ai < 2; ++ai)
#pragma unroll
            for (int m = 0; m < 4; ++m) { const int row = row0 + ai * HALF + m * 16; const float rs = row_rstd(rowss, row, fq, inv_n);
                const f32x4 g0 = acc[ai][0][m][0] * rs, g1 = acc[ai][0][m][1] * rs, u0 = acc[ai][1][m][0] * rs, u1 = acc[ai][1][m][1] * rs;
                u32x4 w; w.x = cvt_pk_bf16(silu_mul(g0[0], u0[0]), silu_mul(g0[1], u0[1])); w.y = cvt_pk_bf16(silu_mul(g0[2], u0[2]), silu_mul(g0[3], u0[3]));
                w.z = cvt_pk_bf16(silu_mul(g1[0], u1[0]), silu_mul(g1[1], u1[1])); w.w = cvt_pk_bf16(silu_mul(g1[2], u1[2]), silu_mul(g1[3], u1[3]));
                *(u32x4*)(O + (size_t)row * ldc + col0) = w; }
    }
};
struct EpiResid {
    static constexpr bool PERM = false, AFTER_DRAIN = false;
    const float* xin_p; const float* xin_s; int nsplit;
    float* xout; bf16_t* xn; const float* gain; float* rowss; int ldc;
    __device__ __forceinline__ void operator()(const f32x4 (&acc)[2][2][4][2], const Unit& u, int wr, int wc, int fr, int fq) const {
        typedef unsigned u32x2v __attribute__((ext_vector_type(2)));
        const int col0 = u.pn * BM + wc * 32 + 4 * fq;
        f32x4 gv[2][2];
#pragma unroll
        for (int bj = 0; bj < 2; ++bj)
#pragma unroll
            for (int n = 0; n < 2; ++n) gv[bj][n] = *(const f32x4*)(gain + col0 + bj * HALF + n * 16);
#pragma unroll
        for (int ai = 0; ai < 2; ++ai)
#pragma unroll
            for (int m = 0; m < 4; ++m) { const int row = u.pm * BM + ai * HALF + wr * 64 + m * 16 + fr;
                const float* xi = (row < nsplit ? xin_p + (size_t)row * ldc : xin_s + (size_t)(row - nsplit) * ldc) + col0;
                const size_t off = (size_t)row * ldc + col0; float ss = 0.f;
#pragma unroll
                for (int bj = 0; bj < 2; ++bj)
#pragma unroll
                    for (int n = 0; n < 2; ++n) { const f32x4 x1 = *(const f32x4*)(xi + bj * HALF + n * 16) + acc[ai][bj][m][n];
                        *(f32x4*)(xout + off + bj * HALF + n * 16) = x1;
                        ss += (x1[0] * x1[0] + x1[1] * x1[1]) + (x1[2] * x1[2] + x1[3] * x1[3]);
                        const f32x4 y = x1 * gv[bj][n]; u32x2v w; w.x = cvt_pk_bf16(y[0], y[1]); w.y = cvt_pk_bf16(y[2], y[3]);
                        *(u32x2v*)(xn + off + bj * HALF + n * 16) = w; }
                ss += __shfl_xor(ss, 16); ss += __shfl_xor(ss, 32);
                if (fq == 0) rowss[(size_t)row * 32 + u.pn * 4 + wc] = ss; }
    }
};
template <class Epi, class Sched, bool ALIGN_EPI = false, bool SP2 = false>
__device__ __forceinline__ void gemm_phase(PG8_LAS unsigned char* lds, const Gemm g, const Sched& S, const Epi& E) {
    int tid_ = threadIdx.x; asm volatile("" : "+v"(tid_));
    const int tid = tid_, wid = __builtin_amdgcn_readfirstlane(tid >> 6), lane = tid & 63, wr = wid >> 2, wc = wid & 3, fr = lane & 15, fq = lane >> 4;
    const int K = g.K, nt = K / BK;
    unsigned voffA[2], voffB[2];
#pragma unroll
    for (int i = 0; i < 2; ++i) { int R, C; stage_rc(tid * 16 + i * 8192, R, C); const int Rb = Epi::PERM ? ((R & ~31) + perm32(R & 31)) : R;
        voffA[i] = (unsigned)(R * K + C) * 2u; voffB[i] = (unsigned)(Rb * K + C) * 2u; }
    const size_t kstep = (size_t)(BK * 2);
    const size_t hstep = (size_t)HALF * K * 2;
    const size_t tstep = 2 * hstep;
    const unsigned ldsw = (unsigned)wid * 1024u;
    const int aoff = lds_byte(wr * 64 + fr, fq * 8), boff = lds_byte(wc * 32 + fr, fq * 8);
#define PG8_SA(b, h) (((b) * 2 + (h)) * HTB)
#define PG8_SB(b, h) ((4 + (b) * 2 + (h)) * HTB)
#define PG8_STAGE(bufoff, gbase, voff) do { _Pragma("unroll") for (int _i = 0; _i < 2; ++_i) \
        __builtin_amdgcn_global_load_lds((const unsigned*)((const char*)(gbase) + (voff)[_i]), (PG8_LAS unsigned*)(lds + (bufoff) + ldsw + _i * 8192), 16, 0, 0); } while (0)
#define PG8_LDA(dst, b, h) do { _Pragma("unroll") for (int m = 0; m < 4; ++m) _Pragma("unroll") for (int k = 0; k < 2; ++k) dst[m][k] = *(const PG8_LAS bf16x8*)(lds + PG8_SA(b, h) + aoff + m * 2048 + k * 1024); } while (0)
#define PG8_LDB(dst, b, h) do { _Pragma("unroll") for (int n = 0; n < 2; ++n) _Pragma("unroll") for (int k = 0; k < 2; ++k) dst[n][k] = *(const PG8_LAS bf16x8*)(lds + PG8_SB(b, h) + boff + n * 2048 + k * 1024); } while (0)
#define PG8_MMA(ai, bj, At, Bt) do { __builtin_amdgcn_s_setprio(1); _Pragma("unroll") for (int m = 0; m < 4; ++m) _Pragma("unroll") for (int n = 0; n < 2; ++n) _Pragma("unroll") for (int k = 0; k < 2; ++k) \
        acc[ai][bj][m][n] = __builtin_amdgcn_mfma_f32_16x16x32_bf16(Bt[n][k], At[m][k], acc[ai][bj][m][n], 0, 0, 0); __builtin_amdgcn_s_setprio(0); } while (0)
#define PG8_WAIT_V(n) asm volatile("s_waitcnt vmcnt(" #n ")" ::: "memory")
#define PG8_WAIT_L(n) asm volatile("s_waitcnt lgkmcnt(" #n ")" ::: "memory")
#define PG8_BAR __builtin_amdgcn_s_barrier()
#define PG8_SCHED __builtin_amdgcn_sched_barrier(0)
    Unit cur, nxt; int ui = 0;
    if (!S.next(0, cur)) return;
    f32x4 acc[2][2][4][2];
#pragma unroll
    for (int a = 0; a < 2; ++a)
#pragma unroll
        for (int b = 0; b < 2; ++b)
#pragma unroll
            for (int m = 0; m < 4; ++m)
#pragma unroll
                for (int n = 0; n < 2; ++n) acc[a][b][m][n] = (f32x4){0.f, 0.f, 0.f, 0.f};
    bf16x8 At[4][2], B0[2][2], B1[2][2];
    const char* cA = (const char*)g.A + (size_t)cur.pm * tstep; const char* cB = (const char*)g.Bt + (size_t)cur.pn * tstep;
    S.a_ready(cur);
    if constexpr (SP2) {
        PG8_STAGE(PG8_SB(0, 0), cB, voffB); PG8_STAGE(PG8_SB(0, 1), cB + hstep, voffB); PG8_STAGE(PG8_SA(0, 0), cA, voffA); PG8_STAGE(PG8_SA(0, 1), cA + hstep, voffA);
        if (wr == 1) PG8_BAR;
        PG8_WAIT_V(2); PG8_BAR;
        PG8_STAGE(PG8_SB(1, 0), cB + kstep, voffB); PG8_STAGE(PG8_SA(1, 0), cA + kstep, voffA); PG8_STAGE(PG8_SB(1, 1), cB + hstep + kstep, voffB);
        PG8_WAIT_V(6); PG8_BAR;
    } else {
        PG8_STAGE(PG8_SB(0, 0), cB, voffB); PG8_STAGE(PG8_SA(0, 0), cA, voffA); PG8_STAGE(PG8_SB(0, 1), cB + hstep, voffB); PG8_STAGE(PG8_SA(0, 1), cA + hstep, voffA);
        if (wr == 1) PG8_BAR;
        PG8_WAIT_V(4); PG8_BAR;
        PG8_STAGE(PG8_SB(1, 0), cB + kstep, voffB); PG8_STAGE(PG8_SA(1, 0), cA + kstep, voffA); PG8_STAGE(PG8_SB(1, 1), cB + hstep + kstep, voffB);
        PG8_WAIT_V(6); PG8_BAR;
    }
    for (;;) {
        const bool has_next = S.next(ui + 1, nxt);
        const char* nA = has_next ? (const char*)g.A + (size_t)nxt.pm * tstep : cA; const char* nB = has_next ? (const char*)g.Bt + (size_t)nxt.pn * tstep : cB;
        for (int t = 0; t < nt; t += 2) {
            const bool last = (t == nt - 2);
            const char* a1 = cA + (size_t)(t + 1) * kstep;
            const char* a2 = last ? nA : cA + (size_t)(t + 2) * kstep; const char* b2 = last ? nB : cB + (size_t)(t + 2) * kstep;
            const char* a3 = a2 + kstep; const char* b3 = b2 + kstep;
            if (last && has_next) S.a_ready(nxt);
            if constexpr (SP2) {
            PG8_LDB(B0, 0, 0); PG8_LDB(B1, 0, 1); PG8_SCHED; PG8_LDA(At, 0, 0); PG8_STAGE(PG8_SA(1, 1), a1 + hstep, voffA);
            PG8_WAIT_V(8); PG8_WAIT_L(0); PG8_BAR; PG8_MMA(0, 0, At, B0); PG8_MMA(0, 1, At, B1); PG8_BAR; PG8_SCHED;
            PG8_LDA(At, 0, 1); PG8_STAGE(PG8_SB(0, 0), b2, voffB); PG8_STAGE(PG8_SB(0, 1), b2 + hstep, voffB); PG8_STAGE(PG8_SA(0, 0), a2, voffA);
            PG8_WAIT_V(8); PG8_WAIT_L(0); PG8_BAR; PG8_MMA(1, 0, At, B0); PG8_MMA(1, 1, At, B1); PG8_BAR; PG8_SCHED;
            PG8_LDB(B0, 1, 0); PG8_LDB(B1, 1, 1); PG8_SCHED; PG8_LDA(At, 1, 0); PG8_STAGE(PG8_SA(0, 1), a2 + hstep, voffA);
            PG8_WAIT_V(8); PG8_WAIT_L(0); PG8_BAR; PG8_MMA(0, 0, At, B0); PG8_MMA(0, 1, At, B1); PG8_BAR; PG8_SCHED;
            PG8_LDA(At, 1, 1); PG8_STAGE(PG8_SB(1, 0), b3, voffB); PG8_STAGE(PG8_SB(1, 1), b3 + hstep, voffB); PG8_STAGE(PG8_SA(1, 0), a3, voffA);
            PG8_WAIT_V(8); PG8_WAIT_L(0); PG8_BAR; PG8_MMA(1, 0, At, B0); PG8_MMA(1, 1, At, B1); PG8_BAR; PG8_SCHED;
            } else {
            PG8_LDB(B0, 0, 0); PG8_SCHED; PG8_LDA(At, 0, 0); PG8_STAGE(PG8_SA(1, 1), a1 + hstep, voffA);
            PG8_WAIT_L(8); PG8_BAR; PG8_WAIT_L(0); PG8_MMA(0, 0, At, B0); PG8_BAR; PG8_SCHED;
            PG8_LDB(B1, 0, 1); PG8_STAGE(PG8_SB(0, 0), b2, voffB);
            PG8_BAR; PG8_WAIT_L(0); PG8_MMA(0, 1, At, B1); PG8_BAR;
            PG8_LDA(At, 0, 1); PG8_STAGE(PG8_SA(0, 0), a2, voffA);
            PG8_BAR; PG8_WAIT_L(0); PG8_MMA(1, 0, At, B0); PG8_BAR; PG8_SCHED;
            PG8_STAGE(PG8_SB(0, 1), b2 + hstep, voffB);
            PG8_WAIT_V(6); PG8_BAR; PG8_MMA(1, 1, At, B1); PG8_BAR;
            PG8_LDB(B0, 1, 0); PG8_SCHED; PG8_LDA(At, 1, 0); PG8_STAGE(PG8_SA(0, 1), a2 + hstep, voffA);
            PG8_WAIT_L(8); PG8_BAR; PG8_WAIT_L(0); PG8_MMA(0, 0, At, B0); PG8_BAR; PG8_SCHED;
            PG8_LDB(B1, 1, 1); PG8_STAGE(PG8_SB(1, 0), b3, voffB);
            PG8_BAR; PG8_WAIT_L(0); PG8_MMA(0, 1, At, B1); PG8_BAR;
            PG8_LDA(At, 1, 1); PG8_STAGE(PG8_SA(1, 0), a3, voffA);
            PG8_BAR; PG8_WAIT_L(0); PG8_MMA(1, 0, At, B0); PG8_BAR; PG8_SCHED;
            PG8_STAGE(PG8_SB(1, 1), b3 + hstep, voffB);
            PG8_WAIT_V(6); PG8_BAR; PG8_MMA(1, 1, At, B1); PG8_BAR;
            }
        }
        if constexpr (ALIGN_EPI) { if (wr == 0) PG8_BAR; }
        if constexpr (!Epi::AFTER_DRAIN) { E(acc, cur, wr, wc, fr, fq); S.done(cur); }
        if (!has_next) break;
#pragma unroll
        for (int a = 0; a < 2; ++a)
#pragma unroll
            for (int b = 0; b < 2; ++b)
#pragma unroll
                for (int m = 0; m < 4; ++m)
#pragma unroll
                    for (int n = 0; n < 2; ++n) acc[a][b][m][n] = (f32x4){0.f, 0.f, 0.f, 0.f};
        cur = nxt; cA = nA; cB = nB; ++ui;
        if constexpr (ALIGN_EPI) { if (wr == 1) PG8_BAR; }
    }
    PG8_WAIT_V(0);
    if constexpr (!ALIGN_EPI) { if (wr == 0) PG8_BAR; }
    PG8_BAR;
    if constexpr (Epi::AFTER_DRAIN) { E.fused(acc, cur, wr, wc, fr, fq, lds, wid, lane); S.done(cur); }
#undef PG8_SA
#undef PG8_SB
#undef PG8_STAGE
#undef PG8_LDA
#undef PG8_LDB
#undef PG8_MMA
#undef PG8_WAIT_V
#undef PG8_WAIT_L
#undef PG8_BAR
#undef PG8_SCHED
}
}
#define GAS __attribute__((address_space(1)))
#define LAS __attribute__((address_space(3)))
typedef unsigned short bf16;
typedef unsigned v4u __attribute__((ext_vector_type(4)));
typedef float f32x4 __attribute__((ext_vector_type(4)));
typedef short bf16x8 __attribute__((ext_vector_type(8)));
typedef GAS unsigned gu32;
typedef GAS unsigned long long gu64;
#define RLX_AGENT __ATOMIC_RELAXED, __HIP_MEMORY_SCOPE_AGENT
#define LDS_WAIT() asm volatile("s_waitcnt lgkmcnt(0)" ::: "memory")
#define VM_WAIT() asm volatile("s_waitcnt vmcnt(0)" ::: "memory")
__device__ __forceinline__ unsigned long long rt() { return __builtin_amdgcn_s_memrealtime(); }
__device__ __forceinline__ unsigned f2bf(float f) { unsigned u = __builtin_bit_cast(unsigned, f); return (u + 0x7fffu + ((u >> 16) & 1u)) >> 16; }
__device__ __forceinline__ unsigned pk2(float lo, float hi) { return f2bf(lo) | (f2bf(hi) << 16); }

#define XB_TMO      128
#define XB_XCNT(j)  (256  + 64 * (j))
#define XB_XSUB(j)  (1280 + 64 * (j))
#define XB_XGEN(j)  (2304 + 64 * (j))
#define XB_TOP      3328
#define XB_TOPGEN   3392
#define XCD_BAR_WORDS 3456
#define XB_SPIN_CAP (1u << 18)

__device__ __forceinline__ unsigned xb_ld(unsigned* p)              { return __hip_atomic_load(p, __ATOMIC_RELAXED, __HIP_MEMORY_SCOPE_AGENT); }
__device__ __forceinline__ unsigned xb_add(unsigned* p, unsigned v) { return __hip_atomic_fetch_add(p, v, __ATOMIC_RELAXED, __HIP_MEMORY_SCOPE_AGENT); }
__device__ __forceinline__ unsigned xb_xcc_id() { return (unsigned)__builtin_amdgcn_s_getreg((3 << 11) | 20) & 0xFu; }
#define XB_SPIN(cond, bar) do { unsigned _sp = 0; while (cond) { __builtin_amdgcn_s_sleep(1); \
    if ((++_sp & 255u) == 0u) { if (xb_ld(&(bar)[XB_TMO])) break; if (_sp > XB_SPIN_CAP) { atomicAdd(&(bar)[XB_TMO], 1u); break; } } } } while (0)

struct XcdBarrier {
    unsigned* bar; unsigned x;
    volatile LAS unsigned* st;
};

__device__ __forceinline__ XcdBarrier xcd_barrier_post(unsigned* bar, volatile LAS unsigned* st) {
    XcdBarrier b; b.bar = bar; b.x = xb_xcc_id(); b.st = st;
    if (threadIdx.x == 0) (void)xb_add(&bar[XB_XCNT(b.x)], 1u);
    return b;
}
__device__ __forceinline__ void xcd_barrier_complete(unsigned* bar, unsigned x, unsigned& nloc, unsigned& nx) {
    const unsigned G = gridDim.x * gridDim.y * gridDim.z;
    unsigned sum, cnt, mine, sp = 0u;
    for (;;) {
        sum = 0u; cnt = 0u; mine = 0u;
#pragma unroll
        for (unsigned j = 0; j < 16; ++j) { const unsigned c = xb_ld(&bar[XB_XCNT(j)]); sum += c; cnt += (c > 0u) ? 1u : 0u; mine = (j == x) ? c : mine; }
        if (sum == G) break;
        __builtin_amdgcn_s_sleep(1);
        if ((++sp & 255u) == 0u) { if (xb_ld(&bar[XB_TMO])) break; if (sp > XB_SPIN_CAP) { atomicAdd(&bar[XB_TMO], 1u); break; } }
    }
    nloc = mine > 0u ? mine : 1u; nx = cnt > 0u ? cnt : 1u;
}

__device__ __forceinline__ void xcd_barrier(const XcdBarrier& b) {
    asm volatile("s_waitcnt vmcnt(0)" ::: "memory");
    __syncthreads();
    if (threadIdx.x == 0) {
        unsigned* bar = b.bar;
        __builtin_amdgcn_s_waitcnt(0);
        unsigned nloc = b.st[0], nx = b.st[1];
        if (nloc == 0u) { xcd_barrier_complete(bar, b.x, nloc, nx); b.st[0] = nloc; b.st[1] = nx; }
        const unsigned old = xb_add(&bar[XB_XSUB(b.x)], 1u);
        const unsigned gen = old / nloc;
        if (old + 1u == (gen + 1u) * nloc) {
            __builtin_amdgcn_fence(__ATOMIC_RELEASE, "agent");
            asm volatile("s_waitcnt vmcnt(0)" ::: "memory");
            const unsigned og = xb_add(&bar[XB_TOP], 1u);
            const unsigned tg = og / nx;
            if (og + 1u == (tg + 1u) * nx) xb_add(&bar[XB_TOPGEN], 1u);
            else XB_SPIN(xb_ld(&bar[XB_TOPGEN]) == tg, bar);
            __builtin_amdgcn_fence(__ATOMIC_ACQUIRE, "agent");
            xb_add(&bar[XB_XGEN(b.x)], 1u);
            asm volatile("s_waitcnt vmcnt(0)" ::: "memory");
        } else {
            XB_SPIN(xb_ld(&bar[XB_XGEN(b.x)]) == gen, bar);
            __builtin_amdgcn_fence(__ATOMIC_ACQUIRE, "agent");
            asm volatile("s_waitcnt vmcnt(0)" ::: "memory");
        }
    }
    __syncthreads();
}

constexpr int NWAVES = 8;
constexpr int DM = 2048, SEQ = 16384, DEPTH = 4, DB = 8, DS = 32, PAST = 1024;
constexpr int MS = DB * DS;
constexpr int M = SEQ + MS;
constexpr int SKEYS = PAST + DS;
constexpr int NKR = SEQ + DB * SKEYS;
constexpr int NKRP = NKR + 128;
constexpr int NIN = 3908, NPROJ = 4096;
constexpr int DFF = 5632, NQC = 768, NKV = 1024, MIXW = 1536, HD = 128, QKD = 192;
constexpr float EPS = 1e-6f, LOG2E = 1.4426950408889634f, LN2 = 0.6931471805599453f;
constexpr float QS_A = 0.08838834764831845f * LOG2E;
constexpr float QS_B = 0.08838834764831845f;
constexpr float QS_C = 0.07216878364870322f * LOG2E;
constexpr size_t O_Y = 0;
constexpr size_t O_FKP = O_Y + (size_t)M * DM;
constexpr size_t O_FVP = O_FKP + (size_t)DEPTH * SEQ * 512;
constexpr size_t O_FLP = O_FVP + (size_t)DEPTH * SEQ * 512;
constexpr size_t O_SKP = O_FLP + (size_t)DEPTH * SEQ * 4;
constexpr size_t O_SVP = O_SKP + (size_t)DEPTH * SEQ * 512;
constexpr size_t O_CKP = O_SVP + (size_t)DEPTH * SEQ * 512;
constexpr size_t O_KRP = O_CKP + (size_t)DEPTH * SEQ * 256;
constexpr size_t O_FKS = O_KRP + (size_t)DEPTH * SEQ * 64;
constexpr size_t O_FVS = O_FKS + (size_t)DEPTH * MS * 512;
constexpr size_t O_FLS = O_FVS + (size_t)DEPTH * MS * 512;
constexpr size_t O_SKS = O_FLS + (size_t)DEPTH * MS * 4;
constexpr size_t O_SVS = O_SKS + (size_t)DEPTH * MS * 512;
constexpr size_t O_CKS = O_SVS + (size_t)DEPTH * MS * 512;
constexpr size_t O_KRS = O_CKS + (size_t)DEPTH * MS * 256;
constexpr size_t O_END = O_KRS + (size_t)DEPTH * MS * 64;
static_assert(O_END == 191959040ull, "d_out size");
constexpr size_t MiB = 1u << 20;
constexpr size_t WS_CTL = 0, CTL_ZERO_BYTES = 1 * MiB;
constexpr size_t WS_W = 2 * MiB, W_LAYER = 90 * MiB;
constexpr size_t WO_IN = 0, WO_UQ = 16 * MiB, WO_UKV = 17 * MiB, WO_OUT = 18 * MiB, WO_GU = 24 * MiB, WO_DOWN = 68 * MiB;
constexpr size_t WS_ROPE = WS_W + DEPTH * W_LAYER;
constexpr size_t WS_XN = WS_ROPE + 4 * MiB;
constexpr size_t WS_RSS = WS_XN + 65 * MiB;
constexpr size_t WS_QA = WS_RSS + 3 * MiB, WS_QB = WS_QA + 17 * MiB, WS_CQ = WS_QB + 17 * MiB;
constexpr size_t WS_KA = WS_CQ + 17 * MiB, WS_VA = WS_KA + 25 * MiB, WS_KB = WS_VA + 25 * MiB, WS_VB = WS_KB + 25 * MiB;
constexpr size_t WS_CKVN = WS_VB + 25 * MiB;
constexpr size_t WS_KROPE = WS_CKVN + 13 * MiB;
constexpr size_t WS_LOGF = WS_KROPE + 7 * MiB;
constexpr size_t WS_FBIAS = WS_LOGF + 1 * MiB;
constexpr size_t WS_QC = WS_FBIAS + 1 * MiB;
constexpr size_t WS_KC = WS_QC + 25 * MiB;
constexpr size_t WS_ATT = WS_KC + 37 * MiB;
constexpr size_t WS_MIX = WS_ATT + 49 * MiB;
constexpr size_t WS_R = WS_MIX + 49 * MiB;
constexpr size_t WS_PROJ = WS_R, WS_QCR = WS_R + 130 * MiB, WS_KVR = WS_QCR + 25 * MiB;
constexpr size_t WS_H = WS_R;
constexpr size_t WS_END = WS_R + 204 * MiB;
static_assert((size_t)M * DM * 2 <= 65 * MiB && (size_t)M * 32 * 4 <= 3 * MiB && (size_t)M * 512 * 2 <= 17 * MiB && (size_t)NKRP * 512 * 2 <= 25 * MiB, "ws map 1");
static_assert((size_t)NKRP * 256 * 2 <= 13 * MiB && (size_t)NKRP * 64 * 4 <= 7 * MiB && (size_t)NKRP * 16 <= 1 * MiB && (size_t)M * 768 * 2 <= 25 * MiB && (size_t)NKRP * 768 * 2 <= 37 * MiB, "ws map 2");
static_assert((size_t)M * 1536 * 2 <= 49 * MiB && (size_t)M * 4096 * 2 <= 130 * MiB && (size_t)NKRP * 1024 * 2 <= 49 * MiB && (size_t)M * DFF * 2 <= 204 * MiB, "ws map 3");
static_assert((size_t)NPROJ * DM * 2 <= 16 * MiB && (size_t)NQC * 512 * 2 <= MiB && (size_t)NKV * 256 * 2 <= MiB && (size_t)DM * MIXW * 2 <= 6 * MiB && (size_t)2 * DFF * DM * 2 <= 44 * MiB && (size_t)DM * DFF * 2 <= 22 * MiB, "ws map 4");
constexpr int CW_TMO = 0, CW_CODE = 1, CW_BAR = 4096, CW_AQ = 8192;
constexpr int RING_OFF = 0, RING_BYTES = 131072;
constexpr int LDSCTL_OFF = RING_BYTES, MISC_OFF = LDSCTL_OFF + 320;
constexpr int LDS_BYTES = 147456;

typedef float f32x2 __attribute__((ext_vector_type(2)));
__device__ __forceinline__ unsigned pkbf(float lo, float hi) { unsigned r; asm("v_cvt_pk_bf16_f32 %0, %1, %2" : "=v"(r) : "v"(lo), "v"(hi)); return r; }
__device__ __forceinline__ void unpack8(v4u w, float* x) {
    x[0] = __uint_as_float(w.x << 16); x[1] = __uint_as_float(w.x & 0xffff0000u); x[2] = __uint_as_float(w.y << 16); x[3] = __uint_as_float(w.y & 0xffff0000u);
    x[4] = __uint_as_float(w.z << 16); x[5] = __uint_as_float(w.z & 0xffff0000u); x[6] = __uint_as_float(w.w << 16); x[7] = __uint_as_float(w.w & 0xffff0000u); }
__device__ __forceinline__ v4u pack8(const float* y) { v4u w; w.x = pkbf(y[0], y[1]); w.y = pkbf(y[2], y[3]); w.z = pkbf(y[4], y[5]); w.w = pkbf(y[6], y[7]); return w; }
__device__ __forceinline__ void ld8f(const float* p, float* x) { const f32x4 a = *(const f32x4*)p, b = *(const f32x4*)(p + 4); x[0] = a[0]; x[1] = a[1]; x[2] = a[2]; x[3] = a[3]; x[4] = b[0]; x[5] = b[1]; x[6] = b[2]; x[7] = b[3]; }
__device__ __forceinline__ void st8f(float* p, const float* x) { *(f32x4*)p = (f32x4){x[0], x[1], x[2], x[3]}; *(f32x4*)(p + 4) = (f32x4){x[4], x[5], x[6], x[7]}; }
__device__ __forceinline__ float sumsq8(const float* x) { return ((x[0] * x[0] + x[1] * x[1]) + (x[2] * x[2] + x[3] * x[3])) + ((x[4] * x[4] + x[5] * x[5]) + (x[6] * x[6] + x[7] * x[7])); }
__device__ __forceinline__ float wsum16(float v) { v += __shfl_xor(v, 1); v += __shfl_xor(v, 2); v += __shfl_xor(v, 4); v += __shfl_xor(v, 8); return v; }
__device__ __forceinline__ float wsum32(float v) { v = wsum16(v); v += __shfl_xor(v, 16); return v; }
__device__ __forceinline__ float wsum64(float v) { v = wsum32(v); v += __shfl_xor(v, 32); return v; }
enum { I_XP = 0, I_XS, I_CFK, I_CFV, I_CFL, I_CSK, I_CSV, I_CCKV, I_CKR, I_NMIX, I_WIN, I_FBIAS, I_FQN, I_FKN, I_QAN, I_WUQ, I_KVAN, I_WUKV, I_QN, I_KN, I_ONA, I_ONB, I_ONC, I_WOUT, I_NFFN, I_WGU, I_WDOWN, N_INPUTS };
struct KArgs { const float* in[N_INPUTS]; float* out; unsigned char* ws; int ph_lo, ph_hi; };
static_assert(sizeof(KArgs) == N_INPUTS * 8 + 8 + 8 + 8, "KArgs has no padding");

template <int MAT> __device__ __forceinline__ int srccol(int n) {
    if (MAT == 0) { if (n < 1536) return n; if (n < 3904) return n + 4; if (n < 3908) return 1536 + (n - 3904); return -1; }
    if (MAT == 1) { const int pn = n >> 8, half = (n >> 7) & 1, j = n & 127; return half * DFF + pn * 128 + j; }
    return n;
}
template <int MAT> __device__ __forceinline__ void p0_transpose_item(const float* W, int K, int Nsrc, int Ndst, bf16* WT, LAS float* scr, int item, int lane) {
    const int nblk = Ndst / 32, kb = item / nblk, nb = item % nblk, k0 = 64 * kb, n0 = 32 * nb;
    const int sc = srccol<MAT>(n0 + (lane & 31));
#pragma unroll 8
    for (int i = 0; i < 32; ++i) { const int kk = 2 * i + (lane >> 5); scr[kk * 33 + (lane & 31)] = sc >= 0 ? W[(size_t)(k0 + kk) * Nsrc + sc] : 0.f; }
    LDS_WAIT(); asm volatile("" ::: "memory");
    const int c = lane & 7;
#pragma unroll
    for (int j = 0; j < 4; ++j) { const int n = (lane >> 3) + 8 * j; const LAS float* s = scr + (8 * c) * 33 + n;
        v4u o; o.x = pkbf(s[0 * 33], s[1 * 33]); o.y = pkbf(s[2 * 33], s[3 * 33]); o.z = pkbf(s[4 * 33], s[5 * 33]); o.w = pkbf(s[6 * 33], s[7 * 33]);
        *(GAS v4u*)(WT + (size_t)(n0 + n) * K + k0 + 8 * c) = o; }
    LDS_WAIT(); asm volatile("" ::: "memory");
}
__device__ __forceinline__ void p0_prologue(const KArgs& a, LAS unsigned char* lds, int gw, int NGW, int lane, int wave) {
    LAS float* scr = (LAS float*)(lds + RING_OFF + wave * 16384);
    unsigned char* ws = a.ws;
    constexpr int I_IN = (DM / 64) * (NPROJ / 32), I_UQ = (512 / 64) * (NQC / 32), I_UKV = (256 / 64) * (NKV / 32), I_OUT = (MIXW / 64) * (DM / 32),
                  I_GU = (DM / 64) * (2 * DFF / 32), I_DN = (DFF / 64) * (DM / 32), I_LAYER = I_IN + I_UQ + I_UKV + I_OUT + I_GU + I_DN;
    for (int it = gw; it < DEPTH * I_LAYER; it += NGW) {
        const int l = it / I_LAYER; int r = it - l * I_LAYER; unsigned char* wl = ws + WS_W + (size_t)l * W_LAYER;
        if (r < I_IN) { p0_transpose_item<0>(a.in[I_WIN] + (size_t)l * DM * NIN, DM, NIN, NPROJ, (bf16*)(wl + WO_IN), scr, r, lane); continue; } r -= I_IN;
        if (r < I_UQ) { p0_transpose_item<2>(a.in[I_WUQ] + (size_t)l * 512 * NQC, 512, NQC, NQC, (bf16*)(wl + WO_UQ), scr, r, lane); continue; } r -= I_UQ;
        if (r < I_UKV) { p0_transpose_item<2>(a.in[I_WUKV] + (size_t)l * 256 * NKV, 256, NKV, NKV, (bf16*)(wl + WO_UKV), scr, r, lane); continue; } r -= I_UKV;
        if (r < I_OUT) { p0_transpose_item<2>(a.in[I_WOUT] + (size_t)l * MIXW * DM, MIXW, DM, DM, (bf16*)(wl + WO_OUT), scr, r, lane); continue; } r -= I_OUT;
        if (r < I_GU) { p0_transpose_item<1>(a.in[I_WGU] + (size_t)l * DM * 2 * DFF, DM, 2 * DFF, 2 * DFF, (bf16*)(wl + WO_GU), scr, r, lane); continue; } r -= I_GU;
        p0_transpose_item<2>(a.in[I_WDOWN] + (size_t)l * DFF * DM, DFF, DM, DM, (bf16*)(wl + WO_DOWN), scr, r, lane);
    }
    bf16* XN = (bf16*)(ws + WS_XN); float* RSS = (float*)(ws + WS_RSS);
    for (int r = gw; r < M; r += NGW) {
        const float* xr = (r < SEQ ? a.in[I_XP] + (size_t)r * DM : a.in[I_XS] + (size_t)(r - SEQ) * DM) + 4 * lane; float ss = 0.f;
#pragma unroll
        for (int j = 0; j < 8; ++j) { const f32x4 v = *(const f32x4*)(xr + 256 * j), g = *(const f32x4*)(a.in[I_NMIX] + 4 * lane + 256 * j);
            ss += (v[0] * v[0] + v[1] * v[1]) + (v[2] * v[2] + v[3] * v[3]);
            f32x2 o; o.x = __uint_as_float(pkbf(v[0] * g[0], v[1] * g[1])); o.y = __uint_as_float(pkbf(v[2] * g[2], v[3] * g[3]));
            *(f32x2*)(XN + (size_t)r * DM + 4 * lane + 256 * j) = o; }
        ss = wsum64(ss);
        if (lane < 32) RSS[(size_t)r * 32 + lane] = lane == 0 ? ss : 0.f;
    }
    f32x2* ROPE = (f32x2*)(ws + WS_ROPE);
    for (int e = gw * 64 + lane; e < SEQ * 32; e += NGW * 64) { const int pos = e >> 5, j = e & 31;
        const float inv = exp2f(-(float)j * 0.4152410118609203f); const float ang = (float)pos * inv;
        double rv = (double)ang * 0.15915494309189535; rv -= rint(rv);
        ROPE[e] = (f32x2){__builtin_amdgcn_cosf((float)rv), __builtin_amdgcn_sinf((float)rv)}; }
    for (int e = gw * 64 + lane; e < 128 * 64; e += NGW * 64) { const int pr = NKR + (e >> 6), c = (e & 63) * 8; const v4u z = {0u, 0u, 0u, 0u};
        *(v4u*)((bf16*)(ws + WS_KA) + (size_t)pr * 512 + c) = z; *(v4u*)((bf16*)(ws + WS_VA) + (size_t)pr * 512 + c) = z;
        *(v4u*)((bf16*)(ws + WS_KB) + (size_t)pr * 512 + c) = z; *(v4u*)((bf16*)(ws + WS_VB) + (size_t)pr * 512 + c) = z;
        *(v4u*)((bf16*)(ws + WS_KC) + (size_t)pr * 768 + c) = z; if (c < 256) *(v4u*)((bf16*)(ws + WS_KC) + (size_t)pr * 768 + 512 + c) = z;
        *(v4u*)((bf16*)(ws + WS_KVR) + (size_t)pr * 1024 + c) = z; *(v4u*)((bf16*)(ws + WS_KVR) + (size_t)pr * 1024 + 512 + c) = z;
        if (c < 4 * 8) ((float*)(ws + WS_FBIAS))[(size_t)(c >> 3) * NKRP + pr] = 0.f; }
}

__device__ __forceinline__ float log_sigmoid(float v) { return fminf(v, 0.f) - log1pf(__expf(-fabsf(v))); }
__device__ __forceinline__ void pb_token_row(const KArgs& a, int l, int r, int lane) {
    unsigned char* ws = a.ws; float* out = a.out;
    const bf16* pr = (const bf16*)(ws + WS_PROJ) + (size_t)r * NPROJ + lane * 8;
    const bool smp = r >= SEQ; const int rs_ = r - SEQ;
    const int kr = smp ? SEQ + (rs_ >> 5) * SKEYS + PAST + (rs_ & 31) : r;
    const size_t orow = smp ? (size_t)l * MS + rs_ : (size_t)l * SEQ + r;
    float x[8], y[8], g[8];
    { unpack8(*(const v4u*)(pr + 0), x); const float rs = 1.0f / sqrtf(wsum16(sumsq8(x)) * (1.f / 128.f) + EPS); ld8f(a.in[I_FQN] + l * 128 + (lane & 15) * 8, g);
#pragma unroll
      for (int i = 0; i < 8; ++i) y[i] = x[i] * rs * g[i] * QS_A;
      *(v4u*)((bf16*)(ws + WS_QA) + (size_t)r * 512 + lane * 8) = pack8(y); }
    { unpack8(*(const v4u*)(pr + 512), x); const float rs = 1.0f / sqrtf(wsum16(sumsq8(x)) * (1.f / 128.f) + EPS); ld8f(a.in[I_FKN] + l * 128 + (lane & 15) * 8, g);
#pragma unroll
      for (int i = 0; i < 8; ++i) y[i] = x[i] * rs * g[i];
      st8f(out + (smp ? O_FKS : O_FKP) + orow * 512 + lane * 8, y); *(v4u*)((bf16*)(ws + WS_KA) + (size_t)kr * 512 + lane * 8) = pack8(y); }
    { const v4u w = *(const v4u*)(pr + 1024); unpack8(w, x); st8f(out + (smp ? O_FVS : O_FVP) + orow * 512 + lane * 8, x); *(v4u*)((bf16*)(ws + WS_VA) + (size_t)kr * 512 + lane * 8) = w; }
    { unpack8(*(const v4u*)(pr + 1536), x);
#pragma unroll
      for (int i = 0; i < 8; ++i) y[i] = x[i] * QS_B;
      *(v4u*)((bf16*)(ws + WS_QB) + (size_t)r * 512 + lane * 8) = pack8(y); }
    { const v4u w = *(const v4u*)(pr + 2048); unpack8(w, x); st8f(out + (smp ? O_SKS : O_SKP) + orow * 512 + lane * 8, x); *(v4u*)((bf16*)(ws + WS_KB) + (size_t)kr * 512 + lane * 8) = w; }
    { const v4u w = *(const v4u*)(pr + 2560); unpack8(w, x); st8f(out + (smp ? O_SVS : O_SVP) + orow * 512 + lane * 8, x); *(v4u*)((bf16*)(ws + WS_VB) + (size_t)kr * 512 + lane * 8) = w; }
    { unpack8(*(const v4u*)(pr + 3072), x); const float rs = 1.0f / sqrtf(wsum64(sumsq8(x)) * (1.f / 512.f) + EPS); ld8f(a.in[I_QAN] + l * 512 + lane * 8, g);
#pragma unroll
      for (int i = 0; i < 8; ++i) y[i] = x[i] * rs * g[i];
      *(v4u*)((bf16*)(ws + WS_CQ) + (size_t)r * 512 + lane * 8) = pack8(y); }
    { unpack8(*(const v4u*)(pr + 3584), x);
      const float rs = 1.0f / sqrtf(wsum32(sumsq8(x)) * (1.f / 256.f) + EPS);
      if (lane < 32) { ld8f(a.in[I_KVAN] + l * 256 + lane * 8, g);
#pragma unroll
          for (int i = 0; i < 8; ++i) y[i] = x[i] * rs * g[i];
          st8f(out + (smp ? O_CKS : O_CKP) + orow * 256 + lane * 8, y); *(v4u*)((bf16*)(ws + WS_CKVN) + (size_t)kr * 256 + lane * 8) = pack8(y); }
      else if (lane < 40) { st8f(out + (smp ? O_KRS : O_KRP) + orow * 64 + (lane - 32) * 8, x); st8f((float*)(ws + WS_KROPE) + (size_t)kr * 64 + (lane - 32) * 8, x); }
      else if (lane == 40) { const f32x4 fb = *(const f32x4*)(a.in[I_FBIAS] + l * 4);
          const f32x4 lf = {log_sigmoid(x[0] + fb[0]), log_sigmoid(x[1] + fb[1]), log_sigmoid(x[2] + fb[2]), log_sigmoid(x[3] + fb[3])};
          *(f32x4*)(out + (smp ? O_FLS : O_FLP) + orow * 4) = lf; *(f32x4*)((float*)(ws + WS_LOGF) + (size_t)kr * 4) = lf; } }
}
__device__ __forceinline__ void pb_cache_row(const KArgs& a, int l, int cr, int lane) {
    unsigned char* ws = a.ws; const int b = cr >> 10, j = cr & 1023, kr = SEQ + b * SKEYS + j; const size_t src = (size_t)l * DB * PAST + cr;
    float x[8];
    ld8f(a.in[I_CFK] + src * 512 + lane * 8, x); *(v4u*)((bf16*)(ws + WS_KA) + (size_t)kr * 512 + lane * 8) = pack8(x);
    ld8f(a.in[I_CFV] + src * 512 + lane * 8, x); *(v4u*)((bf16*)(ws + WS_VA) + (size_t)kr * 512 + lane * 8) = pack8(x);
    ld8f(a.in[I_CSK] + src * 512 + lane * 8, x); *(v4u*)((bf16*)(ws + WS_KB) + (size_t)kr * 512 + lane * 8) = pack8(x);
    ld8f(a.in[I_CSV] + src * 512 + lane * 8, x); *(v4u*)((bf16*)(ws + WS_VB) + (size_t)kr * 512 + lane * 8) = pack8(x);
    if (lane < 32) { ld8f(a.in[I_CCKV] + src * 256 + lane * 8, x); *(v4u*)((bf16*)(ws + WS_CKVN) + (size_t)kr * 256 + lane * 8) = pack8(x); }
    else if (lane < 40) { ld8f(a.in[I_CKR] + src * 64 + (lane - 32) * 8, x); st8f((float*)(ws + WS_KROPE) + (size_t)kr * 64 + (lane - 32) * 8, x); }
    else if (lane == 40) { *(f32x4*)((float*)(ws + WS_LOGF) + (size_t)kr * 4) = *(const f32x4*)(a.in[I_CFL] + src * 4); }
}
__device__ __forceinline__ void scan_job(unsigned char* ws, LAS float* sm, int job, int tid, int wave, int lane) {
    const int h = job & 3, sq = job >> 2; const int krow0 = sq == 0 ? 0 : SEQ + (sq - 1) * SKEYS, n = sq == 0 ? SEQ : SKEYS, per = sq == 0 ? 32 : 3;
    const float* LOGF = (const float*)(ws + WS_LOGF) + (size_t)krow0 * 4 + h; float* FB = (float*)(ws + WS_FBIAS) + (size_t)h * NKRP + krow0;
    const int i0 = tid * per; float loc = 0.f;
    for (int i = 0; i < per; ++i) if (i0 + i < n) loc += LOGF[(size_t)(i0 + i) * 4];
    float inc = loc;
#pragma unroll
    for (int o = 1; o < 64; o <<= 1) { const float t = __shfl_up(inc, o); if (lane >= o) inc += t; }
    if (lane == 63) sm[wave] = inc;
    __syncthreads();
    float run = inc - loc;
    for (int w = 0; w < wave; ++w) run += sm[w];
    for (int i = 0; i < per; ++i) if (i0 + i < n) { run += LOGF[(size_t)(i0 + i) * 4]; FB[i0 + i] = -LOG2E * run; }
    __syncthreads();
}
__device__ __forceinline__ void pd_q_row(const KArgs& a, int l, int r, int lane) {
    unsigned char* ws = a.ws; const int li = lane & 31, hh = lane >> 5;
    const int qpos = r < SEQ ? r : PAST + ((r - SEQ) & 31);
    const f32x2* rope = (const f32x2*)(ws + WS_ROPE) + (size_t)qpos * 32; const float* gn = a.in[I_QN] + l * QKD;
#pragma unroll
    for (int it = 0; it < 2; ++it) { const int head = it * 2 + hh;
        const bf16* src = (const bf16*)(ws + WS_QCR) + (size_t)r * NQC + head * QKD; bf16* dst = (bf16*)(ws + WS_QC) + (size_t)r * NQC + head * QKD;
        float x1[8], x2[8], y[8], g[8]; float ss = 0.f;
        if (li < 16) { unpack8(*(const v4u*)(src + li * 8), x1); ss = sumsq8(x1); }
        else if (li < 20) { unpack8(*(const v4u*)(src + 128 + (li - 16) * 8), x1); unpack8(*(const v4u*)(src + 160 + (li - 16) * 8), x2); ss = sumsq8(x1) + sumsq8(x2); }
        const float rs = 1.0f / sqrtf(wsum32(ss) * (1.f / 192.f) + EPS);
        if (li < 16) { ld8f(gn + li * 8, g);
#pragma unroll
            for (int i = 0; i < 8; ++i) y[i] = x1[i] * rs * g[i] * QS_C;
            *(v4u*)(dst + li * 8) = pack8(y); }
        else if (li < 20) { const int m = li - 16; float g2[8], y2[8]; ld8f(gn + 128 + m * 8, g); ld8f(gn + 160 + m * 8, g2);
#pragma unroll
            for (int i = 0; i < 8; ++i) { const f32x2 cs = rope[m * 8 + i]; const float u1 = x1[i] * rs * g[i], u2 = x2[i] * rs * g2[i];
                y[i] = (u1 * cs.x - u2 * cs.y) * QS_C; y2[i] = (u2 * cs.x + u1 * cs.y) * QS_C; }
            *(v4u*)(dst + 128 + m * 8) = pack8(y); *(v4u*)(dst + 160 + m * 8) = pack8(y2); }
    }
}
__device__ __forceinline__ void pd_k_row(const KArgs& a, int l, int kr, int lane) {
    unsigned char* ws = a.ws; const int li = lane & 31, hh = lane >> 5;
    const int kpos = kr < SEQ ? kr : (kr - SEQ) % SKEYS;
    const f32x2* rope = (const f32x2*)(ws + WS_ROPE) + (size_t)kpos * 32; const float* gn = a.in[I_KN] + l * QKD;
    const float* kro = (const float*)(ws + WS_KROPE) + (size_t)kr * 64;
#pragma unroll
    for (int it = 0; it < 2; ++it) { const int head = it * 2 + hh;
        const bf16* src = (const bf16*)(ws + WS_KVR) + (size_t)kr * NKV + head * 256; bf16* dst = (bf16*)(ws + WS_KC) + (size_t)kr * NQC + head * QKD;
        float x1[8], x2[8], y[8], g[8]; float ss = 0.f;
        if (li < 16) { unpack8(*(const v4u*)(src + li * 8), x1); ss = sumsq8(x1); }
        else if (li < 20) { ld8f(kro + (li - 16) * 8, x1); ld8f(kro + 32 + (li - 16) * 8, x2); ss = sumsq8(x1) + sumsq8(x2); }
        const float rs = 1.0f / sqrtf(wsum32(ss) * (1.f / 192.f) + EPS);
        if (li < 16) { ld8f(gn + li * 8, g);
#pragma unroll
            for (int i = 0; i < 8; ++i) y[i] = x1[i] * rs * g[i];
            *(v4u*)(dst + li * 8) = pack8(y); }
        else if (li < 20) { const int m = li - 16; float g2[8], y2[8]; ld8f(gn + 128 + m * 8, g); ld8f(gn + 160 + m * 8, g2);
#pragma unroll
            for (int i = 0; i < 8; ++i) { const f32x2 cs = rope[m * 8 + i]; const float u1 = x1[i] * rs * g[i], u2 = x2[i] * rs * g2[i];
                y[i] = u1 * cs.x - u2 * cs.y; y2[i] = u2 * cs.x + u1 * cs.y; }
            *(v4u*)(dst + 128 + m * 8) = pack8(y); *(v4u*)(dst + 160 + m * 8) = pack8(y2); }
    }
}
__device__ __forceinline__ void pf_row(const KArgs& a, int l, int r, int lane) {
    unsigned char* ws = a.ws; const bf16* src = (const bf16*)(ws + WS_ATT) + (size_t)r * MIXW + lane * 8; bf16* dst = (bf16*)(ws + WS_MIX) + (size_t)r * MIXW + lane * 8;
#pragma unroll
    for (int gI = 0; gI < 3; ++gI) { float x[8], g[8], y[8]; unpack8(*(const v4u*)(src + gI * 512), x);
        const float rs = 1.0f / sqrtf(wsum64(sumsq8(x)) * (1.f / 512.f) + EPS); ld8f(a.in[I_ONA + gI] + l * 512 + lane * 8, g);
#pragma unroll
        for (int i = 0; i < 8; ++i) y[i] = x[i] * rs * g[i];
        *(v4u*)(dst + gI * 512) = pack8(y); }
}

namespace att {
typedef float f32x16 __attribute__((ext_vector_type(16)));
typedef short s16x4 __attribute__((ext_vector_type(4)));
constexpr int OFF_K = 0, OFF_V = 24576, OFF_B = 40960, BUF = 41216, WSC = 2 * BUF;
constexpr int ATT_LDS = WSC + NWAVES * 256;
static_assert(ATT_LDS <= RING_BYTES, "attention LDS");
__device__ __forceinline__ int v_st(int k, int c) { const int kk = (k & ~0xC) | ((k & 4) << 1) | ((k & 8) >> 1); return ((kk >> 3) * 4 + (c >> 5)) * 512 + ((kk & 7) * 32 + (c & 31)) * 2; }
__device__ __forceinline__ int v_rd_base(int lane) { return ((lane & 3) << 3) | (((lane >> 2) & 3) << 6) | (((lane >> 4) & 1) << 5) | (((lane >> 5) & 1) << 8); }
constexpr int v_rd_off(int d0, int ks, int half) { return d0 * 512 + ks * 4096 + half * 2048; }
__device__ __forceinline__ int crow(int r, int hi) { return (r & 3) + 8 * (r >> 2) + 4 * hi; }
__device__ __forceinline__ bf16x8 mk8(s16x4 l, s16x4 h) { return (bf16x8){l[0], l[1], l[2], l[3], h[0], h[1], h[2], h[3]}; }
__device__ __forceinline__ void pv_tile(f32x16* o, unsigned vb, bf16x8 pa0, bf16x8 pa1, bf16x8 pa2, bf16x8 pa3) {
#define TRRD(dst, off) asm volatile("ds_read_b64_tr_b16 %0, %1 offset:%2" : "=&v"(dst) : "v"(vb), "i"(off) : "memory")
#define PV_D0(d0) do { s16x4 l0, l1, l2, l3, h0, h1, h2, h3; constexpr int b_ = v_rd_off(d0, 0, 0); \
        TRRD(l0, b_); TRRD(h0, b_ + 2048); TRRD(l1, b_ + 4096); TRRD(h1, b_ + 6144); TRRD(l2, b_ + 8192); TRRD(h2, b_ + 10240); TRRD(l3, b_ + 12288); TRRD(h3, b_ + 14336); \
        asm volatile("s_waitcnt lgkmcnt(0)" ::: "memory"); __builtin_amdgcn_sched_barrier(0); \
        o[d0] = __builtin_amdgcn_mfma_f32_32x32x16_bf16(pa0, mk8(l0, h0), o[d0], 0, 0, 0); \
        o[d0] = __builtin_amdgcn_mfma_f32_32x32x16_bf16(pa1, mk8(l1, h1), o[d0], 0, 0, 0); \
        o[d0] = __builtin_amdgcn_mfma_f32_32x32x16_bf16(pa2, mk8(l2, h2), o[d0], 0, 0, 0); \
        o[d0] = __builtin_amdgcn_mfma_f32_32x32x16_bf16(pa3, mk8(l3, h3), o[d0], 0, 0, 0); } while (0)
    PV_D0(0); PV_D0(1); PV_D0(2); PV_D0(3);
#undef PV_D0
#undef TRRD
}
__device__ __forceinline__ void pack_p(const f32x16& p0, const f32x16& p1, bf16x8& pa0, bf16x8& pa1, bf16x8& pa2, bf16x8& pa3) {
#define PK4(P, B_, OUT) do { unsigned a0 = pkbf(P[B_ + 0], P[B_ + 1]), a1 = pkbf(P[B_ + 2], P[B_ + 3]), b0 = pkbf(P[B_ + 4], P[B_ + 5]), b1 = pkbf(P[B_ + 6], P[B_ + 7]); \
        auto r0 = __builtin_amdgcn_permlane32_swap(a0, b0, false, false); auto r1 = __builtin_amdgcn_permlane32_swap(a1, b1, false, false); \
        v4u w = {r0[0], r1[0], r0[1], r1[1]}; OUT = __builtin_bit_cast(bf16x8, w); } while (0)
    PK4(p0, 0, pa0); PK4(p0, 8, pa1); PK4(p1, 0, pa2); PK4(p1, 8, pa3);
#undef PK4
}
struct UnitDesc { int h, qrow0, nq, krow0, qpos0, nkeys; };
template <int TYPE  >
__device__ __forceinline__ void attn_unit(LAS unsigned char* L, unsigned char* ws, const UnitDesc U) {
    constexpr int DK = TYPE == 2 ? QKD : HD, ND = DK / 16, NKC = DK / 64, CPR = DK / 8, KROWB = DK * 2;
    constexpr int QP = TYPE == 2 ? NQC : 512, KP = QP, VP = TYPE == 2 ? NKV : 512;
    int tid_ = threadIdx.x; asm volatile("" : "+v"(tid_));
    const int tid = tid_, wid = __builtin_amdgcn_readfirstlane(tid >> 6), lane = tid & 63, r32 = lane & 31, hi = lane >> 5;
    const bf16* Qg = (const bf16*)(ws + (TYPE == 0 ? WS_QA : TYPE == 1 ? WS_QB : WS_QC)) + (size_t)U.qrow0 * QP + U.h * DK;
    const bf16* Kg = (const bf16*)(ws + (TYPE == 0 ? WS_KA : TYPE == 1 ? WS_KB : WS_KC)) + (size_t)U.krow0 * KP + U.h * DK;
    const bf16* Vg = (const bf16*)(ws + (TYPE == 0 ? WS_VA : TYPE == 1 ? WS_VB : WS_KVR)) + (size_t)U.krow0 * VP + (TYPE == 2 ? U.h * 256 + 128 : U.h * HD);
    const float* FBh = (const float*)(ws + WS_FBIAS) + (size_t)U.h * NKRP + U.krow0;
    const bool wact = wid * 32 < U.nq;
    const int qlo = U.qpos0 + wid * 32, qpos = qlo + r32;
    const int NT = (U.qpos0 + U.nq - 1) / 64 + 1;
    int kgoff[NKC], kloff[NKC];
#pragma unroll
    for (int i = 0; i < NKC; ++i) { const int c = tid + 512 * i, row = c / CPR, cc = c % CPR; kgoff[i] = row * KP + cc * 8; kloff[i] = row * KROWB + ((cc * 16) ^ ((row & 7) << 4)); }
    const int sr = tid >> 4, sc = (tid & 15) * 8; const int vg0 = sr * VP + sc, vg1 = (32 + sr) * VP + sc, vl0 = v_st(sr, sc), vl1 = v_st(32 + sr, sc);
    v4u stk[NKC], stv0, stv1; f32x4 stb = {0.f, 0.f, 0.f, 0.f};
#define ST_LOAD(t) do { const int kb_ = (t) * 64; \
        _Pragma("unroll") for (int i = 0; i < NKC; ++i) stk[i] = *(const v4u*)(Kg + (size_t)kb_ * KP + kgoff[i]); \
        stv0 = *(const v4u*)(Vg + (size_t)kb_ * VP + vg0); stv1 = *(const v4u*)(Vg + (size_t)kb_ * VP + vg1); \
        if (TYPE == 0 && tid < 16) stb = *(const f32x4*)(FBh + kb_ + tid * 4); } while (0)
#define ST_WRITE(bf) do { LAS unsigned char* B_ = L + (bf) * BUF; \
        _Pragma("unroll") for (int i = 0; i < NKC; ++i) *(LAS v4u*)(B_ + OFF_K + kloff[i]) = stk[i]; \
        *(LAS v4u*)(B_ + OFF_V + vl0) = stv0; *(LAS v4u*)(B_ + OFF_V + vl1) = stv1; \
        if (TYPE == 0 && tid < 16) *(LAS f32x4*)(B_ + OFF_B + tid * 16) = stb; } while (0)
    ST_LOAD(NT - 1);
    bf16x8 qr[ND];
    if (wact) {
#pragma unroll
        for (int d0 = 0; d0 < ND; ++d0) qr[d0] = *(const bf16x8*)(Qg + (size_t)(wid * 32 + r32) * QP + d0 * 16 + hi * 8);
    } else {
#pragma unroll
        for (int d0 = 0; d0 < ND; ++d0) qr[d0] = (bf16x8){0, 0, 0, 0, 0, 0, 0, 0};
    }
    LAS float* wsc = (LAS float*)(L + WSC + wid * 256);
    float m_reg = -1e30f, l_reg = 0.f, Rsum = 0.f; f32x16 o[4];
#pragma unroll
    for (int d = 0; d < 4; ++d) o[d] = (f32x16){};
    int kbase[4];
#pragma unroll
    for (int dd = 0; dd < 4; ++dd) kbase[dd] = r32 * KROWB + ((dd * 32 + hi * 16) ^ ((r32 & 7) << 4));
    const unsigned vrd = (unsigned)(size_t)(L + OFF_V) + (unsigned)v_rd_base(lane);
    VM_WAIT(); ST_WRITE(0); __syncthreads();
    for (int i = 0; i < NT; ++i) {
        const int t = NT - 1 - i, bf = i & 1, kb = t * 64;
        if (i + 1 < NT) ST_LOAD(t - 1);
        bool act, needmask;
        if (TYPE == 0) { act = kb <= qlo + 31; needmask = kb + 63 > qlo; }
        else if (TYPE == 1) { act = kb < qlo + 31; needmask = kb + 63 >= qlo; }
        else { act = t <= (qlo >> 6); needmask = kb + 64 > U.nkeys; }
        act = act && wact;
        if (act) {
            LAS unsigned char* Bf = L + bf * BUF;
            f32x16 p0 = (f32x16){}, p1 = (f32x16){};
#pragma unroll
            for (int d0 = 0; d0 < ND; ++d0) { LAS unsigned char* ka = Bf + OFF_K + kbase[d0 & 3] + (d0 >> 2) * 128;
                const bf16x8 a0 = *(const LAS bf16x8*)ka, a1 = *(const LAS bf16x8*)(ka + 32 * KROWB);
                p0 = __builtin_amdgcn_mfma_f32_32x32x16_bf16(a0, qr[d0], p0, 0, 0, 0);
                p1 = __builtin_amdgcn_mfma_f32_32x32x16_bf16(a1, qr[d0], p1, 0, 0, 0); }
            bf16x8 pa0, pa1, pa2, pa3;
            if (TYPE != 1) {
                if (TYPE == 0) {
#pragma unroll
                    for (int g = 0; g < 4; ++g) { const f32x4 b0 = *(const LAS f32x4*)(Bf + OFF_B + (8 * g + 4 * hi) * 4), b1 = *(const LAS f32x4*)(Bf + OFF_B + (32 + 8 * g + 4 * hi) * 4);
#pragma unroll
                        for (int e = 0; e < 4; ++e) { p0[4 * g + e] += b0[e]; p1[4 * g + e] += b1[e]; } }
                }
                if (needmask) { const float NEG = -__builtin_inff();
#pragma unroll
                    for (int r = 0; r < 16; ++r) { const int kv = kb + crow(r, hi);
                        if (TYPE == 0) { if (kv > qpos) p0[r] = NEG; if (kv + 32 > qpos) p1[r] = NEG; }
                        else { if (kv >= U.nkeys) p0[r] = NEG; if (kv + 32 >= U.nkeys) p1[r] = NEG; } } }
                float pmax = p0[0];
#pragma unroll
                for (int r = 1; r < 16; ++r) pmax = fmaxf(pmax, p0[r]);
#pragma unroll
                for (int r = 0; r < 16; ++r) pmax = fmaxf(pmax, p1[r]);
                { auto rr = __builtin_amdgcn_permlane32_swap(__float_as_uint(pmax), __float_as_uint(pmax), false, false); pmax = fmaxf(__uint_as_float(rr[0]), __uint_as_float(rr[1])); }
                const float mn = fmaxf(m_reg, pmax), alpha = __builtin_amdgcn_exp2f(m_reg - mn); m_reg = mn;
                float ps = 0.f;
#pragma unroll
                for (int r = 0; r < 16; ++r) { p0[r] = __builtin_amdgcn_exp2f(p0[r] - mn); p1[r] = __builtin_amdgcn_exp2f(p1[r] - mn); ps += p0[r] + p1[r]; }
                { auto rr = __builtin_amdgcn_permlane32_swap(__float_as_uint(ps), __float_as_uint(ps), false, false); ps = __uint_as_float(rr[0]) + __uint_as_float(rr[1]); }
                l_reg = l_reg * alpha + ps;
                if (__any(alpha < 1.f)) { if (hi == 0) wsc[r32] = alpha; LDS_WAIT();
#pragma unroll
                    for (int g = 0; g < 4; ++g) { const f32x4 al = *(const LAS f32x4*)(wsc + 8 * g + 4 * hi);
#pragma unroll
                        for (int d = 0; d < 4; ++d)
#pragma unroll
                            for (int e = 0; e < 4; ++e) o[d][4 * g + e] *= al[e]; } }
            } else {
                f32x16 k0, k1;
#pragma unroll
                for (int r = 0; r < 16; ++r) { const int kv = kb + crow(r, hi); const bool v0 = !needmask || kv < qpos, v1 = !needmask || kv + 32 < qpos;
                    const float z0 = p0[r], z1 = p1[r];
                    const float s0 = fmaxf(z0, 0.f) + LN2 * __builtin_amdgcn_logf(1.0f + __builtin_amdgcn_exp2f(-LOG2E * fabsf(z0)));
                    const float s1 = fmaxf(z1, 0.f) + LN2 * __builtin_amdgcn_logf(1.0f + __builtin_amdgcn_exp2f(-LOG2E * fabsf(z1)));
                    k0[r] = v0 ? -s0 : 0.f; k1[r] = v1 ? -s1 : 0.f; }
                float G[8], T[8], X[8];
#pragma unroll
                for (int g = 0; g < 4; ++g) { G[g] = (k0[4 * g] + k0[4 * g + 1]) + (k0[4 * g + 2] + k0[4 * g + 3]); G[4 + g] = (k1[4 * g] + k1[4 * g + 1]) + (k1[4 * g + 2] + k1[4 * g + 3]); }
#pragma unroll
                for (int g = 0; g < 8; ++g) { auto rr = __builtin_amdgcn_permlane32_swap(__float_as_uint(G[g]), __float_as_uint(G[g]), false, false);
                    const float a_lo = __uint_as_float(rr[0]), a_hi = __uint_as_float(rr[1]);
                    T[g] = a_lo + a_hi; X[g] = hi == 0 ? a_hi : 0.f; }
                float later = Rsum;
#pragma unroll
                for (int g = 7; g >= 0; --g) { const float base = later + X[g];
                    if (g >= 4) { float s = base;
#pragma unroll
                        for (int e = 3; e >= 0; --e) { s += k1[4 * (g - 4) + e]; k1[4 * (g - 4) + e] = s; } }
                    else { float s = base;
#pragma unroll
                        for (int e = 3; e >= 0; --e) { s += k0[4 * g + e]; k0[4 * g + e] = s; } }
                    later += T[g]; }
                Rsum = later;
#pragma unroll
                for (int r = 0; r < 16; ++r) { const int kv = kb + crow(r, hi); const bool v0 = !needmask || kv < qpos, v1 = !needmask || kv + 32 < qpos;
                    const float a0 = __builtin_amdgcn_exp2f(LOG2E * (p0[r] + k0[r])), a1 = __builtin_amdgcn_exp2f(LOG2E * (p1[r] + k1[r]));
                    p0[r] = v0 ? a0 : 0.f; p1[r] = v1 ? a1 : 0.f; }
            }
            pack_p(p0, p1, pa0, pa1, pa2, pa3);
            pv_tile(o, vrd + (unsigned)(bf * BUF), pa0, pa1, pa2, pa3);
        }
        if (i + 1 < NT) { VM_WAIT(); ST_WRITE(bf ^ 1); }
        __syncthreads();
    }
#undef ST_LOAD
#undef ST_WRITE
    if (wact) {
        float rli[16];
        if (TYPE != 1) { if (hi == 0) wsc[r32] = l_reg; LDS_WAIT();
#pragma unroll
            for (int g = 0; g < 4; ++g) { const f32x4 lv = *(const LAS f32x4*)(wsc + 8 * g + 4 * hi);
#pragma unroll
                for (int e = 0; e < 4; ++e) rli[4 * g + e] = 1.0f / lv[e]; } }
        else {
#pragma unroll
            for (int r = 0; r < 16; ++r) rli[r] = 1.f; }
        bf16* Ow = (bf16*)(ws + WS_ATT) + (size_t)(U.qrow0 + wid * 32) * MIXW + TYPE * 512 + U.h * HD;
#pragma unroll
        for (int r = 0; r < 16; ++r) { const int orow = crow(r, hi);
#pragma unroll
            for (int d0 = 0; d0 < 4; ++d0) { const float v = o[d0][r] * rli[r]; const float vn = __shfl_xor(v, 1);
                if ((r32 & 1) == 0) *(unsigned*)(Ow + (size_t)orow * MIXW + d0 * 32 + r32) = pkbf(v, vn); } }
    }
}
constexpr int NU_PROMPT = 3 * 4 * (SEQ / 256), NU_SAMPLE = 3 * DB * 4, NU = NU_PROMPT + NU_SAMPLE;
}

constexpr int NPH = 1 + 9 * DEPTH;
__global__ void __launch_bounds__(NWAVES * 64, 2) trunk_fwd(KArgs a) {
    extern __shared__ __attribute__((aligned(16))) unsigned char lds_raw[];
    LAS unsigned char* lds = (LAS unsigned char*)lds_raw;
    volatile LAS unsigned* MISC = (volatile LAS unsigned*)(lds + MISC_OFF);
    const int tid = threadIdx.x, lane = tid & 63, wave = __builtin_amdgcn_readfirstlane(tid >> 6);
    const int G = gridDim.x, gw = blockIdx.x * NWAVES + wave, NGW = G * NWAVES;
    unsigned char* ws = a.ws;
    gu32* ctl = (gu32*)(ws + WS_CTL);
    for (int u = tid; u < (LDS_BYTES - LDSCTL_OFF) / 4; u += NWAVES * 64) ((LAS unsigned*)(lds + LDSCTL_OFF))[u] = 0u;
    __syncthreads();
    XcdBarrier bar; bar.bar = (unsigned*)(ctl + CW_BAR); bar.x = 0; bar.st = nullptr;
    if (MK_ONE_LAUNCH) bar = xcd_barrier_post((unsigned*)(ctl + CW_BAR), MISC + 8);
    const int lo = a.ph_lo, hi = a.ph_hi;
#define IN(k) (lo <= (k) && (k) < hi)
#define SEAM(k) do { if (IN(k) && IN((k) + 1)) xcd_barrier(bar); } while (0)

    if (IN(0)) { p0_prologue(a, lds, gw, NGW, lane, wave); SEAM(0); }

    for (int l = 0; l < DEPTH; ++l) {
        const int pb = 1 + 9 * l;
        unsigned char* wl = ws + WS_W + (size_t)l * W_LAYER;
        if (IN(pb + 0)) {
            pg8::Gemm g{(const bf16*)(ws + WS_XN), (const bf16*)(wl + WO_IN), M, NPROJ, DM}; pg8::StaticOrder S; S.init(M, NPROJ, G, (int)blockIdx.x);
            pg8::EpiScaled E{(bf16*)(ws + WS_PROJ), NPROJ, (const float*)(ws + WS_RSS), 1.f / DM};
            pg8::gemm_phase<pg8::EpiScaled, pg8::StaticOrder, true, true>(lds + RING_OFF, g, S, E);
            SEAM(pb + 0);
        }
        if (IN(pb + 1)) {
            int ln = lane; asm volatile("" : "+v"(ln));
            for (int r = gw; r < M + DB * PAST; r += NGW) { if (r < M) pb_token_row(a, l, r, ln); else pb_cache_row(a, l, r - M, ln); }
            SEAM(pb + 1);
        }
        if (IN(pb + 2)) {
            { int tn = tid; asm volatile("" : "+v"(tn)); for (int j = blockIdx.x; j < 36; j += G) scan_job(ws, (LAS float*)(lds + RING_OFF), j, tn, wave, tn & 63); }
            { pg8::Gemm g{(const bf16*)(ws + WS_CQ), (const bf16*)(wl + WO_UQ), M, NQC, 512}; pg8::StaticOrder S; S.init(M, NQC, G, (int)blockIdx.x);
              pg8::EpiPlain E{(bf16*)(ws + WS_QCR), NQC};
              pg8::gemm_phase<pg8::EpiPlain, pg8::StaticOrder, true, true>(lds + RING_OFF, g, S, E); }
            __syncthreads();
            { pg8::Gemm g{(const bf16*)(ws + WS_CKVN), (const bf16*)(wl + WO_UKV), NKR, NKV, 256}; pg8::StaticOrder S; S.init(NKR, NKV, G, (int)blockIdx.x);
              pg8::EpiPlain E{(bf16*)(ws + WS_KVR), NKV};
              pg8::gemm_phase<pg8::EpiPlain, pg8::StaticOrder, true, true>(lds + RING_OFF, g, S, E); }
            SEAM(pb + 2);
        }
        if (IN(pb + 3)) {
            int ln = lane; asm volatile("" : "+v"(ln));
            for (int r = gw; r < M + NKR; r += NGW) { if (r < M) pd_q_row(a, l, r, ln); else pd_k_row(a, l, r - M, ln); }
            SEAM(pb + 3);
        }
        if (IN(pb + 4)) {
            gu32* head = ctl + CW_AQ + 64 * l;
            for (;;) {
                if (tid == 0) MISC[12] = __hip_atomic_fetch_add(head, 1u, RLX_AGENT);
                __syncthreads();
                const int u = (int)MISC[12];
                __syncthreads();
                if (u >= att::NU) break;
                att::UnitDesc U; int type;
                if (u < att::NU_PROMPT) { const int k = u >> 8, v = u & 255; type = k == 0 ? 2 : k == 1 ? 0 : 1;
                    U.h = v & 3; const int qb = 63 - (v >> 2); U.qrow0 = qb * 256; U.nq = 256; U.krow0 = 0; U.qpos0 = qb * 256; U.nkeys = SEQ; }
                else { const int v = u - att::NU_PROMPT; const int k = v >> 5, b = (v & 31) >> 2; type = k == 0 ? 2 : k == 1 ? 0 : 1;
                    U.h = v & 3; U.qrow0 = SEQ + b * DS; U.nq = DS; U.krow0 = SEQ + b * SKEYS; U.qpos0 = PAST; U.nkeys = SKEYS; }
                if (type == 2) att::attn_unit<2>(lds + RING_OFF, ws, U);
                else if (type == 0) att::attn_unit<0>(lds + RING_OFF, ws, U);
                else att::attn_unit<1>(lds + RING_OFF, ws, U);
            }
            SEAM(pb + 4);
        }
        if (IN(pb + 5)) {
            int ln = lane; asm volatile("" : "+v"(ln));
            for (int r = gw; r < M; r += NGW) pf_row(a, l, r, ln);
            SEAM(pb + 5);
        }
        if (IN(pb + 6)) {
            pg8::Gemm g{(const bf16*)(ws + WS_MIX), (const bf16*)(wl + WO_OUT), M, DM, MIXW}; pg8::StaticOrder S; S.init(M, DM, G, (int)blockIdx.x);
            pg8::EpiResid E{l == 0 ? a.in[I_XP] : a.out + O_Y, l == 0 ? a.in[I_XS] : a.out + O_Y, l == 0 ? SEQ : M, a.out + O_Y, (bf16*)(ws + WS_XN), a.in[I_NFFN] + l * DM, (float*)(ws + WS_RSS), DM};
            pg8::gemm_phase<pg8::EpiResid, pg8::StaticOrder, true, true>(lds + RING_OFF, g, S, E);
            SEAM(pb + 6);
        }
        if (IN(pb + 7)) {
            pg8::Gemm g{(const bf16*)(ws + WS_XN), (const bf16*)(wl + WO_GU), M, 2 * DFF, DM}; pg8::StaticOrder S; S.init(M, 2 * DFF, G, (int)blockIdx.x);
            pg8::EpiSwiGlu E{(bf16*)(ws + WS_H), DFF, (const float*)(ws + WS_RSS), 1.f / DM};
            pg8::gemm_phase<pg8::EpiSwiGlu, pg8::StaticOrder, true, true>(lds + RING_OFF, g, S, E);
            SEAM(pb + 7);
        }
        if (IN(pb + 8)) {
            pg8::Gemm g{(const bf16*)(ws + WS_H), (const bf16*)(wl + WO_DOWN), M, DM, DFF}; pg8::StaticOrder S; S.init(M, DM, G, (int)blockIdx.x);
            pg8::EpiResid E{a.out + O_Y, a.out + O_Y, M, a.out + O_Y, (bf16*)(ws + WS_XN), a.in[I_NMIX] + (l + 1 < DEPTH ? l + 1 : l) * DM, (float*)(ws + WS_RSS), DM};
            pg8::gemm_phase<pg8::EpiResid, pg8::StaticOrder, true, true>(lds + RING_OFF, g, S, E);
            SEAM(pb + 8);
        }
    }
#undef IN
#undef SEAM
}

extern "C" void kernel_launch(void* const* d_in, const int* in_sizes, int n_in, void* d_out, int out_size, void* d_ws, size_t ws_size, hipStream_t stream) {
    static int grid = 0;
    if (grid == 0) {
        if (n_in != N_INPUTS || (size_t)out_size != O_END || ws_size < WS_END) { fprintf(stderr, "kernel_launch: unexpected shapes (n_in %d, out %d, ws %zu; need ws >= %zu)\n", n_in, out_size, ws_size, (size_t)WS_END); grid = -1; return; }
        int dev = 0, cus = 0, per_cu = 0;
        if (hipGetDevice(&dev) != hipSuccess || hipDeviceGetAttribute(&cus, hipDeviceAttributeMultiprocessorCount, dev) != hipSuccess) { grid = -1; return; }
        if (hipFuncSetAttribute((const void*)trunk_fwd, hipFuncAttributeMaxDynamicSharedMemorySize, LDS_BYTES) != hipSuccess) { fprintf(stderr, "kernel_launch: hipFuncSetAttribute failed\n"); grid = -1; return; }
        if (hipOccupancyMaxActiveBlocksPerMultiprocessor(&per_cu, (const void*)trunk_fwd, NWAVES * 64, LDS_BYTES) != hipSuccess || per_cu < 1) { fprintf(stderr, "kernel_launch: occupancy query says %d blocks per CU\n", per_cu); }
        (void)hipGetLastError();
        grid = cus;
    }
    if (grid < 0) return;
    (void)in_sizes;
    if (hipMemsetAsync((char*)d_ws + WS_CTL, 0, CTL_ZERO_BYTES, stream) != hipSuccess) { fprintf(stderr, "kernel_launch: memset failed\n"); return; }
    KArgs a{};
    for (int i = 0; i < N_INPUTS; ++i) a.in[i] = (const float*)d_in[i];
    a.out = (float*)d_out; a.ws = (unsigned char*)d_ws;
#if MK_ONE_LAUNCH
    a.ph_lo = 0; a.ph_hi = NPH;
    hipLaunchKernelGGL(trunk_fwd, dim3(grid), dim3(NWAVES * 64), LDS_BYTES, stream, a);
#else
    for (int p = 0; p < NPH; ++p) { a.ph_lo = p; a.ph_hi = p + 1; hipLaunchKernelGGL(trunk_fwd, dim3(grid), dim3(NWAVES * 64), LDS_BYTES, stream, a); }
#endif
    const hipError_t le = hipPeekAtLastError();
    if (le != hipSuccess) fprintf(stderr, "kernel_launch: launch failed: %s\n", hipGetErrorName(le));
}
```

```cpp
#include <hip/hip_runtime.h>
#include <cstdio>
#include <cstdint>
#ifndef CONV_IN_E
#define CONV_IN_E 1
#endif
#ifndef PROBE_DUP_E
#define PROBE_DUP_E 0
#endif
#ifndef PROBE_DUP_H
#define PROBE_DUP_H 0
#endif
#ifndef USE_THIN
#define USE_THIN 1
#endif
#ifndef PROBE_DUP_ROW
#define PROBE_DUP_ROW 0
#endif
#ifndef PROBE_DUP_C
#define PROBE_DUP_C 0
#endif
#ifndef WGM_A
#define WGM_A 4
#endif
#ifndef WGM_G
#define WGM_G 4
#endif
#ifndef WGM_H
#define WGM_H 4
#endif
#ifndef WGM_I
#define WGM_I 4
#endif
#ifndef WGM_C
#define WGM_C 4
#endif
#ifndef ATT_LAG
#define ATT_LAG 0
#endif
#ifndef FOLD_QC
#define FOLD_QC 1
#endif
#ifndef FOLD_KC
#define FOLD_KC 1
#endif
#ifndef FUSE_B
#define FUSE_B 1
#endif
#ifndef ATT_NEGM
#define ATT_NEGM 1
#endif
#ifndef ATT_PIPE
#define ATT_PIPE 0
#endif
#ifndef MK_ONE_LAUNCH
#define MK_ONE_LAUNCH 1
#endif
__device__ __forceinline__ int fresh_lane() { int l_; asm volatile("v_mbcnt_lo_u32_b32 %0, -1, 0\n\tv_mbcnt_hi_u32_b32 %0, -1, %0" : "=v"(l_)); return l_; }
namespace pg8 {
#define PG8_LAS __attribute__((address_space(3)))
typedef unsigned short bf16_t;
typedef short bf16x8 __attribute__((ext_vector_type(8)));
typedef float f32x4 __attribute__((ext_vector_type(4)));
typedef unsigned u32x4 __attribute__((ext_vector_type(4)));
constexpr int BM = 256, BK = 64, HALF = 128, HTB = HALF * BK * 2  , STAGE_BYTES = 8 * HTB, NXCD = 8;

__host__ __device__ __forceinline__ int lds_byte(int r, int c) { const int st = (r >> 4) * 2 + (c >> 5), rr = r & 15, cc = c & 31, ob = rr * 64 + cc * 2; return st * 1024 + (ob ^ (((ob >> 9) & 1) << 5)); }
__host__ __device__ __forceinline__ void stage_rc(int b, int& R, int& C) { const int st = b / 1024, sb = b % 1024, swz = sb ^ (((sb >> 9) & 1) << 5); R = (st >> 1) * 16 + swz / 64; C = (st & 1) * 32 + (swz % 64) / 2; }
__host__ __device__ __forceinline__ int perm32(int rho) { const int n = rho >> 4, i = rho & 15; return 8 * (i >> 2) + 4 * n + (i & 3); }

struct Unit { int pm, pn; };
struct Gemm { const bf16_t* A; const bf16_t* Bt; int M, N, K, lda, ldb; };

struct StaticOrder {
    int nM, nN, nwg, G, c, WGM;
    __host__ __device__ void init(int M, int N, int G_, int c_, int wgm = 4) { nM = M / BM; nN = N / BM; nwg = nM * nN; G = G_; c = c_; WGM = wgm; }
    __host__ __device__ bool next(int i, Unit& u) const {
        const long L = (long)i * G + c; if (L >= nwg) return false;
        int wgid = (int)L; { const int q = nwg / NXCD, r = nwg % NXCD, xcd = wgid % NXCD, off = wgid / NXCD; wgid = (xcd < r ? xcd * (q + 1) : r * (q + 1) + (xcd - r) * q) + off; }
        const int nig = WGM * nN, gid = wgid / nig, fm = gid * WGM, gsz = (nM - fm) < WGM ? (nM - fm) : WGM;
        u.pm = fm + ((wgid % nig) % gsz); u.pn = (wgid % nig) / gsz; return true;
    }
    __device__ __forceinline__ void a_ready(const Unit&) const {}
    __device__ __forceinline__ void done(const Unit&) const {}
};

__device__ __forceinline__ unsigned cvt_pk_bf16(float lo, float hi) { unsigned r; asm volatile("v_cvt_pk_bf16_f32 %0, %1, %2" : "=v"(r) : "v"(lo), "v"(hi)); return r; }
typedef float f32x2 __attribute__((ext_vector_type(2)));

constexpr float RMS_EPS = 1e-6f;
__device__ __forceinline__ float row_rstd(const float* rowss, int row, int fq, float inv_n) {
    const f32x4 a = *(const f32x4*)(rowss + (size_t)row * 32 + fq * 8), b = *(const f32x4*)(rowss + (size_t)row * 32 + fq * 8 + 4);
    float s = ((a[0] + a[1]) + (a[2] + a[3])) + ((b[0] + b[1]) + (b[2] + b[3]));
    s += __shfl_xor(s, 16); s += __shfl_xor(s, 32);
    return 1.0f / sqrtf(s * inv_n + RMS_EPS);
}
__device__ __forceinline__ void rstd_rows(float (&rsv)[2][4], const float* rowss, int row0, int fr, int fq, float inv_n, PG8_LAS float* tab, unsigned want, int wid) {
    PG8_LAS float* tb = tab + wid * 128; volatile PG8_LAS unsigned* tg = (volatile PG8_LAS unsigned*)(tab + 1024) + wid;
    if ((unsigned)__builtin_amdgcn_readfirstlane((int)*tg) == want) {
#pragma unroll
        for (int ai = 0; ai < 2; ++ai)
#pragma unroll
            for (int m = 0; m < 4; ++m) rsv[ai][m] = tb[ai * 64 + m * 16 + fr];
    } else {
#pragma unroll
        for (int ai = 0; ai < 2; ++ai)
#pragma unroll
            for (int m = 0; m < 4; ++m) { rsv[ai][m] = row_rstd(rowss, row0 + ai * HALF + m * 16, fq, inv_n); tb[ai * 64 + m * 16 + fr] = rsv[ai][m]; }
        *tg = want;
    }
}
__device__ __forceinline__ void unperm_sw(float& a, float& b) {
    asm volatile("s_nop 1\n\tv_permlane16_swap_b32 %0, %1\n\ts_nop 1\n\tv_permlane32_swap_b32 %0, %1" : "+v"(a), "+v"(b)); }
__device__ __forceinline__ void unperm8(f32x4& x, f32x4& y) {
    float a0 = x[0], a1 = x[1], a2 = x[2], a3 = x[3], b0 = y[0], b1 = y[1], b2 = y[2], b3 = y[3];
    unperm_sw(a0, b0); unperm_sw(a1, b1); unperm_sw(a2, b2); unperm_sw(a3, b3);
    x = (f32x4){a0, a1, a2, a3}; y = (f32x4){b0, b1, b2, b3};
}
struct EpiPlain {
    static constexpr bool PERM = true, AFTER_DRAIN = false, WIDE = false;
    bf16_t* O; int ldc;
    __device__ __forceinline__ void operator()(const f32x4 (&acc)[2][2][4][2], const Unit& u, int wr, int wc, int fr, int fq) const {
        const int row0 = u.pm * BM + wr * 64 + fr, col0 = u.pn * BM + wc * 32 + 8 * fq;
#pragma unroll
        for (int ai = 0; ai < 2; ++ai)
#pragma unroll
            for (int m = 0; m < 4; ++m) { bf16_t* rowp = O + (size_t)(row0 + ai * HALF + m * 16) * ldc + col0;
#pragma unroll
                for (int bj = 0; bj < 2; ++bj) { const f32x4 v0 = acc[ai][bj][m][0], v1 = acc[ai][bj][m][1];
                    u32x4 w; w.x = cvt_pk_bf16(v0[0], v0[1]); w.y = cvt_pk_bf16(v0[2], v0[3]); w.z = cvt_pk_bf16(v1[0], v1[1]); w.w = cvt_pk_bf16(v1[2], v1[3]);
                    *(u32x4*)(rowp + bj * HALF) = w; } }
    }
};
struct EpiScaled {
    static constexpr bool PERM = true, AFTER_DRAIN = false, WIDE = false;
    bf16_t* O; int ldc; const float* rowss; float inv_n;
    __device__ __forceinline__ void operator()(const f32x4 (&acc)[2][2][4][2], const Unit& u, int wr, int wc, int fr, int fq) const {
        const int row0 = u.pm * BM + wr * 64 + fr, col0 = u.pn * BM + wc * 32 + 8 * fq;
        float rsv[2][4];
#pragma unroll
        for (int ai = 0; ai < 2; ++ai)
#pragma unroll
            for (int m = 0; m < 4; ++m) rsv[ai][m] = row_rstd(rowss, row0 + ai * HALF + m * 16, fq, inv_n);
#pragma unroll
        for (int ai = 0; ai < 2; ++ai)
#pragma unroll
            for (int m = 0; m < 4; ++m) { const int row = row0 + ai * HALF + m * 16; const float rs = rsv[ai][m];
                bf16_t* rowp = O + (size_t)row * ldc + col0;
#pragma unroll
                for (int bj = 0; bj < 2; ++bj) { const f32x4 v0 = acc[ai][bj][m][0] * rs, v1 = acc[ai][bj][m][1] * rs;
                    u32x4 w; w.x = cvt_pk_bf16(v0[0], v0[1]); w.y = cvt_pk_bf16(v0[2], v0[3]); w.z = cvt_pk_bf16(v1[0], v1[1]); w.w = cvt_pk_bf16(v1[2], v1[3]);
                    *(u32x4*)(rowp + bj * HALF) = w; } }
    }
};
__device__ __forceinline__ void ld8(const float* p, float* x) { const f32x4 a = *(const f32x4*)p, b = *(const f32x4*)(p + 4); x[0] = a[0]; x[1] = a[1]; x[2] = a[2]; x[3] = a[3]; x[4] = b[0]; x[5] = b[1]; x[6] = b[2]; x[7] = b[3]; }
__device__ __forceinline__ float logsig(float v) { return fminf(v, 0.f) - log1pf(__expf(-fabsf(v))); }
struct EpiProj {
    static constexpr bool PERM = true, AFTER_DRAIN = false, WIDE = false;
    bf16_t* O; int ldc; const float* rowss; float inv_n;
    float* o_fv; float* o_sk; float* o_sv; bf16_t* VA; bf16_t* QB; bf16_t* KB; bf16_t* VB; unsigned* kslice; float qs_b;
    int fuse; float* o_fk; float* o_ck; float* o_kr; float* o_fl; bf16_t* QA; bf16_t* KA; bf16_t* CQ; bf16_t* CKVN; float* KROPE; float* LOGF; float* KRSS; float* CQSS;
    const float* gq; const float* gk; const float* gqa; const float* gkv; const float* fbias; PG8_LAS float* xch; unsigned* kslice_a; float qs_a; int ldcq, ldckv; PG8_LAS float* rstab; unsigned tag;
    __device__ __forceinline__ void operator()(const f32x4 (&acc)[2][2][4][2], const Unit& u, int wr, int wc, int fr, int fq) const {
        const int row0 = u.pm * BM + wr * 64 + fr, col0 = u.pn * BM + wc * 32 + 8 * fq;
        float rsv[2][4];
        rstd_rows(rsv, rowss, row0, fr, fq, inv_n, rstab, tag | (unsigned)(u.pm + 1), wr * 4 + wc);
        const int kind = (u.pn >= 4 && u.pn < 12) ? ((u.pn - 4) >> 1) + 1 : 0;
        if (kind == 0 && fuse) {
            if (u.pn < 2) norm_tiles<5>(acc, u, rsv, wr, wc); else if (u.pn < 4) norm_tiles<6>(acc, u, rsv, wr, wc);
            else if (u.pn < 14) cq_tiles(acc, u, rsv, wr, wc); else if (u.pn == 14) norm_tiles<7>(acc, u, rsv, wr, wc); else norm_tiles<8>(acc, u, rsv, wr, wc);
        } else if (kind == 0) {
#pragma unroll
            for (int ai = 0; ai < 2; ++ai)
#pragma unroll
                for (int m = 0; m < 4; ++m) { const int row = row0 + ai * HALF + m * 16; const float rs = rsv[ai][m];
                    bf16_t* rowp = O + (size_t)row * ldc + col0;
#pragma unroll
                    for (int bj = 0; bj < 2; ++bj) { const f32x4 v0 = acc[ai][bj][m][0] * rs, v1 = acc[ai][bj][m][1] * rs;
                        u32x4 w; w.x = cvt_pk_bf16(v0[0], v0[1]); w.y = cvt_pk_bf16(v0[2], v0[3]); w.z = cvt_pk_bf16(v1[0], v1[1]); w.w = cvt_pk_bf16(v1[2], v1[3]);
                        *(u32x4*)(rowp + bj * HALF) = w; } }
        } else if (kind == 1) copy_tiles<1>(acc, u, rsv, row0, wc, fq, fr, o_fv, VA, 1.f);
        else if (kind == 2) copy_tiles<2>(acc, u, rsv, row0, wc, fq, fr, nullptr, QB, qs_b);
        else if (kind == 3) copy_tiles<3>(acc, u, rsv, row0, wc, fq, fr, o_sk, KB, 1.f);
        else copy_tiles<4>(acc, u, rsv, row0, wc, fq, fr, o_sv, VB, 1.f);
    }
    template <int KIND> __device__ __forceinline__ void norm_tiles(const f32x4 (&acc)[2][2][4][2], const Unit& u, const float (&rsv)[2][4], int wr, int wc) const {
        const int ln_ = fresh_lane(), fr = ln_ & 15, fq = ln_ >> 4, rl0 = wr * 64 + fr, row0 = u.pm * BM + rl0, c8 = wc * 32 + 8 * fq;
#pragma unroll
        for (int ai = 0; ai < 2; ++ai)
#pragma unroll
            for (int m = 0; m < 4; ++m) { const float rs = rsv[ai][m];
#pragma unroll
                for (int bj = 0; bj < 2; ++bj) { const f32x4 a0 = acc[ai][bj][m][0] * rs, a1 = acc[ai][bj][m][1] * rs;
                    float p_ = ((a0[0] * a0[0] + a0[1] * a0[1]) + (a0[2] * a0[2] + a0[3] * a0[3])) + ((a1[0] * a1[0] + a1[1] * a1[1]) + (a1[2] * a1[2] + a1[3] * a1[3]));
                    if (KIND == 8 && (bj != 0 || wc >= 2)) p_ = 0.f;
                    p_ += __shfl_xor(p_, 16); p_ += __shfl_xor(p_, 32);
                    if (fq == 0) xch[((ai * HALF + rl0 + m * 16) * 2 + bj) * 4 + wc] = p_; } }
        float g0[8], g1[8];
        if (KIND == 5) { ld8(gq + c8, g0); } else if (KIND == 6) { ld8(gk + c8, g0); } else if (KIND == 7) { ld8(gkv + c8, g0); ld8(gkv + HALF + c8, g1); }
        f32x4 fb = {0.f, 0.f, 0.f, 0.f}; if (KIND == 8) fb = *(const f32x4*)fbias;
        asm volatile("s_waitcnt lgkmcnt(0)\n\ts_barrier" ::: "memory");
        float kmx0 = 0.f, kmx1 = 0.f;
#pragma unroll
        for (int ai = 0; ai < 2; ++ai)
#pragma unroll
            for (int m = 0; m < 4; ++m) { const int row = row0 + ai * HALF + m * 16; const float rs = rsv[ai][m];
                const f32x4 q0 = *(const PG8_LAS f32x4*)(xch + ((ai * HALF + rl0 + m * 16) * 2 + 0) * 4), q1 = *(const PG8_LAS f32x4*)(xch + ((ai * HALF + rl0 + m * 16) * 2 + 1) * 4);
                const float s0 = (q0[0] + q0[1]) + (q0[2] + q0[3]), s1 = (q1[0] + q1[1]) + (q1[2] + q1[3]);
                if (KIND == 5 || KIND == 6) {
#pragma unroll
                    for (int bj = 0; bj < 2; ++bj) { const float rn = rs / sqrtf((bj == 0 ? s0 : s1) * (1.f / 128.f) + RMS_EPS) * (KIND == 5 ? qs_a : 1.f);
                        const f32x4 a0 = acc[ai][bj][m][0] * rn, a1 = acc[ai][bj][m][1] * rn;
                        const f32x4 y0 = {a0[0] * g0[0], a0[1] * g0[1], a0[2] * g0[2], a0[3] * g0[3]}, y1 = {a1[0] * g0[4], a1[1] * g0[5], a1[2] * g0[6], a1[3] * g0[7]};
                        const size_t off = (size_t)row * 512 + (u.pn & 1) * BM + bj * HALF + c8;
                        u32x4 w; w.x = cvt_pk_bf16(y0[0], y0[1]); w.y = cvt_pk_bf16(y0[2], y0[3]); w.z = cvt_pk_bf16(y1[0], y1[1]); w.w = cvt_pk_bf16(y1[2], y1[3]);
                        if (KIND == 5) *(u32x4*)(QA + off) = w;
                        else { *(u32x4*)(KA + off) = w; { f32x4 x = y0, y = y1; unperm8(x, y); float* p = o_fk + (off - 4 * fq); __builtin_nontemporal_store(x, (f32x4*)p); __builtin_nontemporal_store(y, (f32x4*)(p + 16)); }
                            float p_ = ((y0[0] * y0[0] + y0[1] * y0[1]) + (y0[2] * y0[2] + y0[3] * y0[3])) + ((y1[0] * y1[0] + y1[1] * y1[1]) + (y1[2] * y1[2] + y1[3] * y1[3]));
                            p_ += __shfl_xor(p_, 16); p_ += __shfl_xor(p_, 32); if (bj == 0) kmx0 = fmaxf(kmx0, p_); else kmx1 = fmaxf(kmx1, p_); } }
                } else if (KIND == 7) { const float rn = rs / sqrtf((s0 + s1) * (1.f / 256.f) + RMS_EPS);
#pragma unroll
                    for (int bj = 0; bj < 2; ++bj) { const f32x4 a0 = acc[ai][bj][m][0] * rn, a1 = acc[ai][bj][m][1] * rn;
                        const f32x4 y0 = bj == 0 ? (f32x4){a0[0] * g0[0], a0[1] * g0[1], a0[2] * g0[2], a0[3] * g0[3]} : (f32x4){a0[0] * g1[0], a0[1] * g1[1], a0[2] * g1[2], a0[3] * g1[3]};
                        const f32x4 y1 = bj == 0 ? (f32x4){a1[0] * g0[4], a1[1] * g0[5], a1[2] * g0[6], a1[3] * g0[7]} : (f32x4){a1[0] * g1[4], a1[1] * g1[5], a1[2] * g1[6], a1[3] * g1[7]};
                        const int cc = bj * HALF + c8;
                        { f32x4 x = y0, y = y1; unperm8(x, y); float* p = o_ck + (size_t)row * 256 + (cc - 4 * fq); __builtin_nontemporal_store(x, (f32x4*)p); __builtin_nontemporal_store(y, (f32x4*)(p + 16)); }
                        u32x4 w; w.x = cvt_pk_bf16(y0[0], y0[1]); w.y = cvt_pk_bf16(y0[2], y0[3]); w.z = cvt_pk_bf16(y1[0], y1[1]); w.w = cvt_pk_bf16(y1[2], y1[3]);
                        *(u32x4*)(CKVN + (size_t)row * ldckv + cc) = w; }
                } else {
                    const f32x4 a0 = acc[ai][0][m][0] * rs, a1 = acc[ai][0][m][1] * rs;
                    if (wc < 2) { __builtin_nontemporal_store(a0, (f32x4*)(o_kr + (size_t)row * 64 + c8)); __builtin_nontemporal_store(a1, (f32x4*)(o_kr + (size_t)row * 64 + c8 + 4));
                        *(f32x4*)(KROPE + (size_t)row * 64 + c8) = a0; *(f32x4*)(KROPE + (size_t)row * 64 + c8 + 4) = a1;
                        if (wc == 0 && fq == 0) KRSS[row] = s0; }
                    else if (wc == 2 && fq == 0) { const f32x4 lf = {logsig(a0[0] + fb[0]), logsig(a0[1] + fb[1]), logsig(a0[2] + fb[2]), logsig(a0[3] + fb[3])};
                        __builtin_nontemporal_store(lf, (f32x4*)(o_fl + (size_t)row * 4)); *(f32x4*)(LOGF + (size_t)row * 4) = lf; } } }
        if (KIND == 6) {
#pragma unroll
            for (int bj = 0; bj < 2; ++bj) { float mx = bj == 0 ? kmx0 : kmx1;
#pragma unroll
                for (int o_ = 1; o_ < 16; o_ <<= 1) mx = fmaxf(mx, __shfl_xor(mx, o_));
                if (fr == 0 && fq == 0) __hip_atomic_fetch_max(kslice_a + (((u.pn - 2) * 2 + bj) * 4 + wc), __float_as_uint(mx * 1.02f), __ATOMIC_RELAXED, __HIP_MEMORY_SCOPE_AGENT); } }
    }
    __device__ __forceinline__ void cq_tiles(const f32x4 (&acc)[2][2][4][2], const Unit& u, const float (&rsv)[2][4], int wr, int wc) const {
        const int ln_ = fresh_lane(), fr = ln_ & 15, fq = ln_ >> 4, row0 = u.pm * BM + wr * 64 + fr, c8 = wc * 32 + 8 * fq;
        float g0[8], g1[8]; ld8(gqa + (u.pn - 12) * BM + c8, g0); ld8(gqa + (u.pn - 12) * BM + HALF + c8, g1);
#pragma unroll
        for (int ai = 0; ai < 2; ++ai)
#pragma unroll
            for (int m = 0; m < 4; ++m) { const int row = row0 + ai * HALF + m * 16; const float rs = rsv[ai][m];
#pragma unroll
                for (int bj = 0; bj < 2; ++bj) { const f32x4 a0 = acc[ai][bj][m][0] * rs, a1 = acc[ai][bj][m][1] * rs;
                    float p_ = ((a0[0] * a0[0] + a0[1] * a0[1]) + (a0[2] * a0[2] + a0[3] * a0[3])) + ((a1[0] * a1[0] + a1[1] * a1[1]) + (a1[2] * a1[2] + a1[3] * a1[3]));
                    p_ += __shfl_xor(p_, 16); p_ += __shfl_xor(p_, 32);
                    if (fq == 0) CQSS[(size_t)row * 16 + (u.pn - 12) * 8 + bj * 4 + wc] = p_;
                    u32x4 w;
                    if (bj == 0) { w.x = cvt_pk_bf16(a0[0] * g0[0], a0[1] * g0[1]); w.y = cvt_pk_bf16(a0[2] * g0[2], a0[3] * g0[3]); w.z = cvt_pk_bf16(a1[0] * g0[4], a1[1] * g0[5]); w.w = cvt_pk_bf16(a1[2] * g0[6], a1[3] * g0[7]); }
                    else { w.x = cvt_pk_bf16(a0[0] * g1[0], a0[1] * g1[1]); w.y = cvt_pk_bf16(a0[2] * g1[2], a0[3] * g1[3]); w.z = cvt_pk_bf16(a1[0] * g1[4], a1[1] * g1[5]); w.w = cvt_pk_bf16(a1[2] * g1[6], a1[3] * g1[7]); }
                    *(u32x4*)(CQ + (size_t)row * ldcq + (u.pn - 12) * BM + bj * HALF + c8) = w; } }
    }
    template <int KIND> __device__ __forceinline__ void copy_tiles(const f32x4 (&acc)[2][2][4][2], const Unit& u, const float (&rsv)[2][4], int row0, int wc, int fq, int fr, float* of, bf16_t* ob, float sc) const {
        const int dcol0 = ((u.pn - 4) & 1) * BM + wc * 32 + 8 * fq;
        float kmx0 = 0.f, kmx1 = 0.f;
#pragma unroll
        for (int ai = 0; ai < 2; ++ai)
#pragma unroll
            for (int m = 0; m < 4; ++m) { const int row = row0 + ai * HALF + m * 16; const float rs = rsv[ai][m] * sc;
#pragma unroll
                for (int bj = 0; bj < 2; ++bj) { const f32x4 v0 = acc[ai][bj][m][0] * rs, v1 = acc[ai][bj][m][1] * rs; const size_t off = (size_t)row * 512 + dcol0 + bj * HALF;
                    if (KIND != 2) { f32x4 x = v0, y = v1; unperm8(x, y); float* p = of + (off - 4 * fq); __builtin_nontemporal_store(x, (f32x4*)p); __builtin_nontemporal_store(y, (f32x4*)(p + 16)); }
                    u32x4 w; w.x = cvt_pk_bf16(v0[0], v0[1]); w.y = cvt_pk_bf16(v0[2], v0[3]); w.z = cvt_pk_bf16(v1[0], v1[1]); w.w = cvt_pk_bf16(v1[2], v1[3]);
                    *(u32x4*)(ob + off) = w;
                    if (KIND == 3) { float p_ = ((v0[0] * v0[0] + v0[1] * v0[1]) + (v0[2] * v0[2] + v0[3] * v0[3])) + ((v1[0] * v1[0] + v1[1] * v1[1]) + (v1[2] * v1[2] + v1[3] * v1[3]));
                        p_ += __shfl_xor(p_, 16); p_ += __shfl_xor(p_, 32); if (bj == 0) kmx0 = fmaxf(kmx0, p_); else kmx1 = fmaxf(kmx1, p_); } } }
        if (KIND == 3) {
#pragma unroll
            for (int bj = 0; bj < 2; ++bj) { float mx = bj == 0 ? kmx0 : kmx1;
#pragma unroll
                for (int o_ = 1; o_ < 16; o_ <<= 1) mx = fmaxf(mx, __shfl_xor(mx, o_));
                if (fr == 0 && fq == 0) __hip_atomic_fetch_max(kslice + (((u.pn - 8) * 2 + bj) * 4 + wc), __float_as_uint(mx * 1.02f), __ATOMIC_RELAXED, __HIP_MEMORY_SCOPE_AGENT); } }
    }
};
struct EpiKV {
    static constexpr bool PERM = true, AFTER_DRAIN = false, WIDE = false;
    bf16_t* KC; bf16_t* KVR; const float* krss; const float* krope; const float* rope; const float* gk; PG8_LAS float* xch; int seq, skeys;
    __device__ __forceinline__ void operator()(const f32x4 (&acc)[2][2][4][2], const Unit& u, int wr, int wc, int fr_, int fq_) const {
        typedef float f32x2v __attribute__((ext_vector_type(2)));
        const int ln_ = fresh_lane(), fr = ln_ & 15, fq = ln_ >> 4; (void)fr_; (void)fq_;
        const int rl0 = wr * 64 + fr, row0 = u.pm * BM + rl0, h = u.pn, c8 = wc * 32 + 8 * fq, j0 = 2 * (wc * 4 + fq);
#pragma unroll
        for (int ai = 0; ai < 2; ++ai)
#pragma unroll
            for (int m = 0; m < 4; ++m) { const f32x4 a0 = acc[ai][0][m][0], a1 = acc[ai][0][m][1];
                float p_ = ((a0[0] * a0[0] + a0[1] * a0[1]) + (a0[2] * a0[2] + a0[3] * a0[3])) + ((a1[0] * a1[0] + a1[1] * a1[1]) + (a1[2] * a1[2] + a1[3] * a1[3]));
                p_ += __shfl_xor(p_, 16); p_ += __shfl_xor(p_, 32);
                if (fq == 0) xch[(ai * HALF + rl0 + m * 16) * 4 + wc] = p_; }
        float gn[8]; { const f32x4 t0 = *(const f32x4*)(gk + c8), t1 = *(const f32x4*)(gk + c8 + 4); gn[0] = t0[0]; gn[1] = t0[1]; gn[2] = t0[2]; gn[3] = t0[3]; gn[4] = t1[0]; gn[5] = t1[1]; gn[6] = t1[2]; gn[7] = t1[3]; }
        const f32x2v g1 = *(const f32x2v*)(gk + 128 + j0), g2 = *(const f32x2v*)(gk + 160 + j0);
        float kq[4]; f32x2v kr1[4], kr2[4]; f32x4 cs[4];
#define KV_LOADS(ai_) do { _Pragma("unroll") for (int m = 0; m < 4; ++m) { const int row = row0 + (ai_) * HALF + m * 16; const int pos = row < seq ? row : (row - seq) % skeys; \
            kq[m] = krss[row]; kr1[m] = *(const f32x2v*)(krope + (size_t)row * 64 + j0); kr2[m] = *(const f32x2v*)(krope + (size_t)row * 64 + 32 + j0); \
            cs[m] = *(const f32x4*)(rope + ((size_t)pos * 32 + j0) * 2); } } while (0)
        KV_LOADS(0);
        asm volatile("s_waitcnt lgkmcnt(0)\n\ts_barrier" ::: "memory");
#pragma unroll
        for (int ai = 0; ai < 2; ++ai) {
            if (ai == 1) { KV_LOADS(1); asm volatile("" ::: "memory"); }
#pragma unroll
            for (int m = 0; m < 4; ++m) { const int row = row0 + ai * HALF + m * 16;
                const f32x4 pp = *(const PG8_LAS f32x4*)(xch + (ai * HALF + rl0 + m * 16) * 4);
                const float rs = 1.0f / sqrtf((((pp[0] + pp[1]) + (pp[2] + pp[3])) + kq[m]) * (1.f / 192.f) + RMS_EPS);
                { const f32x4 a0 = acc[ai][0][m][0] * rs, a1 = acc[ai][0][m][1] * rs;
                  u32x4 w; w.x = cvt_pk_bf16(a0[0] * gn[0], a0[1] * gn[1]); w.y = cvt_pk_bf16(a0[2] * gn[2], a0[3] * gn[3]); w.z = cvt_pk_bf16(a1[0] * gn[4], a1[1] * gn[5]); w.w = cvt_pk_bf16(a1[2] * gn[6], a1[3] * gn[7]);
                  *(u32x4*)(KC + (size_t)row * 768 + h * 192 + c8) = w; }
                { const f32x4 v0 = acc[ai][1][m][0], v1 = acc[ai][1][m][1];
                  u32x4 w; w.x = cvt_pk_bf16(v0[0], v0[1]); w.y = cvt_pk_bf16(v0[2], v0[3]); w.z = cvt_pk_bf16(v1[0], v1[1]); w.w = cvt_pk_bf16(v1[2], v1[3]);
                  *(u32x4*)(KVR + (size_t)row * 1024 + h * 256 + HALF + c8) = w; }
                { const float u1a = kr1[m].x * rs * g1.x, u2a = kr2[m].x * rs * g2.x, u1b = kr1[m].y * rs * g1.y, u2b = kr2[m].y * rs * g2.y; const f32x4 c = cs[m];
                  *(unsigned*)(KC + (size_t)row * 768 + h * 192 + 128 + j0) = cvt_pk_bf16(u1a * c[0] - u2a * c[1], u1b * c[2] - u2b * c[3]);
                  *(unsigned*)(KC + (size_t)row * 768 + h * 192 + 160 + j0) = cvt_pk_bf16(u2a * c[0] + u1a * c[1], u2b * c[2] + u1b * c[3]); } }
        }
#undef KV_LOADS
    }
};
__device__ __forceinline__ float silu_mul(float g, float u) { return g * u * __builtin_amdgcn_rcpf(1.0f + __builtin_amdgcn_exp2f(-1.4426950408889634f * g)); }
struct EpiSwiGlu {
    static constexpr bool PERM = true, AFTER_DRAIN = false, WIDE = false;
    bf16_t* O; int ldc; const float* rowss; float inv_n; PG8_LAS float* rstab; unsigned tag;
    __device__ __forceinline__ void operator()(const f32x4 (&acc)[2][2][4][2], const Unit& u, int wr, int wc, int fr, int fq) const {
        typedef float f32x2p __attribute__((ext_vector_type(2)));
        const int row0 = u.pm * BM + wr * 64 + fr, col0 = u.pn * HALF + wc * 32 + 8 * fq;
        float rsv[2][4];
        rstd_rows(rsv, rowss, row0, fr, fq, inv_n, rstab, tag | (unsigned)(u.pm + 1), wr * 4 + wc);
#pragma unroll
        for (int ai = 0; ai < 2; ++ai)
#pragma unroll
            for (int m = 0; m < 4; ++m) { const int row = row0 + ai * HALF + m * 16; const float rs = rsv[ai][m], c = -1.4426950408889634f * rs, rs2 = rs * rs;
                unsigned wv_[4];
#pragma unroll
                for (int n = 0; n < 2; ++n)
#pragma unroll
                    for (int h = 0; h < 2; ++h) { const f32x4 G = acc[ai][0][m][n], U = acc[ai][1][m][n];
                        const f32x2p g = {G[2 * h], G[2 * h + 1]}, up = {U[2 * h], U[2 * h + 1]};
                        const f32x2p t = g * c; f32x2p d = {__builtin_amdgcn_exp2f(t.x), __builtin_amdgcn_exp2f(t.y)}; d = d + 1.0f;
                        const f32x2p r = {__builtin_amdgcn_rcpf(d.x), __builtin_amdgcn_rcpf(d.y)}; const f32x2p o = ((g * up) * rs2) * r;
                        wv_[2 * n + h] = cvt_pk_bf16(o.x, o.y); }
                u32x4 w; w.x = wv_[0]; w.y = wv_[1]; w.z = wv_[2]; w.w = wv_[3];
                *(u32x4*)(O + (size_t)row * ldc + col0) = w; }
    }
};
struct EpiResid {
    static constexpr bool PERM = true, AFTER_DRAIN = false, WIDE = true;
    const float* xin32; float* xout32; bf16_t* yb; int ldy;
    float* rowss; int ldc;
    typedef float f32x2p __attribute__((ext_vector_type(2)));
    template <bool IN32> __device__ __forceinline__ void run(const f32x4 (&acc)[2][2][4][2], const Unit& u, int wr, int wc, int fr, int fq) const {
        constexpr int MB = IN32 ? 2 : 4;
        const int col0 = u.pn * BM + wc * 64 + 8 * fq;
#pragma unroll
        for (int ai = 0; ai < 2; ++ai)
#pragma unroll
        for (int mb = 0; mb < 4; mb += MB) {
            u32x4 xw[IN32 ? 1 : MB][2]; f32x4 xf[IN32 ? MB : 1][2][2];
#pragma unroll
            for (int mm = 0; mm < MB; ++mm) { const int row = u.pm * BM + ai * HALF + wr * 64 + (mb + mm) * 16 + fr;
#pragma unroll
                for (int bj = 0; bj < 2; ++bj) {
                    if constexpr (IN32) { const float* p = xin32 + (size_t)row * ldc + col0 + bj * 32; xf[mm][bj][0] = *(const f32x4*)p; xf[mm][bj][1] = *(const f32x4*)(p + 4); }
                    else xw[mm][bj] = *(const u32x4*)(yb + (size_t)row * ldy + col0 + bj * 32); } }
            asm volatile("" ::: "memory");
#pragma unroll
            for (int mm = 0; mm < MB; ++mm) { const int m = mb + mm, row = u.pm * BM + ai * HALF + wr * 64 + m * 16 + fr; f32x2p ss2 = {0.f, 0.f};
#pragma unroll
                for (int bj = 0; bj < 2; ++bj) { f32x2p xa, xb, xc, xd; const int col = col0 + bj * 32;
                    if constexpr (IN32) { const f32x4 t0 = xf[mm][bj][0], t1 = xf[mm][bj][1]; xa = (f32x2p){t0[0], t0[1]}; xb = (f32x2p){t0[2], t0[3]}; xc = (f32x2p){t1[0], t1[1]}; xd = (f32x2p){t1[2], t1[3]}; }
                    else { const u32x4 w = xw[mm][bj];
                        xa = (f32x2p){__uint_as_float(w.x << 16), __uint_as_float(w.x & 0xffff0000u)}; xb = (f32x2p){__uint_as_float(w.y << 16), __uint_as_float(w.y & 0xffff0000u)};
                        xc = (f32x2p){__uint_as_float(w.z << 16), __uint_as_float(w.z & 0xffff0000u)}; xd = (f32x2p){__uint_as_float(w.w << 16), __uint_as_float(w.w & 0xffff0000u)}; }
                    const f32x4 c0 = acc[ai][bj][m][0], c1 = acc[ai][bj][m][1];
                    xa += (f32x2p){c0[0], c0[1]}; xb += (f32x2p){c0[2], c0[3]}; xc += (f32x2p){c1[0], c1[1]}; xd += (f32x2p){c1[2], c1[3]};
                    if (xout32) { float* p = xout32 + (size_t)row * ldc + col; __builtin_nontemporal_store((f32x4){xa.x, xa.y, xb.x, xb.y}, (f32x4*)p); __builtin_nontemporal_store((f32x4){xc.x, xc.y, xd.x, xd.y}, (f32x4*)(p + 4)); }
                    else { u32x4 w; w.x = cvt_pk_bf16(xa.x, xa.y); w.y = cvt_pk_bf16(xb.x, xb.y); w.z = cvt_pk_bf16(xc.x, xc.y); w.w = cvt_pk_bf16(xd.x, xd.y); *(u32x4*)(yb + (size_t)row * ldy + col) = w; }
                    ss2 += xa * xa; ss2 += xb * xb; ss2 += xc * xc; ss2 += xd * xd;
                    }
                float ss = ss2.x + ss2.y;
                ss += __shfl_xor(ss, 16); ss += __shfl_xor(ss, 32);
                if (fq == 0) rowss[(size_t)row * 32 + u.pn * 4 + wc] = ss; }
        }
    }
    __device__ __forceinline__ void operator()(const f32x4 (&acc)[2][2][4][2], const Unit& u, int wr, int wc, int fr, int fq) const {
        if (xin32) run<true>(acc, u, wr, wc, fr, fq); else run<false>(acc, u, wr, wc, fr, fq);
    }
};
template <class Epi, class Sched, bool ALIGN_EPI = false, bool SP2 = false>
__device__ __forceinline__ void gemm_phase(PG8_LAS unsigned char* lds, const Gemm g, const Sched& S, const Epi& E, const int wid) {
    const int lane = fresh_lane(), tid = wid * 64 + lane, wr = wid >> 2, wc = wid & 3, fr = lane & 15, fq = lane >> 4;
    const int K = g.K, nt = K / BK;
    unsigned voffA[2], voffB[2];
#pragma unroll
    for (int i = 0; i < 2; ++i) { int R, C; stage_rc(tid * 16 + i * 8192, R, C); const int Rb = Epi::PERM ? ((Epi::WIDE ? 2 * (R & ~31) : (R & ~31)) + perm32(R & 31)) : R;
        voffA[i] = (unsigned)(R * g.lda + C) * 2u; voffB[i] = (unsigned)(Rb * g.ldb + C) * 2u; }
    const size_t kstep = (size_t)(BK * 2);
    const size_t hstepA = (size_t)HALF * g.lda * 2, hstepB = (size_t)(Epi::WIDE ? 32 : HALF) * g.ldb * 2;
    const size_t tstepA = 2 * hstepA, tstepB = (size_t)BM * g.ldb * 2;
    const unsigned ldsw = (unsigned)wid * 1024u;
    const int aoff = lds_byte(wr * 64 + fr, fq * 8), boff = lds_byte(wc * 32 + fr, fq * 8);
#define PG8_SA(b, h) (((b) * 2 + (h)) * HTB)
#define PG8_SB(b, h) ((4 + (b) * 2 + (h)) * HTB)
#define PG8_STAGE(bufoff, gbase, voff) do { _Pragma("unroll") for (int _i = 0; _i < 2; ++_i) \
        __builtin_amdgcn_global_load_lds((const unsigned*)((const char*)(gbase) + (voff)[_i]), (PG8_LAS unsigned*)(lds + (bufoff) + ldsw + _i * 8192), 16, 0, 0); } while (0)
#define PG8_LDA(dst, b, h) do { _Pragma("unroll") for (int m = 0; m < 4; ++m) _Pragma("unroll") for (int k = 0; k < 2; ++k) dst[m][k] = *(const PG8_LAS bf16x8*)(lds + PG8_SA(b, h) + aoff + m * 2048 + k * 1024); } while (0)
#define PG8_LDB(dst, b, h) do { _Pragma("unroll") for (int n = 0; n < 2; ++n) _Pragma("unroll") for (int k = 0; k < 2; ++k) dst[n][k] = *(const PG8_LAS bf16x8*)(lds + PG8_SB(b, h) + boff + n * 2048 + k * 1024); } while (0)
#define PG8_MMA(ai, bj, At, Bt) do { __builtin_amdgcn_s_setprio(1); _Pragma("unroll") for (int m = 0; m < 4; ++m) _Pragma("unroll") for (int n = 0; n < 2; ++n) _Pragma("unroll") for (int k = 0; k < 2; ++k) \
        acc[ai][bj][m][n] = __builtin_amdgcn_mfma_f32_16x16x32_bf16(Bt[n][k], At[m][k], acc[ai][bj][m][n], 0, 0, 0); __builtin_amdgcn_s_setprio(0); } while (0)
#define PG8_WAIT_V(n) asm volatile("s_waitcnt vmcnt(" #n ")" ::: "memory")
#define PG8_WAIT_L(n) asm volatile("s_waitcnt lgkmcnt(" #n ")" ::: "memory")
#define PG8_BAR __builtin_amdgcn_s_barrier()
#define PG8_SCHED __builtin_amdgcn_sched_barrier(0)
    Unit cur, nxt; int ui = 0;
    if (!S.next(0, cur)) return;
    f32x4 acc[2][2][4][2];
#pragma unroll
    for (int a = 0; a < 2; ++a)
#pragma unroll
        for (int b = 0; b < 2; ++b)
#pragma unroll
            for (int m = 0; m < 4; ++m)
#pragma unroll
                for (int n = 0; n < 2; ++n) acc[a][b][m][n] = (f32x4){0.f, 0.f, 0.f, 0.f};
    bf16x8 At[4][2], B0[2][2], B1[2][2];
    const char* cA = (const char*)g.A + (size_t)cur.pm * tstepA; const char* cB = (const char*)g.Bt + (size_t)cur.pn * tstepB;
    S.a_ready(cur);
    if constexpr (SP2) {
        PG8_STAGE(PG8_SB(0, 0), cB, voffB); PG8_STAGE(PG8_SB(0, 1), cB + hstepB, voffB); PG8_STAGE(PG8_SA(0, 0), cA, voffA); PG8_STAGE(PG8_SA(0, 1), cA + hstepA, voffA);
        if (wr == 1) PG8_BAR;
        PG8_WAIT_V(2); PG8_BAR;
        PG8_STAGE(PG8_SB(1, 0), cB + kstep, voffB); PG8_STAGE(PG8_SA(1, 0), cA + kstep, voffA); PG8_STAGE(PG8_SB(1, 1), cB + hstepB + kstep, voffB);
        PG8_WAIT_V(6); PG8_BAR;
    } else {
        PG8_STAGE(PG8_SB(0, 0), cB, voffB); PG8_STAGE(PG8_SA(0, 0), cA, voffA); PG8_STAGE(PG8_SB(0, 1), cB + hstepB, voffB); PG8_STAGE(PG8_SA(0, 1), cA + hstepA, voffA);
        if (wr == 1) PG8_BAR;
        PG8_WAIT_V(4); PG8_BAR;
        PG8_STAGE(PG8_SB(1, 0), cB + kstep, voffB); PG8_STAGE(PG8_SA(1, 0), cA + kstep, voffA); PG8_STAGE(PG8_SB(1, 1), cB + hstepB + kstep, voffB);
        PG8_WAIT_V(6); PG8_BAR;
    }
    for (;;) {
        const bool has_next = S.next(ui + 1, nxt);
        const char* nA = has_next ? (const char*)g.A + (size_t)nxt.pm * tstepA : cA; const char* nB = has_next ? (const char*)g.Bt + (size_t)nxt.pn * tstepB : cB;
        for (int t = 0; t < nt; t += 2) {
            const bool last = (t == nt - 2);
            const char* a1 = cA + (size_t)(t + 1) * kstep;
            const char* a2 = last ? nA : cA + (size_t)(t + 2) * kstep; const char* b2 = last ? nB : cB + (size_t)(t + 2) * kstep;
            const char* a3 = a2 + kstep; const char* b3 = b2 + kstep;
            if (last && has_next) S.a_ready(nxt);
            if constexpr (SP2) {
            PG8_LDB(B0, 0, 0); PG8_LDB(B1, 0, 1); PG8_SCHED; PG8_LDA(At, 0, 0); PG8_STAGE(PG8_SA(1, 1), a1 + hstepA, voffA);
            PG8_WAIT_V(8); PG8_WAIT_L(0); PG8_BAR; PG8_MMA(0, 0, At, B0); PG8_MMA(0, 1, At, B1); PG8_BAR; PG8_SCHED;
            PG8_LDA(At, 0, 1); PG8_STAGE(PG8_SB(0, 0), b2, voffB); PG8_STAGE(PG8_SB(0, 1), b2 + hstepB, voffB); PG8_STAGE(PG8_SA(0, 0), a2, voffA);
            PG8_WAIT_V(8); PG8_WAIT_L(0); PG8_BAR; PG8_MMA(1, 0, At, B0); PG8_MMA(1, 1, At, B1); PG8_BAR; PG8_SCHED;
            PG8_LDB(B0, 1, 0); PG8_LDB(B1, 1, 1); PG8_SCHED; PG8_LDA(At, 1, 0); PG8_STAGE(PG8_SA(0, 1), a2 + hstepA, voffA);
            PG8_WAIT_V(8); PG8_WAIT_L(0); PG8_BAR; PG8_MMA(0, 0, At, B0); PG8_MMA(0, 1, At, B1); PG8_BAR; PG8_SCHED;
            PG8_LDA(At, 1, 1); PG8_STAGE(PG8_SB(1, 0), b3, voffB); PG8_STAGE(PG8_SB(1, 1), b3 + hstepB, voffB); PG8_STAGE(PG8_SA(1, 0), a3, voffA);
            PG8_WAIT_V(8); PG8_WAIT_L(0); PG8_BAR; PG8_MMA(1, 0, At, B0); PG8_MMA(1, 1, At, B1); PG8_BAR; PG8_SCHED;
            } else {
            PG8_LDB(B0, 0, 0); PG8_SCHED; PG8_LDA(At, 0, 0); PG8_STAGE(PG8_SA(1, 1), a1 + hstepA, voffA);
            PG8_WAIT_L(8); PG8_BAR; PG8_WAIT_L(0); PG8_MMA(0, 0, At, B0); PG8_BAR; PG8_SCHED;
            PG8_LDB(B1, 0, 1); PG8_STAGE(PG8_SB(0, 0), b2, voffB);
            PG8_BAR; PG8_WAIT_L(0); PG8_MMA(0, 1, At, B1); PG8_BAR;
            PG8_LDA(At, 0, 1); PG8_STAGE(PG8_SA(0, 0), a2, voffA);
            PG8_BAR; PG8_WAIT_L(0); PG8_MMA(1, 0, At, B0); PG8_BAR; PG8_SCHED;
            PG8_STAGE(PG8_SB(0, 1), b2 + hstepB, voffB);
            PG8_WAIT_V(6); PG8_BAR; PG8_MMA(1, 1, At, B1); PG8_BAR;
            PG8_LDB(B0, 1, 0); PG8_SCHED; PG8_LDA(At, 1, 0); PG8_STAGE(PG8_SA(0, 1), a2 + hstepA, voffA);
            PG8_WAIT_L(8); PG8_BAR; PG8_WAIT_L(0); PG8_MMA(0, 0, At, B0); PG8_BAR; PG8_SCHED;
            PG8_LDB(B1, 1, 1); PG8_STAGE(PG8_SB(1, 0), b3, voffB);
            PG8_BAR; PG8_WAIT_L(0); PG8_MMA(0, 1, At, B1); PG8_BAR;
            PG8_LDA(At, 1, 1); PG8_STAGE(PG8_SA(1, 0), a3, voffA);
            PG8_BAR; PG8_WAIT_L(0); PG8_MMA(1, 0, At, B0); PG8_BAR; PG8_SCHED;
            PG8_STAGE(PG8_SB(1, 1), b3 + hstepB, voffB);
            PG8_WAIT_V(6); PG8_BAR; PG8_MMA(1, 1, At, B1); PG8_BAR;
            }
        }
        if constexpr (ALIGN_EPI) { if (wr == 0) PG8_BAR; }
        if constexpr (!Epi::AFTER_DRAIN) { E(acc, cur, wr, wc, fr, fq); S.done(cur); }
        if (!has_next) break;
#pragma unroll
        for (int a = 0; a < 2; ++a)
#pragma unroll
            for (int b = 0; b < 2; ++b)
#pragma unroll
                for (int m = 0; m < 4; ++m)
#pragma unroll
                    for (int n = 0; n < 2; ++n) acc[a][b][m][n] = (f32x4){0.f, 0.f, 0.f, 0.f};
        cur = nxt; cA = nA; cB = nB; ++ui;
        if constexpr (ALIGN_EPI) { if (wr == 1) PG8_BAR; }
    }
    PG8_WAIT_V(0);
    if constexpr (!ALIGN_EPI) { if (wr == 0) PG8_BAR; }
    PG8_BAR;
    if constexpr (Epi::AFTER_DRAIN) { E.fused(acc, cur, wr, wc, fr, fq, lds, wid, lane); S.done(cur); }
#undef PG8_SA
#undef PG8_SB
#undef PG8_STAGE
#undef PG8_LDA
#undef PG8_LDB
#undef PG8_MMA
#undef PG8_WAIT_V
#undef PG8_WAIT_L
#undef PG8_BAR
#undef PG8_SCHED
}
}
#define GAS __attribute__((address_space(1)))
#define LAS __attribute__((address_space(3)))
typedef unsigned short bf16;
typedef unsigned v4u __attribute__((ext_vector_type(4)));
typedef float f32x4 __attribute__((ext_vector_type(4)));
typedef short bf16x8 __attribute__((ext_vector_type(8)));
typedef GAS unsigned gu32;
typedef GAS unsigned long long gu64;
#define RLX_AGENT __ATOMIC_RELAXED, __HIP_MEMORY_SCOPE_AGENT
#define LDS_WAIT() asm volatile("s_waitcnt lgkmcnt(0)" ::: "memory")
#define VM_WAIT() asm volatile("s_waitcnt vmcnt(0)" ::: "memory")
__device__ __forceinline__ unsigned long long rt() { return __builtin_amdgcn_s_memrealtime(); }
__device__ __forceinline__ unsigned f2bf(float f) { unsigned u = __builtin_bit_cast(unsigned, f); return (u + 0x7fffu + ((u >> 16) & 1u)) >> 16; }
__device__ __forceinline__ unsigned pk2(float lo, float hi) { return f2bf(lo) | (f2bf(hi) << 16); }

#define XB_TMO      128
#define XB_XCNT(j)  (256  + 64 * (j))
#define XB_XSUB(j)  (1280 + 64 * (j))
#define XB_XGEN(j)  (2304 + 64 * (j))
#define XB_TOP      3328
#define XB_TOPGEN   3392
#define XCD_BAR_WORDS 3456
#define XB_SPIN_CAP (1u << 18)

__device__ __forceinline__ unsigned xb_ld(unsigned* p)              { return __hip_atomic_load(p, __ATOMIC_RELAXED, __HIP_MEMORY_SCOPE_AGENT); }
__device__ __forceinline__ unsigned xb_add(unsigned* p, unsigned v) { return __hip_atomic_fetch_add(p, v, __ATOMIC_RELAXED, __HIP_MEMORY_SCOPE_AGENT); }
__device__ __forceinline__ unsigned xb_xcc_id() { return (unsigned)__builtin_amdgcn_s_getreg((3 << 11) | 20) & 0xFu; }
#define XB_SPIN(cond, bar) do { unsigned _sp = 0; while (cond) { __builtin_amdgcn_s_sleep(1); \
    if ((++_sp & 255u) == 0u) { if (xb_ld(&(bar)[XB_TMO])) break; if (_sp > XB_SPIN_CAP) { atomicAdd(&(bar)[XB_TMO], 1u); break; } } } } while (0)

struct XcdBarrier {
    unsigned* bar; unsigned x;
    volatile LAS unsigned* st;
};

__device__ __forceinline__ XcdBarrier xcd_barrier_post(unsigned* bar, volatile LAS unsigned* st, const bool leader  ) {
    XcdBarrier b; b.bar = bar; b.x = xb_xcc_id(); b.st = st;
    if (leader) (void)xb_add(&bar[XB_XCNT(b.x)], 1u);
    return b;
}
__device__ __forceinline__ void xcd_barrier_complete(unsigned* bar, unsigned x, unsigned& nloc, unsigned& nx) {
    const unsigned G = gridDim.x * gridDim.y * gridDim.z;
    unsigned sum, cnt, mine, sp = 0u;
    for (;;) {
        sum = 0u; cnt = 0u; mine = 0u;
#pragma unroll
        for (unsigned j = 0; j < 16; ++j) { const unsigned c = xb_ld(&bar[XB_XCNT(j)]); sum += c; cnt += (c > 0u) ? 1u : 0u; mine = (j == x) ? c : mine; }
        if (sum == G) break;
        __builtin_amdgcn_s_sleep(1);
        if ((++sp & 255u) == 0u) { if (xb_ld(&bar[XB_TMO])) break; if (sp > XB_SPIN_CAP) { atomicAdd(&bar[XB_TMO], 1u); break; } }
    }
    nloc = mine > 0u ? mine : 1u; nx = cnt > 0u ? cnt : 1u;
}

__device__ __forceinline__ void xcd_barrier(const XcdBarrier& b, const bool leader  ) {
    asm volatile("s_waitcnt vmcnt(0)" ::: "memory");
    __syncthreads();
    if (leader) {
        unsigned* bar = b.bar;
        __builtin_amdgcn_s_waitcnt(0);
        unsigned nloc = b.st[0], nx = b.st[1];
        if (nloc == 0u) { xcd_barrier_complete(bar, b.x, nloc, nx); b.st[0] = nloc; b.st[1] = nx; }
        const unsigned old = xb_add(&bar[XB_XSUB(b.x)], 1u);
        const unsigned gen = old / nloc;
        if (old + 1u == (gen + 1u) * nloc) {
            __builtin_amdgcn_fence(__ATOMIC_RELEASE, "agent");
            asm volatile("s_waitcnt vmcnt(0)" ::: "memory");
            const unsigned og = xb_add(&bar[XB_TOP], 1u);
            const unsigned tg = og / nx;
            if (og + 1u == (tg + 1u) * nx) xb_add(&bar[XB_TOPGEN], 1u);
            else XB_SPIN(xb_ld(&bar[XB_TOPGEN]) == tg, bar);
            __builtin_amdgcn_fence(__ATOMIC_ACQUIRE, "agent");
            xb_add(&bar[XB_XGEN(b.x)], 1u);
            asm volatile("s_waitcnt vmcnt(0)" ::: "memory");
        } else {
            XB_SPIN(xb_ld(&bar[XB_XGEN(b.x)]) == gen, bar);
            __builtin_amdgcn_fence(__ATOMIC_ACQUIRE, "agent");
            asm volatile("s_waitcnt vmcnt(0)" ::: "memory");
        }
    }
    __syncthreads();
}

constexpr int NWAVES = 8;
constexpr int DM = 2048, SEQ = 16384, DEPTH = 4, DB = 8, DS = 32, PAST = 1024;
constexpr int MS = DB * DS;
constexpr int M = SEQ + MS;
constexpr int SKEYS = PAST + DS;
constexpr int NKR = SEQ + DB * SKEYS;
constexpr int NKRP = NKR + 128;
constexpr int NIN = 3908, NPROJ = 4096;
constexpr int DFF = 5632, NQC = 768, NKV = 1024, MIXW = 1536, HD = 128, QKD = 192;
constexpr int LDX = DM + 128, LDMIX = MIXW + 128, LDH = DFF + 128, LDCQ = 512 + 128, LDCKV = 256 + 128;
constexpr float EPS = 1e-6f, LOG2E = 1.4426950408889634f, LN2 = 0.6931471805599453f;
constexpr float QS_A = 0.08838834764831845f * LOG2E;
constexpr float QS_B = 0.08838834764831845f;
constexpr float QS_C = 0.07216878364870322f * LOG2E;
constexpr size_t O_Y = 0;
constexpr size_t O_FKP = O_Y + (size_t)M * DM;
constexpr size_t O_FVP = O_FKP + (size_t)DEPTH * SEQ * 512;
constexpr size_t O_FLP = O_FVP + (size_t)DEPTH * SEQ * 512;
constexpr size_t O_SKP = O_FLP + (size_t)DEPTH * SEQ * 4;
constexpr size_t O_SVP = O_SKP + (size_t)DEPTH * SEQ * 512;
constexpr size_t O_CKP = O_SVP + (size_t)DEPTH * SEQ * 512;
constexpr size_t O_KRP = O_CKP + (size_t)DEPTH * SEQ * 256;
constexpr size_t O_FKS = O_KRP + (size_t)DEPTH * SEQ * 64;
constexpr size_t O_FVS = O_FKS + (size_t)DEPTH * MS * 512;
constexpr size_t O_FLS = O_FVS + (size_t)DEPTH * MS * 512;
constexpr size_t O_SKS = O_FLS + (size_t)DEPTH * MS * 4;
constexpr size_t O_SVS = O_SKS + (size_t)DEPTH * MS * 512;
constexpr size_t O_CKS = O_SVS + (size_t)DEPTH * MS * 512;
constexpr size_t O_KRS = O_CKS + (size_t)DEPTH * MS * 256;
constexpr size_t O_END = O_KRS + (size_t)DEPTH * MS * 64;
static_assert(O_END == 191959040ull, "d_out size");
constexpr size_t MiB = 1u << 20;
constexpr size_t WS_CTL = 0, CTL_ZERO_BYTES = 1 * MiB;
constexpr size_t WS_W = 2 * MiB, W_LAYER = 96 * MiB;
constexpr size_t WO_IN = 0, WO_UQ = 17 * MiB, WO_UKV = 18 * MiB, WO_OUT = 19 * MiB, WO_GU = 26 * MiB, WO_DOWN = 73 * MiB;
constexpr size_t WS_ROPE = WS_W + DEPTH * W_LAYER;
constexpr size_t WS_XN = WS_ROPE + 4 * MiB;
constexpr size_t WS_RSS = WS_XN + 70 * MiB;
constexpr size_t WS_QA = WS_RSS + 3 * MiB, WS_QB = WS_QA + 17 * MiB, WS_CQ = WS_QB + 17 * MiB;
constexpr size_t WS_KA = WS_CQ + 21 * MiB, WS_VA = WS_KA + 25 * MiB, WS_KB = WS_VA + 25 * MiB, WS_VB = WS_KB + 25 * MiB;
constexpr size_t WS_CKVN = WS_VB + 25 * MiB;
constexpr size_t WS_KROPE = WS_CKVN + 19 * MiB;
constexpr size_t WS_LOGF = WS_KROPE + 7 * MiB;
constexpr size_t WS_FBIAS = WS_LOGF + 1 * MiB;
constexpr size_t WS_QN = WS_FBIAS + 1 * MiB;
constexpr size_t WS_QC = WS_QN + 1 * MiB;
constexpr size_t WS_KC = WS_QC + 25 * MiB;
constexpr size_t WS_ATT = WS_KC + 37 * MiB;
constexpr size_t WS_MIX = WS_ATT + 49 * MiB;
constexpr size_t WS_R = WS_MIX + 53 * MiB;
constexpr size_t WS_PROJ = WS_R, WS_QCR = WS_R + 130 * MiB, WS_KVR = WS_QCR + 25 * MiB;
constexpr size_t WS_H = WS_R;
constexpr size_t WS_PO = WS_R + 204 * MiB;
constexpr size_t WS_PML = WS_PO + 64 * MiB;
constexpr size_t WS_RSSS = WS_PML + 2 * MiB;
constexpr size_t WS_YB = WS_RSSS + 1 * MiB;
constexpr size_t WS_KRSS = WS_YB + 64 * MiB;
constexpr size_t WS_CQSS = WS_KRSS + 1 * MiB;
constexpr size_t WS_END = WS_CQSS + 2 * MiB;
static_assert((size_t)M * LDX * 2 <= 70 * MiB && (size_t)M * 32 * 4 <= 3 * MiB && (size_t)M * 512 * 2 <= 17 * MiB && (size_t)M * LDCQ * 2 <= 21 * MiB && (size_t)NKRP * 512 * 2 <= 25 * MiB, "ws map 1");
static_assert((size_t)NKRP * LDCKV * 2 <= 19 * MiB && (size_t)NKRP * 64 * 4 <= 7 * MiB && (size_t)NKRP * 16 <= 1 * MiB && (size_t)M * 768 * 2 <= 25 * MiB && (size_t)NKRP * 768 * 2 <= 37 * MiB, "ws map 2");
static_assert((size_t)M * 1536 * 2 <= 49 * MiB && (size_t)M * LDMIX * 2 <= 53 * MiB && (size_t)M * 4096 * 2 <= 130 * MiB && (size_t)NKRP * 1024 * 2 <= 49 * MiB && (size_t)M * LDH * 2 <= 204 * MiB, "ws map 3");
static_assert((size_t)NPROJ * LDX * 2 <= 17 * MiB && (size_t)NQC * LDCQ * 2 <= MiB && (size_t)NKV * LDCKV * 2 <= MiB && (size_t)DM * LDMIX * 2 <= 7 * MiB && (size_t)2 * DFF * LDX * 2 <= 47 * MiB && (size_t)DM * LDH * 2 <= 23 * MiB, "ws map 4");
constexpr int CW_TMO = 0, CW_CODE = 1, CW_BAR = 4096, CW_AQ = 8192, CW_KMAX = 12288;
constexpr int RING_OFF = 0, RING_BYTES = 131072;
constexpr int LDSCTL_OFF = RING_BYTES, MISC_OFF = LDSCTL_OFF + 320;
constexpr int LDS_BYTES = 147456;
constexpr int RSTAB_OFF = RING_BYTES + 1024 + 8192;
static_assert(RSTAB_OFF + 4096 + 32 <= LDS_BYTES, "LDS map");

typedef float f32x2 __attribute__((ext_vector_type(2)));
__device__ __forceinline__ unsigned pkbf(float lo, float hi) { unsigned r; asm("v_cvt_pk_bf16_f32 %0, %1, %2" : "=v"(r) : "v"(lo), "v"(hi)); return r; }
__device__ __forceinline__ void unpack8(v4u w, float* x) {
    x[0] = __uint_as_float(w.x << 16); x[1] = __uint_as_float(w.x & 0xffff0000u); x[2] = __uint_as_float(w.y << 16); x[3] = __uint_as_float(w.y & 0xffff0000u);
    x[4] = __uint_as_float(w.z << 16); x[5] = __uint_as_float(w.z & 0xffff0000u); x[6] = __uint_as_float(w.w << 16); x[7] = __uint_as_float(w.w & 0xffff0000u); }
__device__ __forceinline__ v4u pack8(const float* y) { v4u w; w.x = pkbf(y[0], y[1]); w.y = pkbf(y[2], y[3]); w.z = pkbf(y[4], y[5]); w.w = pkbf(y[6], y[7]); return w; }
__device__ __forceinline__ void ld8f(const float* p, float* x) { const f32x4 a = *(const f32x4*)p, b = *(const f32x4*)(p + 4); x[0] = a[0]; x[1] = a[1]; x[2] = a[2]; x[3] = a[3]; x[4] = b[0]; x[5] = b[1]; x[6] = b[2]; x[7] = b[3]; }
__device__ __forceinline__ void st8f(float* p, const float* x) { *(f32x4*)p = (f32x4){x[0], x[1], x[2], x[3]}; *(f32x4*)(p + 4) = (f32x4){x[4], x[5], x[6], x[7]}; }
__device__ __forceinline__ void st8f_nt(float* p, const float* x) { __builtin_nontemporal_store((f32x4){x[0], x[1], x[2], x[3]}, (f32x4*)p); __builtin_nontemporal_store((f32x4){x[4], x[5], x[6], x[7]}, (f32x4*)(p + 4)); }
__device__ __forceinline__ float sumsq8(const float* x) { return ((x[0] * x[0] + x[1] * x[1]) + (x[2] * x[2] + x[3] * x[3])) + ((x[4] * x[4] + x[5] * x[5]) + (x[6] * x[6] + x[7] * x[7])); }
__device__ __forceinline__ float wsum16(float v) { v += __shfl_xor(v, 1); v += __shfl_xor(v, 2); v += __shfl_xor(v, 4); v += __shfl_xor(v, 8); return v; }
__device__ __forceinline__ float wsum32(float v) { v = wsum16(v); v += __shfl_xor(v, 16); return v; }
__device__ __forceinline__ float wsum64(float v) { v = wsum32(v); v += __shfl_xor(v, 32); return v; }
enum { I_XP = 0, I_XS, I_CFK, I_CFV, I_CFL, I_CSK, I_CSV, I_CCKV, I_CKR, I_NMIX, I_WIN, I_FBIAS, I_FQN, I_FKN, I_QAN, I_WUQ, I_KVAN, I_WUKV, I_QN, I_KN, I_ONA, I_ONB, I_ONC, I_WOUT, I_NFFN, I_WGU, I_WDOWN, N_INPUTS };
struct KArgs { const float* in[N_INPUTS]; float* out; unsigned char* ws; int ph_lo, ph_hi; };
static_assert(sizeof(KArgs) == N_INPUTS * 8 + 8 + 8 + 8, "KArgs has no padding");

template <int MAT> __device__ __forceinline__ int srccol(int n) {
    if (MAT == 0) { if (n < 1536) return n; if (n < 3904) return n + 4; if (n < 3908) return 1536 + (n - 3904); return -1; }
    if (MAT == 1) { const int pn = n >> 8, half = (n >> 7) & 1, j = n & 127; return half * DFF + pn * 128 + j; }
    return n;
}
__device__ __forceinline__ void p0_transpose_item(const float* W, int Nsrc, int Ndst, bf16* WT, int ldw, int mat, int item, int lane, const float* gain) {
    const int nblk = Ndst >> 6, kb = item / nblk, nb = item - kb * nblk, n = 64 * nb + 4 * (lane & 15), k = 64 * kb + 16 * (lane >> 4);
    const int sc0 = srccol<0>(n), sc1 = srccol<1>(n), sc = mat == 0 ? sc0 : mat == 1 ? sc1 : n;
    f32x4 v[16];
    const float* src = W + (size_t)k * Nsrc + (sc >= 0 ? sc : 0);
#pragma unroll
    for (int i = 0; i < 16; ++i) v[i] = __builtin_nontemporal_load((const f32x4*)(src + (size_t)i * Nsrc));
    if (sc < 0) {
#pragma unroll
        for (int i = 0; i < 16; ++i) v[i] = (f32x4){0.f, 0.f, 0.f, 0.f}; }
    if (gain) { const f32x4 g0 = *(const f32x4*)(gain + k), g1 = *(const f32x4*)(gain + k + 4), g2 = *(const f32x4*)(gain + k + 8), g3 = *(const f32x4*)(gain + k + 12);
#pragma unroll
        for (int i = 0; i < 4; ++i) { v[i] *= g0[i]; v[4 + i] *= g1[i]; v[8 + i] *= g2[i]; v[12 + i] *= g3[i]; } }
    bf16* dst = WT + (size_t)n * ldw + k;
#pragma unroll
    for (int j = 0; j < 4; ++j) { v4u o0, o1;
        o0.x = pkbf(v[0][j], v[1][j]); o0.y = pkbf(v[2][j], v[3][j]); o0.z = pkbf(v[4][j], v[5][j]); o0.w = pkbf(v[6][j], v[7][j]);
        o1.x = pkbf(v[8][j], v[9][j]); o1.y = pkbf(v[10][j], v[11][j]); o1.z = pkbf(v[12][j], v[13][j]); o1.w = pkbf(v[14][j], v[15][j]);
        *(GAS v4u*)(dst + (size_t)j * ldw) = o0; *(GAS v4u*)(dst + (size_t)j * ldw + 8) = o1; }
}
constexpr int CI_IN = (DM / 64) * (NPROJ / 64), CI_UQ = (512 / 64) * (NQC / 64), CI_UKV = (256 / 64) * (NKV / 64), CI_OUT = (MIXW / 64) * (DM / 64),
              CI_GU = (DM / 64) * (2 * DFF / 64), CI_DN = (DFF / 64) * (DM / 64), CI_LAYER = CI_IN + CI_UQ + CI_UKV + CI_OUT + CI_GU + CI_DN;
constexpr int CONV_PER_UNIT = 24, NCONV = (CI_LAYER + CONV_PER_UNIT - 1) / CONV_PER_UNIT;
__device__ __forceinline__ void p0_conv_item(const KArgs& a, int l, int r, int lane) {
    const float* W = a.in[I_WIN] + (size_t)l * DM * NIN; int Nsrc = NIN, Ndst = NPROJ, ldw = LDX, mat = 0; size_t wo = WO_IN;
    if (r >= CI_IN) { r -= CI_IN; W = a.in[I_WUQ] + (size_t)l * 512 * NQC; Nsrc = NQC; Ndst = NQC; ldw = LDCQ; mat = 2; wo = WO_UQ;
        if (r >= CI_UQ) { r -= CI_UQ; W = a.in[I_WUKV] + (size_t)l * 256 * NKV; Nsrc = NKV; Ndst = NKV; ldw = LDCKV; wo = WO_UKV;
            if (r >= CI_UKV) { r -= CI_UKV; W = a.in[I_WOUT] + (size_t)l * MIXW * DM; Nsrc = DM; Ndst = DM; ldw = LDMIX; wo = WO_OUT;
                if (r >= CI_OUT) { r -= CI_OUT; W = a.in[I_WGU] + (size_t)l * DM * 2 * DFF; Nsrc = 2 * DFF; Ndst = 2 * DFF; ldw = LDX; mat = 1; wo = WO_GU;
                    if (r >= CI_GU) { r -= CI_GU; W = a.in[I_WDOWN] + (size_t)l * DFF * DM; Nsrc = DM; Ndst = DM; ldw = LDH; mat = 2; wo = WO_DOWN; } } } } }
    p0_transpose_item(W, Nsrc, Ndst, (bf16*)(a.ws + WS_W + (size_t)l * W_LAYER + wo), ldw, mat, r, lane, mat == 0 ? a.in[I_NMIX] + l * DM : mat == 1 ? a.in[I_NFFN] + l * DM : nullptr);
}
__device__ __forceinline__ void p0_prologue(const KArgs& a, LAS unsigned char* lds, int gw, int NGW, int lane, int wave) {
    unsigned char* ws = a.ws;
    for (int it = gw; it < (CONV_IN_E ? 1 : DEPTH) * CI_LAYER; it += NGW) { const int l = it / CI_LAYER; p0_conv_item(a, l, it - l * CI_LAYER, lane); }
    bf16* XN = (bf16*)(ws + WS_XN); float* RSS = (float*)(ws + WS_RSS);
    for (int r = gw; r < M; r += NGW) {
        const float* xr = (r < SEQ ? a.in[I_XP] + (size_t)r * DM : a.in[I_XS] + (size_t)(r - SEQ) * DM) + 4 * lane; float ss = 0.f;
        f32x4 vv[8], gg[8];
#pragma unroll
        for (int j = 0; j < 8; ++j) { vv[j] = *(const f32x4*)(xr + 256 * j); gg[j] = (f32x4){1.f, 1.f, 1.f, 1.f}; }
        asm volatile("" ::: "memory");
#pragma unroll
        for (int j = 0; j < 8; ++j) { const f32x4 v = vv[j], g = gg[j];
            ss += (v[0] * v[0] + v[1] * v[1]) + (v[2] * v[2] + v[3] * v[3]);
            f32x2 o; o.x = __uint_as_float(pkbf(v[0] * g[0], v[1] * g[1])); o.y = __uint_as_float(pkbf(v[2] * g[2], v[3] * g[3]));
            *(f32x2*)(XN + (size_t)r * LDX + 4 * lane + 256 * j) = o; }
        ss = wsum64(ss);
        if (lane < 32) RSS[(size_t)r * 32 + lane] = lane == 0 ? ss : 0.f;
        if (r >= SEQ) { float* rs_ = (float*)(ws + WS_RSSS) + (size_t)(r - SEQ) * 128; rs_[lane] = lane == 0 ? ss : 0.f; rs_[64 + lane] = 0.f; }
    }
    f32x2* ROPE = (f32x2*)(ws + WS_ROPE);
    for (int e = gw * 64 + lane; e < SEQ * 32; e += NGW * 64) { const int pos = e >> 5, j = e & 31;
        const float inv = exp2f(-(float)j * 0.4152410118609203f); const float ang = (float)pos * inv;
        double rv = (double)ang * 0.15915494309189535; rv -= rint(rv);
        ROPE[e] = (f32x2){__builtin_amdgcn_cosf((float)rv), __builtin_amdgcn_sinf((float)rv)}; }
    for (int e = gw * 64 + lane; e < 128 * 64; e += NGW * 64) { const int pr = NKR + (e >> 6), c = (e & 63) * 8; const v4u z = {0u, 0u, 0u, 0u};
        *(v4u*)((bf16*)(ws + WS_KA) + (size_t)pr * 512 + c) = z; *(v4u*)((bf16*)(ws + WS_VA) + (size_t)pr * 512 + c) = z;
        *(v4u*)((bf16*)(ws + WS_KB) + (size_t)pr * 512 + c) = z; *(v4u*)((bf16*)(ws + WS_VB) + (size_t)pr * 512 + c) = z;
        *(v4u*)((bf16*)(ws + WS_KC) + (size_t)pr * 768 + c) = z; if (c < 256) *(v4u*)((bf16*)(ws + WS_KC) + (size_t)pr * 768 + 512 + c) = z;
        *(v4u*)((bf16*)(ws + WS_KVR) + (size_t)pr * 1024 + c) = z; *(v4u*)((bf16*)(ws + WS_KVR) + (size_t)pr * 1024 + 512 + c) = z;
        if (c < 4 * 8) ((float*)(ws + WS_FBIAS))[(size_t)(c >> 3) * NKRP + pr] = 0.f; }
}

__device__ __forceinline__ float log_sigmoid(float v) { return fminf(v, 0.f) - log1pf(__expf(-fabsf(v))); }
struct PbGains { float gq[8], gk[8], gqa[8], gkv[8]; f32x4 fb; };
__device__ __forceinline__ void pb_token_row(const KArgs& a, int l, int r, int lane, const v4u (&w)[8], const PbGains& G_, float& kmA, float& kmB) {
    unsigned char* ws = a.ws; float* out = a.out;
    const bool smp = r >= SEQ; const int rs_ = r - SEQ;
    const int kr = smp ? SEQ + (rs_ >> 5) * SKEYS + PAST + (rs_ & 31) : r;
    const size_t orow = smp ? (size_t)l * MS + rs_ : (size_t)l * SEQ + r;
    float x[8], y[8];
    { unpack8(w[0], x); const float rs = 1.0f / sqrtf(wsum16(sumsq8(x)) * (1.f / 128.f) + EPS);
#pragma unroll
      for (int i = 0; i < 8; ++i) y[i] = x[i] * rs * G_.gq[i] * QS_A;
      *(v4u*)((bf16*)(ws + WS_QA) + (size_t)r * 512 + lane * 8) = pack8(y); }
    { unpack8(w[1], x); const float rs = 1.0f / sqrtf(wsum16(sumsq8(x)) * (1.f / 128.f) + EPS);
#pragma unroll
      for (int i = 0; i < 8; ++i) y[i] = x[i] * rs * G_.gk[i];
      st8f_nt(out + (smp ? O_FKS : O_FKP) + orow * 512 + lane * 8, y); *(v4u*)((bf16*)(ws + WS_KA) + (size_t)kr * 512 + lane * 8) = pack8(y);
      kmA = fmaxf(kmA, wsum16(sumsq8(y))); }
    if (smp) {
    { unpack8(w[2], x); st8f_nt(out + O_FVS + orow * 512 + lane * 8, x); *(v4u*)((bf16*)(ws + WS_VA) + (size_t)kr * 512 + lane * 8) = w[2]; }
    { unpack8(w[3], x);
#pragma unroll
      for (int i = 0; i < 8; ++i) y[i] = x[i] * QS_B;
      *(v4u*)((bf16*)(ws + WS_QB) + (size_t)r * 512 + lane * 8) = pack8(y); }
    { unpack8(w[4], x); st8f_nt(out + O_SKS + orow * 512 + lane * 8, x); *(v4u*)((bf16*)(ws + WS_KB) + (size_t)kr * 512 + lane * 8) = w[4];
      kmB = fmaxf(kmB, wsum16(sumsq8(x))); }
    { unpack8(w[5], x); st8f_nt(out + O_SVS + orow * 512 + lane * 8, x); *(v4u*)((bf16*)(ws + WS_VB) + (size_t)kr * 512 + lane * 8) = w[5]; }
    }
    { unpack8(w[6], x); const float ssq = wsum64(sumsq8(x)); const float rs = FUSE_B ? 1.0f : 1.0f / sqrtf(ssq * (1.f / 512.f) + EPS);
#pragma unroll
      for (int i = 0; i < 8; ++i) y[i] = x[i] * rs * G_.gqa[i];
      *(v4u*)((bf16*)(ws + WS_CQ) + (size_t)r * LDCQ + lane * 8) = pack8(y);
      if (FUSE_B && lane < 16) ((float*)(ws + WS_CQSS))[(size_t)r * 16 + lane] = lane == 0 ? ssq : 0.f; }
    { unpack8(w[7], x);
      const float rs = 1.0f / sqrtf(wsum32(sumsq8(x)) * (1.f / 256.f) + EPS);
      if (lane < 32) {
#pragma unroll
          for (int i = 0; i < 8; ++i) y[i] = x[i] * rs * G_.gkv[i];
          st8f_nt(out + (smp ? O_CKS : O_CKP) + orow * 256 + lane * 8, y); *(v4u*)((bf16*)(ws + WS_CKVN) + (size_t)kr * LDCKV + lane * 8) = pack8(y); }
      else if (lane < 40) { st8f_nt(out + (smp ? O_KRS : O_KRP) + orow * 64 + (lane - 32) * 8, x); st8f((float*)(ws + WS_KROPE) + (size_t)kr * 64 + (lane - 32) * 8, x); }
      else if (lane == 40) { const f32x4 fb = G_.fb;
          const f32x4 lf = {log_sigmoid(x[0] + fb[0]), log_sigmoid(x[1] + fb[1]), log_sigmoid(x[2] + fb[2]), log_sigmoid(x[3] + fb[3])};
          *(f32x4*)(out + (smp ? O_FLS : O_FLP) + orow * 4) = lf; *(f32x4*)((float*)(ws + WS_LOGF) + (size_t)kr * 4) = lf; }
      { float k2 = (lane >= 32 && lane < 40) ? sumsq8(x) : 0.f; k2 += __shfl_xor(k2, 1); k2 += __shfl_xor(k2, 2); k2 += __shfl_xor(k2, 4); if (lane == 32) ((float*)(ws + WS_KRSS))[kr] = k2; }
    }
}
__device__ __forceinline__ void pb_tokens(const KArgs& a, int l, int gw, int NGW, int lane, float& kmA, float& kmB) {
    PbGains G_; ld8f(a.in[I_FQN] + l * 128 + (lane & 15) * 8, G_.gq); ld8f(a.in[I_FKN] + l * 128 + (lane & 15) * 8, G_.gk); ld8f(a.in[I_QAN] + l * 512 + lane * 8, G_.gqa);
    ld8f(a.in[I_KVAN] + l * 256 + (lane & 31) * 8, G_.gkv); G_.fb = *(const f32x4*)(a.in[I_FBIAS] + l * 4);
    const bf16* P = (const bf16*)(a.ws + WS_PROJ) + lane * 8;
    v4u cur[8], nxt[8];
    const int r0 = FUSE_B ? SEQ + gw : gw;
    if (r0 < M) {
#pragma unroll
        for (int s_ = 0; s_ < 8; ++s_) if (r0 >= SEQ || s_ < 2 || s_ > 5) cur[s_] = *(const v4u*)(P + (size_t)r0 * NPROJ + s_ * 512); }
    for (int r = r0; r < M; r += NGW) {
        const int rn = r + NGW < M ? r + NGW : r;
#pragma unroll
        for (int s_ = 0; s_ < 8; ++s_) if (rn >= SEQ || s_ < 2 || s_ > 5) nxt[s_] = *(const v4u*)(P + (size_t)rn * NPROJ + s_ * 512);
        __builtin_amdgcn_sched_barrier(0);
        pb_token_row(a, l, r, lane, cur, G_, kmA, kmB);
        __builtin_amdgcn_sched_barrier(0);
#pragma unroll
        for (int s_ = 0; s_ < 8; ++s_) cur[s_] = nxt[s_];
    }
}
__device__ __forceinline__ void pb_cache_row(const KArgs& a, int l, int cr, int lane, float& kmA, float& kmB) {
    unsigned char* ws = a.ws; const int b = cr >> 10, j = cr & 1023, kr = SEQ + b * SKEYS + j; const size_t src = (size_t)l * DB * PAST + cr;
    float x0[8], x1[8], x2[8], x3[8], x4[8];
    ld8f(a.in[I_CFK] + src * 512 + lane * 8, x0); ld8f(a.in[I_CFV] + src * 512 + lane * 8, x1); ld8f(a.in[I_CSK] + src * 512 + lane * 8, x2); ld8f(a.in[I_CSV] + src * 512 + lane * 8, x3);
    if (lane < 32) ld8f(a.in[I_CCKV] + src * 256 + lane * 8, x4); else if (lane < 40) ld8f(a.in[I_CKR] + src * 64 + (lane - 32) * 8, x4); else if (lane == 40) { const f32x4 t_ = *(const f32x4*)(a.in[I_CFL] + src * 4); x4[0] = t_[0]; x4[1] = t_[1]; x4[2] = t_[2]; x4[3] = t_[3]; }
    __builtin_amdgcn_sched_barrier(0);
    *(v4u*)((bf16*)(ws + WS_KA) + (size_t)kr * 512 + lane * 8) = pack8(x0); kmA = fmaxf(kmA, wsum16(sumsq8(x0)));
    *(v4u*)((bf16*)(ws + WS_VA) + (size_t)kr * 512 + lane * 8) = pack8(x1);
    *(v4u*)((bf16*)(ws + WS_KB) + (size_t)kr * 512 + lane * 8) = pack8(x2); kmB = fmaxf(kmB, wsum16(sumsq8(x2)));
    *(v4u*)((bf16*)(ws + WS_VB) + (size_t)kr * 512 + lane * 8) = pack8(x3);
    if (lane < 32) *(v4u*)((bf16*)(ws + WS_CKVN) + (size_t)kr * LDCKV + lane * 8) = pack8(x4);
    else if (lane < 40) st8f((float*)(ws + WS_KROPE) + (size_t)kr * 64 + (lane - 32) * 8, x4);
    else if (lane == 40) *(f32x4*)((float*)(ws + WS_LOGF) + (size_t)kr * 4) = (f32x4){x4[0], x4[1], x4[2], x4[3]};
    { float k2 = (lane >= 32 && lane < 40) ? sumsq8(x4) : 0.f; k2 += __shfl_xor(k2, 1); k2 += __shfl_xor(k2, 2); k2 += __shfl_xor(k2, 4); if (lane == 32) ((float*)(ws + WS_KRSS))[kr] = k2; }
}
__device__ __forceinline__ void scan_job(unsigned char* ws, LAS float* sm, int job, int tid, int wave, int lane) {
    const int h = job & 3, sq = job >> 2; const int krow0 = sq == 0 ? 0 : SEQ + (sq - 1) * SKEYS, n = sq == 0 ? SEQ : SKEYS, per = sq == 0 ? 32 : 3;
    const float* LOGF = (const float*)(ws + WS_LOGF) + (size_t)krow0 * 4 + h; float* FB = (float*)(ws + WS_FBIAS) + (size_t)h * NKRP + krow0;
    const int i0 = tid * per; float loc = 0.f, v_[32];
#pragma unroll
    for (int i = 0; i < 32; ++i) { v_[i] = (i < per && i0 + i < n) ? LOGF[(size_t)(i0 + i) * 4] : 0.f; loc += v_[i]; }
    float inc = loc;
#pragma unroll
    for (int o = 1; o < 64; o <<= 1) { const float t = __shfl_up(inc, o); if (lane >= o) inc += t; }
    if (lane == 63) sm[wave] = inc;
    __syncthreads();
    float run = inc - loc;
    for (int w = 0; w < wave; ++w) run += sm[w];
#pragma unroll
    for (int i = 0; i < 32; ++i) if (i < per && i0 + i < n) { run += v_[i]; FB[i0 + i] = -LOG2E * run; }
    __syncthreads();
}
template <int SRC> __device__ __forceinline__ void pd_row(const KArgs& a, int l, int r, int lane) {
    unsigned char* ws = a.ws; const int li = lane & 31, hh = lane >> 5;
    const int pos = SRC == 0 ? (r < SEQ ? r : PAST + ((r - SEQ) & 31)) : (r < SEQ ? r : (r - SEQ) % SKEYS);
    const f32x2* rope = (const f32x2*)(ws + WS_ROPE) + (size_t)pos * 32; const float* gn = a.in[SRC == 0 ? I_QN : I_KN] + l * QKD;
    const float qs = SRC == 0 ? QS_C : 1.0f;
    float x1[2][8], x2[2][8], g[8], g2[8]; f32x2 cs[8];
#pragma unroll
    for (int it = 0; it < 2; ++it) { const int head = it * 2 + hh;
        if (SRC == 0) { const bf16* src = (const bf16*)(ws + WS_QCR) + (size_t)r * NQC + head * QKD;
            if (li < 16) unpack8(*(const v4u*)(src + li * 8), x1[it]);
            else if (li < 20) { unpack8(*(const v4u*)(src + 128 + (li - 16) * 8), x1[it]); unpack8(*(const v4u*)(src + 160 + (li - 16) * 8), x2[it]); } }
        else { const bf16* src = (const bf16*)(ws + WS_KVR) + (size_t)r * NKV + head * 256; const float* kro = (const float*)(ws + WS_KROPE) + (size_t)r * 64;
            if (li < 16) unpack8(*(const v4u*)(src + li * 8), x1[it]);
            else if (li < 20) { ld8f(kro + (li - 16) * 8, x1[it]); ld8f(kro + 32 + (li - 16) * 8, x2[it]); } } }
    if (li < 16) ld8f(gn + li * 8, g);
    else if (li < 20) { ld8f(gn + 128 + (li - 16) * 8, g); ld8f(gn + 160 + (li - 16) * 8, g2);
#pragma unroll
        for (int i = 0; i < 8; ++i) cs[i] = rope[(li - 16) * 8 + i]; }
    __builtin_amdgcn_sched_barrier(0);
#pragma unroll
    for (int it = 0; it < 2; ++it) { const int head = it * 2 + hh;
        bf16* dst = (bf16*)(ws + (SRC == 0 ? WS_QC : WS_KC)) + (size_t)r * NQC + head * QKD;
        float ss = 0.f, y[8], y2[8];
        if (li < 16) ss = sumsq8(x1[it]); else if (li < 20) ss = sumsq8(x1[it]) + sumsq8(x2[it]);
        const float rs = 1.0f / sqrtf(wsum32(ss) * (1.f / 192.f) + EPS);
        if (li < 16) {
#pragma unroll
            for (int i = 0; i < 8; ++i) y[i] = x1[it][i] * rs * g[i] * qs;
            *(v4u*)(dst + li * 8) = pack8(y); }
        else if (li < 20) { const int m = li - 16;
#pragma unroll
            for (int i = 0; i < 8; ++i) { const float u1 = x1[it][i] * rs * g[i], u2 = x2[it][i] * rs * g2[i];
                y[i] = (u1 * cs[i].x - u2 * cs[i].y) * qs; y2[i] = (u2 * cs[i].x + u1 * cs[i].y) * qs; }
            *(v4u*)(dst + 128 + m * 8) = pack8(y); *(v4u*)(dst + 160 + m * 8) = pack8(y2); }
    }
}
struct PfRow { v4u w0, w1, w2, wp0, wp1, wp2, wp3; f32x2 ml0, ml1, ml2, ml3; };
__device__ __forceinline__ void pf_load(const KArgs& a, int r, int lane, PfRow& R) {
    unsigned char* ws = a.ws; const bf16* src = (const bf16*)(ws + WS_ATT) + (size_t)r * MIXW + lane * 8;
    const bool merged = r < SEQ && r >= 16 * 256;
    const int np = merged ? (r >> 12) + 1 : 0, head = lane >> 4;
    R.w0 = *(const v4u*)(src); R.w1 = *(const v4u*)(src + 512); R.w2 = (v4u){0u, 0u, 0u, 0u};
    if (!merged) R.w2 = *(const v4u*)(src + 1024);
#define PF_LD(p, WP, ML) if (p < np) { ML = *(const f32x2*)((const float*)(ws + WS_PML) + (((size_t)p * SEQ + r) * 4 + head) * 2); WP = *(const v4u*)((const bf16*)(ws + WS_PO) + ((size_t)p * SEQ + r) * 512 + lane * 8); }
    PF_LD(0, R.wp0, R.ml0) PF_LD(1, R.wp1, R.ml1) PF_LD(2, R.wp2, R.ml2) PF_LD(3, R.wp3, R.ml3)
#undef PF_LD
}
__device__ __forceinline__ void pf_compute(const KArgs& a, int r, int lane, const PfRow& R, const float (&g0)[8], const float (&g1)[8], const float (&g2)[8]) {
    bf16* dst = (bf16*)(a.ws + WS_MIX) + (size_t)r * LDMIX + lane * 8;
    const bool merged = r < SEQ && r >= 16 * 256; const int np = merged ? (r >> 12) + 1 : 0;
    float x[8], y[8];
    { unpack8(R.w0, x); const float rs = 1.0f / sqrtf(wsum64(sumsq8(x)) * (1.f / 512.f) + EPS);
#pragma unroll
      for (int i = 0; i < 8; ++i) y[i] = x[i] * rs * g0[i];
      *(v4u*)(dst) = pack8(y); }
    { unpack8(R.w1, x); const float rs = 1.0f / sqrtf(wsum64(sumsq8(x)) * (1.f / 512.f) + EPS);
#pragma unroll
      for (int i = 0; i < 8; ++i) y[i] = x[i] * rs * g1[i];
      *(v4u*)(dst + 512) = pack8(y); }
    { if (merged) { float mx = -3.0e38f, den = 0.f;
          if (0 < np) mx = fmaxf(mx, R.ml0.x); if (1 < np) mx = fmaxf(mx, R.ml1.x); if (2 < np) mx = fmaxf(mx, R.ml2.x); if (3 < np) mx = fmaxf(mx, R.ml3.x);
#pragma unroll
          for (int i = 0; i < 8; ++i) x[i] = 0.f;
#define PF_ACC(p, WP, ML) if (p < np) { const float w = __builtin_amdgcn_exp2f(ML.x - mx) * ML.y; den += w; float xp[8]; unpack8(WP, xp); _Pragma("unroll") for (int i = 0; i < 8; ++i) x[i] += w * xp[i]; }
          PF_ACC(0, R.wp0, R.ml0) PF_ACC(1, R.wp1, R.ml1) PF_ACC(2, R.wp2, R.ml2) PF_ACC(3, R.wp3, R.ml3)
#undef PF_ACC
          const float rd = 1.0f / den;
#pragma unroll
          for (int i = 0; i < 8; ++i) x[i] *= rd; }
      else unpack8(R.w2, x);
      const float rs = 1.0f / sqrtf(wsum64(sumsq8(x)) * (1.f / 512.f) + EPS);
#pragma unroll
      for (int i = 0; i < 8; ++i) y[i] = x[i] * rs * g2[i];
      *(v4u*)(dst + 1024) = pack8(y); }
}
__device__ __forceinline__ void pf_rows(const KArgs& a, int l, int gw, int NGW, int lane) {
    float g0[8], g1[8], g2[8];
    ld8f(a.in[I_ONA] + l * 512 + lane * 8, g0); ld8f(a.in[I_ONB] + l * 512 + lane * 8, g1); ld8f(a.in[I_ONC] + l * 512 + lane * 8, g2);
    for (int r = gw; r < M; r += 2 * NGW) {
        PfRow A, B; const int r2 = r + NGW; const bool two = r2 < M;
        pf_load(a, r, lane, A); if (two) pf_load(a, r2, lane, B);
        __builtin_amdgcn_sched_barrier(0);
        pf_compute(a, r, lane, A, g0, g1, g2); if (two) pf_compute(a, r2, lane, B, g0, g1, g2);
    }
}

namespace att {
typedef float f32x16 __attribute__((ext_vector_type(16)));
typedef short s16x4 __attribute__((ext_vector_type(4)));
constexpr int OFF_K = 0, OFF_V = 24576, OFF_B = 40960, BUF = 41216, WSC = 3 * BUF;
constexpr int FLG = WSC + NWAVES * 256, ATT_LDS = FLG + 64;
static_assert(ATT_LDS <= RING_BYTES, "attention LDS");
__device__ __forceinline__ int v_st(int k, int c) { const int kk = (k & ~0xC) | ((k & 4) << 1) | ((k & 8) >> 1); return ((kk >> 3) * 4 + (c >> 5)) * 512 + ((kk & 7) * 32 + (c & 31)) * 2; }
__device__ __forceinline__ int v_rd_base(int lane) { return ((lane & 3) << 3) | (((lane >> 2) & 3) << 6) | (((lane >> 4) & 1) << 5) | (((lane >> 5) & 1) << 8); }
constexpr int v_rd_off(int d0, int ks, int half) { return d0 * 512 + ks * 4096 + half * 2048; }
__device__ __forceinline__ int crow(int r, int hi) { return (r & 3) + 8 * (r >> 2) + 4 * hi; }
__device__ __forceinline__ bf16x8 mk8(s16x4 l, s16x4 h) { return (bf16x8){l[0], l[1], l[2], l[3], h[0], h[1], h[2], h[3]}; }
__device__ __forceinline__ void pv_tile(f32x16* o, unsigned vb, bf16x8 pa0, bf16x8 pa1, bf16x8 pa2, bf16x8 pa3) {
#define TRRD(dst, off) asm volatile("ds_read_b64_tr_b16 %0, %1 offset:%2" : "=&v"(dst) : "v"(vb), "i"(off) : "memory")
#define PV_D0(d0) do { s16x4 l0, l1, l2, l3, h0, h1, h2, h3; constexpr int b_ = v_rd_off(d0, 0, 0); \
        TRRD(l0, b_); TRRD(h0, b_ + 2048); TRRD(l1, b_ + 4096); TRRD(h1, b_ + 6144); TRRD(l2, b_ + 8192); TRRD(h2, b_ + 10240); TRRD(l3, b_ + 12288); TRRD(h3, b_ + 14336); \
        asm volatile("s_waitcnt lgkmcnt(0)" ::: "memory"); __builtin_amdgcn_sched_barrier(0); \
        o[d0] = __builtin_amdgcn_mfma_f32_32x32x16_bf16(pa0, mk8(l0, h0), o[d0], 0, 0, 0); \
        o[d0] = __builtin_amdgcn_mfma_f32_32x32x16_bf16(pa1, mk8(l1, h1), o[d0], 0, 0, 0); \
        o[d0] = __builtin_amdgcn_mfma_f32_32x32x16_bf16(pa2, mk8(l2, h2), o[d0], 0, 0, 0); \
        o[d0] = __builtin_amdgcn_mfma_f32_32x32x16_bf16(pa3, mk8(l3, h3), o[d0], 0, 0, 0); } while (0)
    __builtin_amdgcn_s_setprio(1); PV_D0(0); PV_D0(1); PV_D0(2); PV_D0(3); __builtin_amdgcn_s_setprio(0);
#undef PV_D0
#undef TRRD
}
__device__ __forceinline__ void glds16(const void* gsrc, unsigned lds_dst) { unsigned keep;
    asm volatile("s_mov_b32 %0, m0\n\ts_mov_b32 m0, %2\n\ts_nop 0\n\tglobal_load_lds_dwordx4 %1, off\n\ts_mov_b32 m0, %0" : "=&s"(keep) : "v"(gsrc), "s"(lds_dst) : "memory"); }
__device__ __forceinline__ void glds4(const void* gsrc, unsigned lds_dst) { unsigned keep;
    asm volatile("s_mov_b32 %0, m0\n\ts_mov_b32 m0, %2\n\ts_nop 0\n\tglobal_load_lds_dword %1, off\n\ts_mov_b32 m0, %0" : "=&s"(keep) : "v"(gsrc), "s"(lds_dst) : "memory"); }
typedef short v4i16_t __attribute__((ext_vector_type(4)));
__device__ __forceinline__ s16x4 vtr(const LAS unsigned char* p) { return __builtin_bit_cast(s16x4, __builtin_amdgcn_ds_read_tr16_b64_v4i16((LAS v4i16_t*)p)); }
__device__ __forceinline__ void pack_p(const f32x16& p0, const f32x16& p1, bf16x8& pa0, bf16x8& pa1, bf16x8& pa2, bf16x8& pa3) {
#define PK4(P, B_, OUT) do { unsigned a0 = pkbf(P[B_ + 0], P[B_ + 1]), a1 = pkbf(P[B_ + 2], P[B_ + 3]), b0 = pkbf(P[B_ + 4], P[B_ + 5]), b1 = pkbf(P[B_ + 6], P[B_ + 7]); \
        auto r0 = __builtin_amdgcn_permlane32_swap(a0, b0, false, false); auto r1 = __builtin_amdgcn_permlane32_swap(a1, b1, false, false); \
        v4u w = {r0[0], r1[0], r0[1], r1[1]}; OUT = __builtin_bit_cast(bf16x8, w); } while (0)
    PK4(p0, 0, pa0); PK4(p0, 8, pa1); PK4(p1, 0, pa2); PK4(p1, 8, pa3);
#undef PK4
}
struct UnitDesc { int h, qrow0, nq, krow0, qpos0, nkeys, t_lo, t_hi, part; };
template <int TYPE  >
__device__ __forceinline__ void attn_unit(LAS unsigned char* L, unsigned char* ws, const UnitDesc U, const float kmax, const int wid, const float* gq = nullptr) {
    constexpr int DK = TYPE == 2 ? QKD : HD, ND = DK / 16, NKC = DK / 64, CPR = DK / 8, KROWB = DK * 2;
    constexpr int QP = TYPE == 2 ? NQC : 512, KP = QP, VP = TYPE == 2 ? NKV : 512;
    const int lane = fresh_lane(), tid = wid * 64 + lane, r32 = lane & 31, hi = lane >> 5;
    const bf16* Qg = (const bf16*)(ws + (TYPE == 0 ? WS_QA : TYPE == 1 ? WS_QB : (FOLD_QC ? WS_QCR : WS_QC))) + (size_t)U.qrow0 * QP + U.h * DK;
    const bf16* Kg = (const bf16*)(ws + (TYPE == 0 ? WS_KA : TYPE == 1 ? WS_KB : WS_KC)) + (size_t)U.krow0 * KP + U.h * DK;
    const bf16* Vg = (const bf16*)(ws + (TYPE == 0 ? WS_VA : TYPE == 1 ? WS_VB : WS_KVR)) + (size_t)U.krow0 * VP + (TYPE == 2 ? U.h * 256 + 128 : U.h * HD);
    const float* FBh = (const float*)(ws + WS_FBIAS) + (size_t)U.h * NKRP + U.krow0;
    const bool wact = wid * 32 < U.nq;
    const int qlo = U.qpos0 + wid * 32, qpos = qlo + r32;
    const int NT = U.t_hi - U.t_lo;
    int kgoff[NKC], vgoff[2];
#pragma unroll
    for (int j = 0; j < NKC; ++j) { const int p = 64 * (wid + 8 * j) + lane, row = p / CPR, cpos = p % CPR, cc = CPR == 16 ? (cpos ^ (row & 15)) : ((cpos & ~7) | ((cpos ^ (row >> 1)) & 7)); kgoff[j] = row * KP + cc * 8; }
#pragma unroll
    for (int j = 0; j < 2; ++j) { const int p = 64 * (wid + 8 * j) + lane, st = p >> 5, q = p & 31, kk = ((st >> 2) << 3) | (q >> 2), c = (st & 3) * 32 + (q & 3) * 8;
        const int k = (kk & ~0xC) | ((kk & 4) << 1) | ((kk & 8) >> 1); vgoff[j] = k * VP + c; }
#define ST_DMA(t, bf) do { const int kb_ = (t) * 64; const unsigned B_ = (unsigned)__builtin_amdgcn_readfirstlane((int)(unsigned)(size_t)(L + (bf) * BUF)); \
        _Pragma("unroll") for (int j = 0; j < NKC; ++j) glds16(Kg + (size_t)kb_ * KP + kgoff[j], B_ + OFF_K + (wid + 8 * j) * 1024); \
        _Pragma("unroll") for (int j = 0; j < 2; ++j) glds16(Vg + (size_t)kb_ * VP + vgoff[j], B_ + OFF_V + (wid + 8 * j) * 1024); \
        if (TYPE == 0 && wid == 0) glds4(FBh + kb_ + lane, B_ + OFF_B); } while (0)
    constexpr int DIST = ATT_LAG ? 1 : 2;
    ST_DMA(U.t_hi - 1, 0); if (DIST == 2 && NT > 1) ST_DMA(U.t_hi - 2, 1);
    bf16x8 qr[ND];
    if (wact) {
#pragma unroll
        for (int d0 = 0; d0 < ND; ++d0) qr[d0] = *(const bf16x8*)(Qg + (size_t)(wid * 32 + r32) * QP + d0 * 16 + hi * 8);
        if constexpr (TYPE == 2 && FOLD_QC) {
            float ss = 0.f;
#pragma unroll
            for (int d0 = 0; d0 < ND; ++d0)
#pragma unroll
                for (int e = 0; e < 8; ++e) { const float f_ = __uint_as_float((unsigned)(unsigned short)qr[d0][e] << 16); ss += f_ * f_; }
            { auto rr = __builtin_amdgcn_permlane32_swap(__float_as_uint(ss), __float_as_uint(ss), false, false); ss = __uint_as_float(rr[0]) + __uint_as_float(rr[1]); }
            float rc = 1.f;
            if (FUSE_B) { const float* cs_ = (const float*)(ws + WS_CQSS) + (size_t)(U.qrow0 + wid * 32 + r32) * 16; float t_ = 0.f;
#pragma unroll
                for (int i = 0; i < 4; ++i) { const f32x4 v_ = *(const f32x4*)(cs_ + 4 * i); t_ += (v_[0] + v_[1]) + (v_[2] + v_[3]); }
                rc = 1.0f / sqrtf(t_ * (1.f / 512.f) + EPS); }
            const float rs = rc / sqrtf(ss * rc * rc * (1.f / 192.f) + EPS) * QS_C;
            const f32x2* rope = (const f32x2*)(ws + WS_ROPE) + (size_t)(U.qpos0 + wid * 32 + r32) * 32;
#pragma unroll
            for (int d0 = 0; d0 < 8; ++d0) { float g[8], y[8]; ld8f(gq + d0 * 16 + hi * 8, g);
#pragma unroll
                for (int e = 0; e < 8; ++e) y[e] = __uint_as_float((unsigned)(unsigned short)qr[d0][e] << 16) * rs * g[e];
                const v4u w_ = pack8(y); qr[d0] = __builtin_bit_cast(bf16x8, w_); }
#pragma unroll
            for (int d0 = 8; d0 < 10; ++d0) { float g1[8], g2[8], y1[8], y2[8]; ld8f(gq + d0 * 16 + hi * 8, g1); ld8f(gq + (d0 + 2) * 16 + hi * 8, g2);
#pragma unroll
                for (int e = 0; e < 8; ++e) { const f32x2 cs = rope[(d0 - 8) * 16 + hi * 8 + e];
                    const float u1 = __uint_as_float((unsigned)(unsigned short)qr[d0][e] << 16) * rs * g1[e], u2 = __uint_as_float((unsigned)(unsigned short)qr[d0 + 2][e] << 16) * rs * g2[e];
                    y1[e] = u1 * cs.x - u2 * cs.y; y2[e] = u2 * cs.x + u1 * cs.y; }
                const v4u w1_ = pack8(y1), w2_ = pack8(y2); qr[d0] = __builtin_bit_cast(bf16x8, w1_); qr[d0 + 2] = __builtin_bit_cast(bf16x8, w2_); }
        }
    } else {
#pragma unroll
        for (int d0 = 0; d0 < ND; ++d0) qr[d0] = (bf16x8){0, 0, 0, 0, 0, 0, 0, 0};
    }
    LAS float* wsc = (LAS float*)(L + WSC + wid * 256);
    constexpr bool NEGM = ATT_NEGM && TYPE != 1;
    float m_reg = NEGM ? 0.f : -1e30f, l_reg = 0.f, Rsum = 0.f; f32x16 o[4];
    f32x16 negm = (f32x16){}; bool fresh = true;
    constexpr float EXIT_FOX = -60.f, EXIT_SB = -42.f;
    float zb = 0.f; bool wdone = !wact; LAS int* flg = (LAS int*)(L + FLG);
    if (TYPE != 2 && wact) { float q2 = 0.f;
#pragma unroll
        for (int d0 = 0; d0 < ND; ++d0)
#pragma unroll
            for (int e = 0; e < 8; ++e) { const float f_ = __uint_as_float((unsigned)(unsigned short)qr[d0][e] << 16); q2 += f_ * f_; }
        { auto rr = __builtin_amdgcn_permlane32_swap(__float_as_uint(q2), __float_as_uint(q2), false, false); q2 = __uint_as_float(rr[0]) + __uint_as_float(rr[1]); }
        zb = sqrtf(q2) * kmax * 1.02f + 0.1f; }
#pragma unroll
    for (int d = 0; d < 4; ++d) o[d] = (f32x16){};
    int kbase[4];
#pragma unroll
    for (int dd = 0; dd < 4; ++dd) kbase[dd] = r32 * KROWB + (((dd * 2 + hi) ^ (CPR == 16 ? (r32 & 15) : ((r32 >> 1) & 7))) << 4);
    const unsigned vrd = (unsigned)(size_t)(L + OFF_V) + (unsigned)v_rd_base(lane);
    VM_WAIT(); __syncthreads();
    int bf = 0, bf2 = DIST;
    const bool lagw = ATT_LAG == 1 ? wid >= 4 : ATT_LAG == 2 ? (wid & 1) != 0 : false;
    bool have_prev = false; int bfp = 0; bf16x8 pa0, pa1, pa2, pa3;
    pa0 = pa1 = pa2 = pa3 = (bf16x8){0, 0, 0, 0, 0, 0, 0, 0};
    for (int i = 0; i < NT; ++i) {
        const int t = U.t_hi - 1 - i, kb = t * 64;
        if (TYPE != 2 && i > 0) { const LAS int* f_ = flg + ((i - 1) & 1) * 8; if ((f_[0] & f_[1] & f_[2] & f_[3] & f_[4] & f_[5] & f_[6] & f_[7]) != 0) break; }
        if (i + DIST < NT) ST_DMA(t - DIST, bf2);
        float bnext = 0.f; if (TYPE == 0) bnext = *(const LAS float*)(L + bf * BUF + OFF_B);
        bool act, needmask;
        if (TYPE == 0) { act = kb <= qlo + 31; needmask = kb + 63 > qlo; }
        else if (TYPE == 1) { act = kb < qlo + 31; needmask = kb + 63 >= qlo; }
        else { act = t <= (qlo >> 6); needmask = kb + 64 > U.nkeys; }
        act = act && !wdone;
        if (ATT_LAG && have_prev) { pv_tile(o, vrd + (unsigned)(bfp * BUF), pa0, pa1, pa2, pa3); have_prev = false; }
        if (ATT_PIPE && act && TYPE != 1 && !needmask) {
            LAS unsigned char* Bf = L + bf * BUF;
            f32x16 p0 = (f32x16){}, p1 = (f32x16){};
            bf16x8 kf[4]; float al0 = 1.f, al1 = 1.f, pmx = 0.f, mn_ = 0.f, ps_ = 0.f;
#define KFR(d0_, half_) (*(const LAS bf16x8*)(Bf + OFF_K + (CPR == 16 ? (kbase[(d0_) & 3] ^ (((d0_) >> 2) * 128)) : (kbase[(d0_) & 3] + ((d0_) >> 2) * 128)) + (half_) * 32 * KROWB))
#define SB0() __builtin_amdgcn_sched_barrier(0)
#define QK_MF(P, half_, j_) do { P = __builtin_amdgcn_mfma_f32_32x32x16_bf16(kf[(j_) & 3], qr[j_], P, 0, 0, 0); if ((j_) + 4 < ND) kf[(j_) & 3] = KFR((j_) + 4, half_); } while (0)
#define SMSTEP(k_, P, KOFF, AL, PA, PB) do { \
            if ((k_) == 0) { if (TYPE == 0) { _Pragma("unroll") for (int g = 0; g < 4; ++g) { const f32x4 b_ = *(const LAS f32x4*)(Bf + OFF_B + ((KOFF) + 8 * g + 4 * hi) * 4); \
                                 _Pragma("unroll") for (int e = 0; e < 4; ++e) P[4 * g + e] += b_[e]; } } } \
            else if ((k_) == 1) { pmx = fmaxf(fmaxf(fmaxf(P[0], P[1]), fmaxf(P[2], P[3])), fmaxf(fmaxf(P[4], P[5]), fmaxf(P[6], P[7]))); } \
            else if ((k_) == 2) { pmx = fmaxf(pmx, fmaxf(fmaxf(fmaxf(P[8], P[9]), fmaxf(P[10], P[11])), fmaxf(fmaxf(P[12], P[13]), fmaxf(P[14], P[15])))); \
                auto rr_ = __builtin_amdgcn_permlane32_swap(__float_as_uint(pmx), __float_as_uint(pmx), false, false); pmx = fmaxf(__uint_as_float(rr_[0]), __uint_as_float(rr_[1])); \
                mn_ = fmaxf(m_reg, pmx); AL = __builtin_amdgcn_exp2f(m_reg - mn_); m_reg = mn_; } \
            else if ((k_) == 3) { _Pragma("unroll") for (int r = 0; r < 6; ++r) P[r] = __builtin_amdgcn_exp2f(P[r] - mn_); } \
            else if ((k_) == 4) { _Pragma("unroll") for (int r = 6; r < 11; ++r) P[r] = __builtin_amdgcn_exp2f(P[r] - mn_); } \
            else if ((k_) == 5) { _Pragma("unroll") for (int r = 11; r < 16; ++r) P[r] = __builtin_amdgcn_exp2f(P[r] - mn_); } \
            else if ((k_) == 6) { ps_ = ((P[0] + P[1]) + (P[2] + P[3])) + ((P[4] + P[5]) + (P[6] + P[7])) + (((P[8] + P[9]) + (P[10] + P[11])) + ((P[12] + P[13]) + (P[14] + P[15]))); \
                auto rr_ = __builtin_amdgcn_permlane32_swap(__float_as_uint(ps_), __float_as_uint(ps_), false, false); ps_ = __uint_as_float(rr_[0]) + __uint_as_float(rr_[1]); l_reg = l_reg * AL + ps_; } \
            else if ((k_) == 7) { \
                { unsigned a0_ = pkbf(P[0], P[1]), a1_ = pkbf(P[2], P[3]), b0_ = pkbf(P[4], P[5]), b1_ = pkbf(P[6], P[7]); auto r0_ = __builtin_amdgcn_permlane32_swap(a0_, b0_, false, false); auto r1_ = __builtin_amdgcn_permlane32_swap(a1_, b1_, false, false); \
                  v4u w_ = {r0_[0], r1_[0], r0_[1], r1_[1]}; PA = __builtin_bit_cast(bf16x8, w_); } \
                { unsigned a0_ = pkbf(P[8], P[9]), a1_ = pkbf(P[10], P[11]), b0_ = pkbf(P[12], P[13]), b1_ = pkbf(P[14], P[15]); auto r0_ = __builtin_amdgcn_permlane32_swap(a0_, b0_, false, false); auto r1_ = __builtin_amdgcn_permlane32_swap(a1_, b1_, false, false); \
                  v4u w_ = {r0_[0], r1_[0], r0_[1], r1_[1]}; PB = __builtin_bit_cast(bf16x8, w_); } } } while (0)
#define RESC_O(AL) do { if (__any((AL) < 1.f)) { if (hi == 0) wsc[r32] = (AL); LDS_WAIT(); \
                _Pragma("unroll") for (int g = 0; g < 4; ++g) { const f32x4 al_ = *(const LAS f32x4*)(wsc + 8 * g + 4 * hi); \
                    _Pragma("unroll") for (int d = 0; d < 4; ++d) _Pragma("unroll") for (int e = 0; e < 4; ++e) o[d][4 * g + e] *= al_[e]; } } } while (0)
            kf[0] = KFR(0, 0); kf[1] = KFR(1, 0); kf[2] = KFR(2, 0); kf[3] = KFR(3, 0); SB0();
#pragma unroll
            for (int j = 0; j < ND; ++j) { QK_MF(p0, 0, j); SB0(); }
            kf[0] = KFR(0, 1); kf[1] = KFR(1, 1); kf[2] = KFR(2, 1); kf[3] = KFR(3, 1); SB0();
#pragma unroll
            for (int j = 0; j < ND; ++j) { QK_MF(p1, 1, j);
#pragma unroll
                for (int k = 0; k < 8; ++k) if ((k * ND) / 8 == j) SMSTEP(k, p0, 0, al0, pa0, pa1);
                SB0(); }
            RESC_O(al0);
            const LAS unsigned char* vb_ = L + OFF_V + bf * BUF + v_rd_base(lane);
            s16x4 vl[2][4];
#define VRD_(set_, d0_, h_) do { vl[set_][0] = vtr(vb_ + v_rd_off(d0_, 2 * (h_), 0)); vl[set_][1] = vtr(vb_ + v_rd_off(d0_, 2 * (h_), 1)); \
                                 vl[set_][2] = vtr(vb_ + v_rd_off(d0_, 2 * (h_) + 1, 0)); vl[set_][3] = vtr(vb_ + v_rd_off(d0_, 2 * (h_) + 1, 1)); } while (0)
            VRD_(0, 0, 0); SB0();
#pragma unroll
            for (int d0 = 0; d0 < 4; ++d0) { if (d0 + 1 < 4) VRD_((d0 + 1) & 1, d0 + 1, 0); SB0();
                o[d0] = __builtin_amdgcn_mfma_f32_32x32x16_bf16(pa0, mk8(vl[d0 & 1][0], vl[d0 & 1][1]), o[d0], 0, 0, 0); SMSTEP(2 * d0, p1, 32, al1, pa2, pa3); SB0();
                o[d0] = __builtin_amdgcn_mfma_f32_32x32x16_bf16(pa1, mk8(vl[d0 & 1][2], vl[d0 & 1][3]), o[d0], 0, 0, 0); SMSTEP(2 * d0 + 1, p1, 32, al1, pa2, pa3); SB0(); }
            RESC_O(al1);
            VRD_(0, 0, 1); SB0();
#pragma unroll
            for (int d0 = 0; d0 < 4; ++d0) { if (d0 + 1 < 4) VRD_((d0 + 1) & 1, d0 + 1, 1); SB0();
                o[d0] = __builtin_amdgcn_mfma_f32_32x32x16_bf16(pa2, mk8(vl[d0 & 1][0], vl[d0 & 1][1]), o[d0], 0, 0, 0);
                o[d0] = __builtin_amdgcn_mfma_f32_32x32x16_bf16(pa3, mk8(vl[d0 & 1][2], vl[d0 & 1][3]), o[d0], 0, 0, 0); SB0(); }
#undef KFR
#undef QK_MF
#undef SMSTEP
#undef RESC_O
#undef VRD_
#undef SB0
        } else if (act) {
            LAS unsigned char* Bf = L + bf * BUF;
            f32x16 p0 = (f32x16){}, p1 = (f32x16){};
            if (NEGM) { p0 = negm; p1 = negm; }
#define KFR(d0_, half_) (*(const LAS bf16x8*)(Bf + OFF_K + (CPR == 16 ? (kbase[(d0_) & 3] ^ (((d0_) >> 2) * 128)) : (kbase[(d0_) & 3] + ((d0_) >> 2) * 128)) + (half_) * 32 * KROWB))
            bf16x8 kA[4], kB[4];
            kA[0] = KFR(0, 0); kA[1] = KFR(0, 1); kA[2] = KFR(1, 0); kA[3] = KFR(1, 1);
            __builtin_amdgcn_s_setprio(1);
#pragma unroll
            for (int d0 = 0; d0 < ND; d0 += 4) {
                kB[0] = KFR(d0 + 2, 0); kB[1] = KFR(d0 + 2, 1); kB[2] = KFR(d0 + 3, 0); kB[3] = KFR(d0 + 3, 1);
                __builtin_amdgcn_sched_barrier(0);
                p0 = __builtin_amdgcn_mfma_f32_32x32x16_bf16(kA[0], qr[d0], p0, 0, 0, 0); p1 = __builtin_amdgcn_mfma_f32_32x32x16_bf16(kA[1], qr[d0], p1, 0, 0, 0);
                p0 = __builtin_amdgcn_mfma_f32_32x32x16_bf16(kA[2], qr[d0 + 1], p0, 0, 0, 0); p1 = __builtin_amdgcn_mfma_f32_32x32x16_bf16(kA[3], qr[d0 + 1], p1, 0, 0, 0);
                __builtin_amdgcn_sched_barrier(0);
                if (d0 + 4 < ND) { kA[0] = KFR(d0 + 4, 0); kA[1] = KFR(d0 + 4, 1); kA[2] = KFR(d0 + 5, 0); kA[3] = KFR(d0 + 5, 1); }
                __builtin_amdgcn_sched_barrier(0);
                p0 = __builtin_amdgcn_mfma_f32_32x32x16_bf16(kB[0], qr[d0 + 2], p0, 0, 0, 0); p1 = __builtin_amdgcn_mfma_f32_32x32x16_bf16(kB[1], qr[d0 + 2], p1, 0, 0, 0);
                p0 = __builtin_amdgcn_mfma_f32_32x32x16_bf16(kB[2], qr[d0 + 3], p0, 0, 0, 0); p1 = __builtin_amdgcn_mfma_f32_32x32x16_bf16(kB[3], qr[d0 + 3], p1, 0, 0, 0);
                __builtin_amdgcn_sched_barrier(0);
            }
            __builtin_amdgcn_s_setprio(0);
#undef KFR
            if (TYPE != 1) {
                if (TYPE == 0) {
#pragma unroll
                    for (int g = 0; g < 4; ++g) { const f32x4 b0 = *(const LAS f32x4*)(Bf + OFF_B + (8 * g + 4 * hi) * 4), b1 = *(const LAS f32x4*)(Bf + OFF_B + (32 + 8 * g + 4 * hi) * 4);
#pragma unroll
                        for (int e = 0; e < 4; ++e) { p0[4 * g + e] += b0[e]; p1[4 * g + e] += b1[e]; } }
                }
                if (needmask) { const float NEG = -__builtin_inff();
#pragma unroll
                    for (int r = 0; r < 16; ++r) { const int kv = kb + crow(r, hi);
                        if (TYPE == 0) { if (kv > qpos) p0[r] = NEG; if (kv + 32 > qpos) p1[r] = NEG; }
                        else { if (kv >= U.nkeys) p0[r] = NEG; if (kv + 32 >= U.nkeys) p1[r] = NEG; } } }
                float pmax = p0[0];
#pragma unroll
                for (int r = 1; r < 16; ++r) pmax = fmaxf(pmax, p0[r]);
#pragma unroll
                for (int r = 0; r < 16; ++r) pmax = fmaxf(pmax, p1[r]);
                { auto rr = __builtin_amdgcn_permlane32_swap(__float_as_uint(pmax), __float_as_uint(pmax), false, false); pmax = fmaxf(__uint_as_float(rr[0]), __uint_as_float(rr[1])); }
                float alpha = 1.f, ps = 0.f;
                if (NEGM) {
                    const bool upd = pmax > -__builtin_inff() && (fresh || pmax > 8.0f);
                    if (__any(upd)) { const float dl = upd ? pmax : 0.f; alpha = (upd && !fresh) ? __builtin_amdgcn_exp2f(-dl) : 1.f; m_reg += dl; fresh = fresh && !upd;
#pragma unroll
                        for (int r = 0; r < 16; ++r) { p0[r] -= dl; p1[r] -= dl; negm[r] = -m_reg; } }
#pragma unroll
                    for (int r = 0; r < 16; ++r) { p0[r] = __builtin_amdgcn_exp2f(p0[r]); p1[r] = __builtin_amdgcn_exp2f(p1[r]); ps += p0[r] + p1[r]; }
                } else {
                const float mn = pmax > m_reg + 8.0f ? pmax : m_reg; alpha = __builtin_amdgcn_exp2f(m_reg - mn); m_reg = mn;
#pragma unroll
                for (int r = 0; r < 16; ++r) { p0[r] = __builtin_amdgcn_exp2f(p0[r] - mn); p1[r] = __builtin_amdgcn_exp2f(p1[r] - mn); ps += p0[r] + p1[r]; }
                }
                { auto rr = __builtin_amdgcn_permlane32_swap(__float_as_uint(ps), __float_as_uint(ps), false, false); ps = __uint_as_float(rr[0]) + __uint_as_float(rr[1]); }
                l_reg = l_reg * alpha + ps;
                if (__any(alpha < 1.f)) { if (hi == 0) wsc[r32] = alpha; LDS_WAIT();
#pragma unroll
                    for (int g = 0; g < 4; ++g) { const f32x4 al = *(const LAS f32x4*)(wsc + 8 * g + 4 * hi);
#pragma unroll
                        for (int d = 0; d < 4; ++d)
#pragma unroll
                            for (int e = 0; e < 4; ++e) o[d][4 * g + e] *= al[e]; } }
            } else {
                f32x16 k0, k1;
#pragma unroll
                for (int r = 0; r < 16; ++r) { const int kv = kb + crow(r, hi); const bool v0 = !needmask || kv < qpos, v1 = !needmask || kv + 32 < qpos;
                    const float z0 = p0[r], z1 = p1[r];
                    const float s0 = fmaxf(z0, 0.f) + LN2 * __builtin_amdgcn_logf(1.0f + __builtin_amdgcn_exp2f(-LOG2E * fabsf(z0)));
                    const float s1 = fmaxf(z1, 0.f) + LN2 * __builtin_amdgcn_logf(1.0f + __builtin_amdgcn_exp2f(-LOG2E * fabsf(z1)));
                    k0[r] = v0 ? -s0 : 0.f; k1[r] = v1 ? -s1 : 0.f; }
                float G[8], T[8], X[8];
#pragma unroll
                for (int g = 0; g < 4; ++g) { G[g] = (k0[4 * g] + k0[4 * g + 1]) + (k0[4 * g + 2] + k0[4 * g + 3]); G[4 + g] = (k1[4 * g] + k1[4 * g + 1]) + (k1[4 * g + 2] + k1[4 * g + 3]); }
#pragma unroll
                for (int g = 0; g < 8; ++g) { auto rr = __builtin_amdgcn_permlane32_swap(__float_as_uint(G[g]), __float_as_uint(G[g]), false, false);
                    const float a_lo = __uint_as_float(rr[0]), a_hi = __uint_as_float(rr[1]);
                    T[g] = a_lo + a_hi; X[g] = hi == 0 ? a_hi : 0.f; }
                float later = Rsum;
#pragma unroll
                for (int g = 7; g >= 0; --g) { const float base = later + X[g];
                    if (g >= 4) { float s = base;
#pragma unroll
                        for (int e = 3; e >= 0; --e) { s += k1[4 * (g - 4) + e]; k1[4 * (g - 4) + e] = s; } }
                    else { float s = base;
#pragma unroll
                        for (int e = 3; e >= 0; --e) { s += k0[4 * g + e]; k0[4 * g + e] = s; } }
                    later += T[g]; }
                Rsum = later;
#pragma unroll
                for (int r = 0; r < 16; ++r) { const int kv = kb + crow(r, hi); const bool v0 = !needmask || kv < qpos, v1 = !needmask || kv + 32 < qpos;
                    const float a0 = __builtin_amdgcn_exp2f(LOG2E * (p0[r] + k0[r])), a1 = __builtin_amdgcn_exp2f(LOG2E * (p1[r] + k1[r]));
                    p0[r] = v0 ? a0 : 0.f; p1[r] = v1 ? a1 : 0.f; }
            }
            pack_p(p0, p1, pa0, pa1, pa2, pa3);
            if (ATT_LAG && lagw) { have_prev = true; bfp = bf; } else pv_tile(o, vrd + (unsigned)(bf * BUF), pa0, pa1, pa2, pa3);
        }
        if (TYPE != 2) { if (!wdone && kb > 0) wdone = TYPE == 1 ? __all(zb + Rsum < EXIT_SB) : __all(!(NEGM && fresh) && zb + bnext - m_reg < EXIT_FOX); if (lane == 0) flg[(i & 1) * 8 + wid] = wdone ? 1 : 0; }
        if (DIST == 2 && i + 2 < NT) { if (NKC == 2) asm volatile("s_waitcnt vmcnt(4)" ::: "memory"); else asm volatile("s_waitcnt vmcnt(5)" ::: "memory"); } else VM_WAIT();
        __syncthreads();
        bf = bf == 2 ? 0 : bf + 1; bf2 = bf2 == 2 ? 0 : bf2 + 1;
    }
    if (ATT_LAG && have_prev) pv_tile(o, vrd + (unsigned)(bfp * BUF), pa0, pa1, pa2, pa3);
    VM_WAIT(); __syncthreads();
#undef ST_DMA
    if (wact) {
        float rli[16];
        if (TYPE != 1) { if (hi == 0) wsc[r32] = l_reg; LDS_WAIT();
#pragma unroll
            for (int g = 0; g < 4; ++g) { const f32x4 lv = *(const LAS f32x4*)(wsc + 8 * g + 4 * hi);
#pragma unroll
                for (int e = 0; e < 4; ++e) rli[4 * g + e] = 1.0f / lv[e]; } }
        else {
#pragma unroll
            for (int r = 0; r < 16; ++r) rli[r] = 1.f; }
        const bool partial = TYPE == 2 && U.part >= 0;
        bf16* Ow = partial ? (bf16*)(ws + WS_PO) + ((size_t)U.part * SEQ + U.qrow0 + wid * 32) * 512 + U.h * HD
                           : (bf16*)(ws + WS_ATT) + (size_t)(U.qrow0 + wid * 32) * MIXW + TYPE * 512 + U.h * HD;
        const int opitch = partial ? 512 : MIXW;
        if (partial && hi == 0) *(f32x2*)((float*)(ws + WS_PML) + (((size_t)U.part * SEQ + U.qrow0 + wid * 32 + r32) * 4 + U.h) * 2) = (f32x2){m_reg, l_reg};
#pragma unroll
        for (int r = 0; r < 16; ++r) { const int orow = crow(r, hi);
#pragma unroll
            for (int d0 = 0; d0 < 4; ++d0) { const float v = o[d0][r] * rli[r]; const float vn = __shfl_xor(v, 1);
                if ((r32 & 1) == 0) *(unsigned*)(Ow + (size_t)orow * opitch + d0 * 32 + r32) = pkbf(v, vn); } }
    }
}
constexpr int NU_MLA_FULL = 4 * 96, NU_MLA = NU_MLA_FULL + 4 * 64, NU_PROMPT = NU_MLA + 2 * 4 * (SEQ / 256), NU_SAMPLE = 3 * DB * 4, NU = NU_PROMPT + NU_SAMPLE;
}

__device__ __forceinline__ float rstd_sample(const float* rsss, int srow, int kq) {
    const float* p = rsss + (size_t)srow * 128 + kq * 32; float s = 0.f;
#pragma unroll
    for (int i = 0; i < 8; ++i) { const f32x4 v = *(const f32x4*)(p + 4 * i); s += (v[0] + v[1]) + (v[2] + v[3]); }
    s += __shfl_xor(s, 16); s += __shfl_xor(s, 32);
    return 1.0f / sqrtf(s * (1.f / DM) + EPS);
}
struct ThinArgs { const bf16* A; const bf16* Bt; int K, lda, ldb; int ncs; bf16* Ob; int ldo; const float* rsss_in; const float* xin; float* xout; bf16* xn; const float* gain; float* rsss_out; };
template <int MODE  , int NBF, int KC>
__device__ __forceinline__ void thin_gemm(const ThinArgs T, LAS unsigned char* L, int wave, int bx) {
    constexpr int KSN = KC / 32, PITCH = KC * 2 + 16, BUFB = NBF * 16 * PITCH, PPR = KC / 8, NPT = NBF * KC / 256;
    static_assert(3 * BUFB <= RING_BYTES, "thin LDS");
    const int lane = fresh_lane(), tid = wave * 64 + lane, m16 = lane & 15, kq = lane >> 4, K = T.K, nch = K / KC;
    for (int q = bx; q < T.ncs * 2; q += gridDim.x) {
        const int cs = q % T.ncs, rh = q / T.ncs, row0 = rh * 128 + wave * 16;
        const bf16* ap = T.A + (size_t)(row0 + m16) * T.lda + kq * 8;
        const bf16* bsrc[NPT]; int bdst[NPT];
#pragma unroll
        for (int i = 0; i < NPT; ++i) { const int p = tid + 512 * i, row = p / PPR, kc = p % PPR, b = row >> 4, m = row & 15; size_t brow;
            if (MODE == 1) { const int f = cs * (NBF / 2) * 16 + (b % (NBF / 2)) * 16 + m; brow = (size_t)(f >> 7) * 256 + (f & 127) + (b >= NBF / 2 ? 128 : 0); }
            else brow = (size_t)cs * NBF * 16 + row;
            bsrc[i] = T.Bt + brow * T.ldb + kc * 8; bdst[i] = row * PITCH + kc * 16; }
        f32x4 acc[NBF];
#pragma unroll
        for (int b = 0; b < NBF; ++b) acc[b] = (f32x4){0.f, 0.f, 0.f, 0.f};
        bf16x8 fa[3][KSN]; v4u stb[3][NPT];
#define T2_LOAD(S_, k0) do { _Pragma("unroll") for (int i = 0; i < NPT; ++i) stb[S_][i] = *(const v4u*)(bsrc[i] + (k0)); \
            _Pragma("unroll") for (int j = 0; j < KSN; ++j) fa[S_][j] = *(const bf16x8*)(ap + (k0) + 32 * j); } while (0)
#define T2_WRITE(S_) do { _Pragma("unroll") for (int i = 0; i < NPT; ++i) *(LAS v4u*)(L + (S_) * BUFB + bdst[i]) = stb[S_][i]; } while (0)
#define T2_MMA(S_) do { _Pragma("unroll") for (int j = 0; j < KSN; ++j) _Pragma("unroll") for (int b = 0; b < NBF; ++b) \
            acc[b] = __builtin_amdgcn_mfma_f32_16x16x32_bf16(*(const LAS bf16x8*)(L + (S_) * BUFB + (b * 16 + m16) * PITCH + j * 64 + kq * 16), fa[S_][j], acc[b], 0, 0, 0); } while (0)
#define T2_BAR() asm volatile("s_waitcnt lgkmcnt(0)\n\ts_barrier" ::: "memory")
#define T2_STEP(cc, SC, SN, SL) do { if ((cc) + 2 < nch) { T2_LOAD(SL, ((cc) + 2) * KC); } __builtin_amdgcn_sched_barrier(0); \
            T2_MMA(SC); __builtin_amdgcn_sched_barrier(0); \
            if ((cc) + 1 < nch) { T2_WRITE(SN); } T2_BAR(); } while (0)
        T2_LOAD(0, 0); if (nch > 1) { T2_LOAD(1, KC); } __builtin_amdgcn_sched_barrier(0);
        T2_WRITE(0); T2_BAR();
#pragma unroll 1
        for (int c = 0; c < nch; c += 3) {
            T2_STEP(c, 0, 1, 2);
            if (c + 1 < nch) T2_STEP(c + 1, 1, 2, 0);
            if (c + 2 < nch) T2_STEP(c + 2, 2, 0, 1);
        }
#undef T2_LOAD
#undef T2_WRITE
#undef T2_MMA
#undef T2_BAR
#undef T2_STEP
        const int srow = row0 + m16; const size_t grow = (size_t)SEQ + srow;
        if (MODE == 0) { const float rs = rstd_sample(T.rsss_in, srow, kq);
#pragma unroll
            for (int b = 0; b < NBF; ++b) { const int col = (cs * NBF + b) * 16 + 4 * kq; const f32x4 v = acc[b] * rs;
                f32x2 o; o.x = __uint_as_float(pkbf(v[0], v[1])); o.y = __uint_as_float(pkbf(v[2], v[3])); *(f32x2*)(T.Ob + grow * T.ldo + col) = o; } }
        else if (MODE == 1) { const float rs = rstd_sample(T.rsss_in, srow, kq);
#pragma unroll
            for (int b = 0; b < NBF / 2; ++b) { const int col = (cs * (NBF / 2) + b) * 16 + 4 * kq; const f32x4 g = acc[b] * rs, u = acc[b + NBF / 2] * rs;
                f32x2 o; o.x = __uint_as_float(pkbf(pg8::silu_mul(g[0], u[0]), pg8::silu_mul(g[1], u[1]))); o.y = __uint_as_float(pkbf(pg8::silu_mul(g[2], u[2]), pg8::silu_mul(g[3], u[3])));
                *(f32x2*)(T.Ob + grow * T.ldo + col) = o; } }
        else {
#pragma unroll
            for (int b = 0; b < NBF; ++b) { const int cg = cs * NBF + b, col = cg * 16 + 4 * kq;
                const f32x4 x1 = *(const f32x4*)(T.xin + (size_t)srow * DM + col) + acc[b]; *(f32x4*)(T.xout + (size_t)srow * DM + col) = x1;
                const f32x4 y = x1;
                f32x2 o; o.x = __uint_as_float(pkbf(y[0], y[1])); o.y = __uint_as_float(pkbf(y[2], y[3])); *(f32x2*)(T.xn + grow * LDX + col) = o;
                float ss = (x1[0] * x1[0] + x1[1] * x1[1]) + (x1[2] * x1[2] + x1[3] * x1[3]); ss += __shfl_xor(ss, 16); ss += __shfl_xor(ss, 32);
                if (kq == 0) T.rsss_out[(size_t)srow * 128 + cg] = ss; } }
    }
}

template <int KC>
__device__ __forceinline__ void thin_gemm_ks(const ThinArgs T, LAS unsigned char* L, int wave, int bx) {
    constexpr int NBF = 2, VB = 2 * NBF, KSN = KC / 32, PITCH = KC * 2 + 16, BUFB = VB * 16 * PITCH, PPR = KC / 8, NPT = VB * KC / 256, NCS = DM / (NBF * 16);
    static_assert(2 * BUFB + 4 * NBF * 64 * 16 <= RING_BYTES, "thin LDS");
    const int lane = fresh_lane(), tid = wave * 64 + lane, m16 = lane & 15, kq = lane >> 4, KH = T.K / 2, nch = KH / KC, wh = wave >> 2, w4 = wave & 3;
    LAS f32x4* red = (LAS f32x4*)(L + 2 * BUFB);
    for (int q = bx; q < NCS * 4; q += gridDim.x) {
        const int cs = q % NCS, rg = q / NCS, row0 = rg * 64 + w4 * 16;
        const bf16* ap = T.A + (size_t)(row0 + m16) * T.lda + wh * KH + kq * 8;
        const bf16* bsrc[NPT]; int bdst[NPT];
#pragma unroll
        for (int i = 0; i < NPT; ++i) { const int p = tid + 512 * i, row = p / PPR, kc = p % PPR, vb = row >> 4, m = row & 15;
            bsrc[i] = T.Bt + (size_t)(cs * NBF * 16 + (vb % NBF) * 16 + m) * T.ldb + (vb / NBF) * KH + kc * 8; bdst[i] = row * PITCH + kc * 16; }
        f32x4 acc[NBF];
#pragma unroll
        for (int b = 0; b < NBF; ++b) acc[b] = (f32x4){0.f, 0.f, 0.f, 0.f};
        bf16x8 fa[3][KSN]; v4u stb[3][NPT];
#define T3_LOAD(S_, k0) do { _Pragma("unroll") for (int i = 0; i < NPT; ++i) stb[S_][i] = *(const v4u*)(bsrc[i] + (k0)); \
            _Pragma("unroll") for (int j = 0; j < KSN; ++j) fa[S_][j] = *(const bf16x8*)(ap + (k0) + 32 * j); } while (0)
#define T3_WRITE(S_, cc_) do { _Pragma("unroll") for (int i = 0; i < NPT; ++i) *(LAS v4u*)(L + ((cc_) & 1) * BUFB + bdst[i]) = stb[S_][i]; } while (0)
#define T3_MMA(S_, cc_) do { _Pragma("unroll") for (int j = 0; j < KSN; ++j) _Pragma("unroll") for (int b = 0; b < NBF; ++b) \
            acc[b] = __builtin_amdgcn_mfma_f32_16x16x32_bf16(*(const LAS bf16x8*)(L + ((cc_) & 1) * BUFB + ((wh * NBF + b) * 16 + m16) * PITCH + j * 64 + kq * 16), fa[S_][j], acc[b], 0, 0, 0); } while (0)
#define T3_BAR() asm volatile("s_waitcnt lgkmcnt(0)\n\ts_barrier" ::: "memory")
#define T3_STEP(cc, SC, SN, SL) do { if ((cc) + 2 < nch) { T3_LOAD(SL, ((cc) + 2) * KC); } __builtin_amdgcn_sched_barrier(0); \
            T3_MMA(SC, cc); __builtin_amdgcn_sched_barrier(0); \
            if ((cc) + 1 < nch) { T3_WRITE(SN, (cc) + 1); } T3_BAR(); } while (0)
        T3_LOAD(0, 0); if (nch > 1) { T3_LOAD(1, KC); } __builtin_amdgcn_sched_barrier(0);
        T3_WRITE(0, 0); T3_BAR();
#pragma unroll 1
        for (int c = 0; c < nch; c += 3) {
            T3_STEP(c, 0, 1, 2);
            if (c + 1 < nch) T3_STEP(c + 1, 1, 2, 0);
            if (c + 2 < nch) T3_STEP(c + 2, 2, 0, 1);
        }
#undef T3_LOAD
#undef T3_WRITE
#undef T3_MMA
#undef T3_STEP
        if (wh == 1) {
#pragma unroll
            for (int b = 0; b < NBF; ++b) red[(w4 * NBF + b) * 64 + lane] = acc[b]; }
        T3_BAR();
#undef T3_BAR
        if (wh == 0) {
            const int srow = row0 + m16; const size_t grow = (size_t)SEQ + srow;
#pragma unroll
            for (int b = 0; b < NBF; ++b) { const int cg = cs * NBF + b, col = cg * 16 + 4 * kq;
                const f32x4 x1 = *(const f32x4*)(T.xin + (size_t)srow * DM + col) + (acc[b] + red[(w4 * NBF + b) * 64 + lane]); *(f32x4*)(T.xout + (size_t)srow * DM + col) = x1;
                f32x2 o; o.x = __uint_as_float(pkbf(x1[0], x1[1])); o.y = __uint_as_float(pkbf(x1[2], x1[3])); *(f32x2*)(T.xn + grow * LDX + col) = o;
                float ss = (x1[0] * x1[0] + x1[1] * x1[1]) + (x1[2] * x1[2] + x1[3] * x1[3]); ss += __shfl_xor(ss, 16); ss += __shfl_xor(ss, 32);
                if (kq == 0) T.rsss_out[(size_t)srow * 128 + cg] = ss; } }
    }
}

static_assert(USE_THIN == 1, "the residual epilogue carries only the prompt rows' stream (bf16)");
constexpr int MG = USE_THIN ? SEQ : M;
constexpr int NPH = 1 + 9 * DEPTH;
__global__ void __launch_bounds__(NWAVES * 64, 2) trunk_fwd(KArgs a) {
    extern __shared__ __attribute__((aligned(16))) unsigned char lds_raw[];
    LAS unsigned char* lds = (LAS unsigned char*)lds_raw;
    volatile LAS unsigned* MISC = (volatile LAS unsigned*)(lds + MISC_OFF);
    const int wave = __builtin_amdgcn_readfirstlane(threadIdx.x >> 6);
    const int G = gridDim.x, gw = blockIdx.x * NWAVES + wave, NGW = G * NWAVES;
    unsigned char* ws = a.ws;
    gu32* ctl = (gu32*)(ws + WS_CTL);
    for (int u = wave * 64 + fresh_lane(); u < (LDS_BYTES - LDSCTL_OFF) / 4; u += NWAVES * 64) ((LAS unsigned*)(lds + LDSCTL_OFF))[u] = 0u;
    __syncthreads();
    XcdBarrier bar; bar.bar = (unsigned*)(ctl + CW_BAR); bar.x = 0; bar.st = nullptr;
    if (MK_ONE_LAUNCH) bar = xcd_barrier_post((unsigned*)(ctl + CW_BAR), MISC + 8, wave == 0 && fresh_lane() == 0);
    const int lo = a.ph_lo, hi = a.ph_hi;
#define IN(k) (lo <= (k) && (k) < hi)
#define SEAM(k) do { if (IN(k) && IN((k) + 1)) xcd_barrier(bar, wave == 0 && fresh_lane() == 0); } while (0)

    if (IN(0)) { p0_prologue(a, lds, gw, NGW, fresh_lane(), wave); SEAM(0); }

    for (int l = 0; l < DEPTH; ++l) {
        const int pb = 1 + 9 * l;
        int bx = (int)blockIdx.x, wv = wave; asm volatile("" : "+s"(bx), "+s"(wv));
        unsigned char* wl = ws + WS_W + (size_t)l * W_LAYER;
        if (IN(pb + 0)) {
            pg8::Gemm g{(const bf16*)(ws + WS_XN), (const bf16*)(wl + WO_IN), MG, NPROJ, DM, LDX, LDX}; pg8::StaticOrder S; S.init(MG, NPROJ, G, bx, WGM_A);
            pg8::EpiProj E{(bf16*)(ws + WS_PROJ), NPROJ, (const float*)(ws + WS_RSS), 1.f / DM, a.out + O_FVP + (size_t)l * SEQ * 512, a.out + O_SKP + (size_t)l * SEQ * 512, a.out + O_SVP + (size_t)l * SEQ * 512,
                           (bf16*)(ws + WS_VA), (bf16*)(ws + WS_QB), (bf16*)(ws + WS_KB), (bf16*)(ws + WS_VB), (unsigned*)(ctl + CW_KMAX + 64 * l + 8), QS_B,
                           FUSE_B, a.out + O_FKP + (size_t)l * SEQ * 512, a.out + O_CKP + (size_t)l * SEQ * 256, a.out + O_KRP + (size_t)l * SEQ * 64, a.out + O_FLP + (size_t)l * SEQ * 4,
                           (bf16*)(ws + WS_QA), (bf16*)(ws + WS_KA), (bf16*)(ws + WS_CQ), (bf16*)(ws + WS_CKVN), (float*)(ws + WS_KROPE), (float*)(ws + WS_LOGF), (float*)(ws + WS_KRSS), (float*)(ws + WS_CQSS),
                           a.in[I_FQN] + l * 128, a.in[I_FKN] + l * 128, a.in[I_QAN] + l * 512, a.in[I_KVAN] + l * 256, a.in[I_FBIAS] + l * 4, (LAS float*)(lds + RING_BYTES + 1024), (unsigned*)(ctl + CW_KMAX + 64 * l + 24), QS_A, LDCQ, LDCKV, (LAS float*)(lds + RSTAB_OFF), (unsigned)(pb + 0) << 8};
            pg8::gemm_phase<pg8::EpiProj, pg8::StaticOrder, true, true>(lds + RING_OFF, g, S, E, wv);
            __syncthreads();
            { const ThinArgs T{(const bf16*)(ws + WS_XN) + (size_t)SEQ * LDX, (const bf16*)(wl + WO_IN), DM, LDX, LDX, NPROJ / 32, (bf16*)(ws + WS_PROJ), NPROJ, (const float*)(ws + WS_RSSS), nullptr, nullptr, nullptr, nullptr, nullptr};
              if (USE_THIN) thin_gemm<0, 2, 256>(T, lds + RING_OFF, wv, bx); }
            SEAM(pb + 0);
        }
        if (IN(pb + 1)) {
            const int ln = fresh_lane();
            float kmA = 0.f, kmB = 0.f;
            for (int rep_ = 0; rep_ < 1 + PROBE_DUP_ROW; ++rep_)
            { pb_tokens(a, l, gw, NGW, ln, kmA, kmB); for (int r = gw; r < DB * PAST; r += NGW) pb_cache_row(a, l, r, ln, kmA, kmB); }
            { LAS float* km = (LAS float*)(lds + RING_OFF);
              if ((ln & 15) == 0) { km[wv * 8 + (ln >> 4)] = kmA; km[wv * 8 + 4 + (ln >> 4)] = kmB; }
              __syncthreads();
              if (wv == 0 && ln < 8) { float m = km[ln];
#pragma unroll
                  for (int w = 1; w < NWAVES; ++w) m = fmaxf(m, km[w * 8 + ln]);
                  __hip_atomic_fetch_max(ctl + CW_KMAX + 64 * l + ln, __float_as_uint(m), RLX_AGENT); }
              __syncthreads(); }
            SEAM(pb + 1);
        }
        if (IN(pb + 2)) {
          for (int rep_ = 0; rep_ < 1 + PROBE_DUP_C; ++rep_) {
            { const int ln_ = fresh_lane(); for (int j = G >= 72 ? bx - (G - 36) : bx; j < 36; j += G) if (j >= 0) scan_job(ws, (LAS float*)(lds + RING_OFF), j, wv * 64 + ln_, wv, ln_); }
            { pg8::Gemm g{(const bf16*)(ws + WS_CQ), (const bf16*)(wl + WO_UQ), M, NQC, 512, LDCQ, LDCQ}; pg8::StaticOrder S; S.init(M, NQC, G, bx, WGM_C);
              pg8::EpiPlain E{(bf16*)(ws + WS_QCR), NQC};
              pg8::gemm_phase<pg8::EpiPlain, pg8::StaticOrder, true, true>(lds + RING_OFF, g, S, E, wv); }
            __syncthreads();
            { pg8::Gemm g{(const bf16*)(ws + WS_CKVN), (const bf16*)(wl + WO_UKV), NKR, NKV, 256, LDCKV, LDCKV}; pg8::StaticOrder S; S.init(NKR, NKV, G, bx, WGM_C);
              if (FOLD_KC) { pg8::EpiKV E{(bf16*)(ws + WS_KC), (bf16*)(ws + WS_KVR), (const float*)(ws + WS_KRSS), (const float*)(ws + WS_KROPE), (const float*)(ws + WS_ROPE), a.in[I_KN] + l * QKD, (LAS float*)(lds + RING_BYTES + 1024), SEQ, SKEYS};
                  pg8::gemm_phase<pg8::EpiKV, pg8::StaticOrder, true, true>(lds + RING_OFF, g, S, E, wv); }
              else { pg8::EpiPlain E{(bf16*)(ws + WS_KVR), NKV};
                  pg8::gemm_phase<pg8::EpiPlain, pg8::StaticOrder, true, true>(lds + RING_OFF, g, S, E, wv); } }
            if (PROBE_DUP_C) __syncthreads();
          }
            SEAM(pb + 2);
        }
        if (IN(pb + 3) && !(FOLD_QC && FOLD_KC)) {
            const int ln = fresh_lane();
            for (int rep_ = 0; rep_ < 1 + PROBE_DUP_ROW; ++rep_)
            for (int r = gw + (FOLD_QC ? M : 0); r < M + NKR; r += NGW) { if (r < M) pd_row<0>(a, l, r, ln); else pd_row<1>(a, l, r - M, ln); }
            SEAM(pb + 3);
        }
        if (IN(pb + 4)) {
          for (int rep_ = 0; rep_ < 1 + PROBE_DUP_E; ++rep_) {
            gu32* head = ctl + CW_AQ + 64 * l + 16 * rep_;
            const int nconv = (CONV_IN_E && l + 1 < DEPTH) ? NCONV : 0; static_assert(2 * NCONV <= att::NU && NCONV * CONV_PER_UNIT >= CI_LAYER && CONV_PER_UNIT % NWAVES == 0, "conversion units fit between the attention units");
            for (;;) {
                if (wv == 0 && fresh_lane() == 0) MISC[12] = __hip_atomic_fetch_add(head, 1u, RLX_AGENT);
                __syncthreads();
                const int t_ = (int)MISC[12];
                __syncthreads();
                if (t_ >= att::NU + nconv) break;
                int u = t_ - nconv;
                if (t_ < 3 * nconv) {
                    if (t_ % 3 == 2) { const int c_ = t_ / 3, ln_ = fresh_lane();
#pragma unroll 1
                        for (int j_ = 0; j_ < CONV_PER_UNIT / NWAVES; ++j_) { const int it_ = (c_ * (CONV_PER_UNIT / NWAVES) + j_) * NWAVES + wv; if (it_ < CI_LAYER) p0_conv_item(a, l + 1, it_, ln_); }
                        continue; }
                    u = t_ - t_ / 3; }
                att::UnitDesc U; int type;
                U.part = -1; U.t_lo = 0;
                if (u < att::NU_MLA) { type = 2; U.h = u & 3; int qb, p;
                    if (u < att::NU_MLA_FULL) { const int idx = u >> 2; if (idx < 48) { qb = 63 - idx / 3; p = idx % 3; } else if (idx < 80) { qb = 47 - (idx - 48) / 2; p = (idx - 48) & 1; } else { qb = 31 - (idx - 80); p = 0; }
                        U.t_lo = 64 * p; U.t_hi = 64 * p + 64; U.part = p; }
                    else { const int k = (u - att::NU_MLA_FULL) >> 2; qb = (k & 3) * 16 + 15 - (k >> 2); p = qb >> 4; U.t_lo = 64 * p; U.t_hi = 4 * (qb + 1); U.part = p > 0 ? p : -1; }
                    U.qrow0 = qb * 256; U.nq = 256; U.krow0 = 0; U.qpos0 = qb * 256; U.nkeys = SEQ; }
                else if (u < att::NU_PROMPT) { const int v = u - att::NU_MLA; type = v >> 8;
                    U.h = v & 3; const int qb = 63 - ((v & 255) >> 2); U.qrow0 = qb * 256; U.nq = 256; U.krow0 = 0; U.qpos0 = qb * 256; U.nkeys = SEQ; U.t_hi = 4 * (qb + 1); }
                else { const int v = u - att::NU_PROMPT; const int k = v >> 5, b = (v & 31) >> 2; type = k == 0 ? 2 : k == 1 ? 0 : 1;
                    U.h = v & 3; U.qrow0 = SEQ + b * DS; U.nq = DS; U.krow0 = SEQ + b * SKEYS; U.qpos0 = PAST; U.nkeys = SKEYS; U.t_hi = (PAST + DS - 1) / 64 + 1; }
                if (type == 2) att::attn_unit<2>(lds + RING_OFF, ws, U, 0.f, wv, a.in[I_QN] + l * QKD);
                else if (type == 0) { const gu32* ks_ = ctl + CW_KMAX + 64 * l + 24 + U.h * 4;
                    const float ka2 = (__uint_as_float(__hip_atomic_load(ks_, RLX_AGENT)) + __uint_as_float(__hip_atomic_load(ks_ + 1, RLX_AGENT))) + (__uint_as_float(__hip_atomic_load(ks_ + 2, RLX_AGENT)) + __uint_as_float(__hip_atomic_load(ks_ + 3, RLX_AGENT)));
                    att::attn_unit<0>(lds + RING_OFF, ws, U, sqrtf(fmaxf(ka2, __uint_as_float(__hip_atomic_load(ctl + CW_KMAX + 64 * l + U.h, RLX_AGENT)))), wv); }
                else { const gu32* ks_ = ctl + CW_KMAX + 64 * l + 8 + U.h * 4;
                    const float kb2 = (__uint_as_float(__hip_atomic_load(ks_, RLX_AGENT)) + __uint_as_float(__hip_atomic_load(ks_ + 1, RLX_AGENT))) + (__uint_as_float(__hip_atomic_load(ks_ + 2, RLX_AGENT)) + __uint_as_float(__hip_atomic_load(ks_ + 3, RLX_AGENT)));
                    att::attn_unit<1>(lds + RING_OFF, ws, U, sqrtf(fmaxf(kb2, __uint_as_float(__hip_atomic_load(ctl + CW_KMAX + 64 * l + 4 + U.h, RLX_AGENT)))), wv); }
            }
            if (PROBE_DUP_E) xcd_barrier(bar, wv == 0 && fresh_lane() == 0);
          }
            SEAM(pb + 4);
        }
        if (IN(pb + 5)) {
            const int ln = fresh_lane();
            for (int rep_ = 0; rep_ < 1 + PROBE_DUP_ROW; ++rep_)
            pf_rows(a, l, gw, NGW, ln);
            SEAM(pb + 5);
        }
        if (IN(pb + 6)) {
            pg8::Gemm g{(const bf16*)(ws + WS_MIX), (const bf16*)(wl + WO_OUT), MG, DM, MIXW, LDMIX, LDMIX}; pg8::StaticOrder S; S.init(MG, DM, G, bx, WGM_G);
            pg8::EpiResid E{l == 0 ? a.in[I_XP] : nullptr, nullptr, (bf16*)(ws + WS_XN), LDX, (float*)(ws + WS_RSS), DM};
            pg8::gemm_phase<pg8::EpiResid, pg8::StaticOrder, true, true>(lds + RING_OFF, g, S, E, wv);
            __syncthreads();
            { const ThinArgs T{(const bf16*)(ws + WS_MIX) + (size_t)SEQ * LDMIX, (const bf16*)(wl + WO_OUT), MIXW, LDMIX, LDMIX, DM / 16, nullptr, 0, nullptr, l == 0 ? a.in[I_XS] : a.out + O_Y + (size_t)SEQ * DM, a.out + O_Y + (size_t)SEQ * DM,
                               (bf16*)(ws + WS_XN), a.in[I_NFFN] + l * DM, (float*)(ws + WS_RSSS)};
              if (USE_THIN) thin_gemm_ks<256>(T, lds + RING_OFF, wv, bx); }
            SEAM(pb + 6);
        }
        if (IN(pb + 7)) {
            pg8::Gemm g{(const bf16*)(ws + WS_XN), (const bf16*)(wl + WO_GU), MG, 2 * DFF, DM, LDX, LDX}; pg8::StaticOrder S; S.init(MG, 2 * DFF, G, bx, WGM_H);
            pg8::EpiSwiGlu E{(bf16*)(ws + WS_H), LDH, (const float*)(ws + WS_RSS), 1.f / DM, (LAS float*)(lds + RSTAB_OFF), (unsigned)(pb + 7) << 8};
            for (int rep_ = 0; rep_ < 1 + PROBE_DUP_H; ++rep_) { pg8::gemm_phase<pg8::EpiSwiGlu, pg8::StaticOrder, true, true>(lds + RING_OFF, g, S, E, wv); if (PROBE_DUP_H) xcd_barrier(bar, wv == 0 && fresh_lane() == 0); }
            __syncthreads();
            { const ThinArgs T{(const bf16*)(ws + WS_XN) + (size_t)SEQ * LDX, (const bf16*)(wl + WO_GU), DM, LDX, LDX, DFF / 32, (bf16*)(ws + WS_H), LDH, (const float*)(ws + WS_RSSS), nullptr, nullptr, nullptr, nullptr, nullptr};
              if (USE_THIN) thin_gemm<1, 4, 256>(T, lds + RING_OFF, wv, bx); }
            SEAM(pb + 7);
        }
        if (IN(pb + 8)) {
            pg8::Gemm g{(const bf16*)(ws + WS_H), (const bf16*)(wl + WO_DOWN), MG, DM, DFF, LDH, LDH}; pg8::StaticOrder S; S.init(MG, DM, G, bx, WGM_I);
            pg8::EpiResid E{nullptr, l + 1 == DEPTH ? a.out + O_Y : nullptr, (bf16*)(ws + WS_XN), LDX, (float*)(ws + WS_RSS), DM};
            pg8::gemm_phase<pg8::EpiResid, pg8::StaticOrder, true, true>(lds + RING_OFF, g, S, E, wv);
            __syncthreads();
            { const ThinArgs T{(const bf16*)(ws + WS_H) + (size_t)SEQ * LDH, (const bf16*)(wl + WO_DOWN), DFF, LDH, LDH, DM / 16, nullptr, 0, nullptr, a.out + O_Y + (size_t)SEQ * DM, a.out + O_Y + (size_t)SEQ * DM,
                               (bf16*)(ws + WS_XN), a.in[I_NMIX] + (l + 1 < DEPTH ? l + 1 : l) * DM, (float*)(ws + WS_RSSS)};
              if (USE_THIN) thin_gemm_ks<256>(T, lds + RING_OFF, wv, bx); }
            SEAM(pb + 8);
        }
    }
#undef IN
#undef SEAM
}

extern "C" void kernel_launch(void* const* d_in, const int* in_sizes, int n_in, void* d_out, int out_size, void* d_ws, size_t ws_size, hipStream_t stream) {
    static int grid = 0;
    if (grid == 0) {
        if (n_in != N_INPUTS || (size_t)out_size != O_END || ws_size < WS_END) { fprintf(stderr, "kernel_launch: unexpected shapes (n_in %d, out %d, ws %zu; need ws >= %zu)\n", n_in, out_size, ws_size, (size_t)WS_END); grid = -1; return; }
        int dev = 0, cus = 0, per_cu = 0;
        if (hipGetDevice(&dev) != hipSuccess || hipDeviceGetAttribute(&cus, hipDeviceAttributeMultiprocessorCount, dev) != hipSuccess) { grid = -1; return; }
        if (hipFuncSetAttribute((const void*)trunk_fwd, hipFuncAttributeMaxDynamicSharedMemorySize, LDS_BYTES) != hipSuccess) { fprintf(stderr, "kernel_launch: hipFuncSetAttribute failed\n"); grid = -1; return; }
        if (hipOccupancyMaxActiveBlocksPerMultiprocessor(&per_cu, (const void*)trunk_fwd, NWAVES * 64, LDS_BYTES) != hipSuccess || per_cu < 1) { fprintf(stderr, "kernel_launch: occupancy query says %d blocks per CU\n", per_cu); }
        (void)hipGetLastError();
        grid = cus;
    }
    if (grid < 0) return;
    (void)in_sizes;
    if (hipMemsetAsync((char*)d_ws + WS_CTL, 0, CTL_ZERO_BYTES, stream) != hipSuccess) { fprintf(stderr, "kernel_launch: memset failed\n"); return; }
    KArgs a{};
    for (int i = 0; i < N_INPUTS; ++i) a.in[i] = (const float*)d_in[i];
    a.out = (float*)d_out; a.ws = (unsigned char*)d_ws;
#if MK_ONE_LAUNCH
    a.ph_lo = 0; a.ph_hi = NPH;
    hipLaunchKernelGGL(trunk_fwd, dim3(grid), dim3(NWAVES * 64), LDS_BYTES, stream, a);
#else
    for (int p = 0; p < NPH; ++p) { a.ph_lo = p; a.ph_hi = p + 1; hipLaunchKernelGGL(trunk_fwd, dim3(grid), dim3(NWAVES * 64), LDS_BYTES, stream, a); }
#endif
    const hipError_t le = hipPeekAtLastError();
    if (le != hipSuccess) fprintf(stderr, "kernel_launch: launch failed: %s\n", hipGetErrorName(le));
}
```

```cpp
#include <hip/hip_runtime.h>
#include <cstdio>
#include <cstdint>
#ifndef MLA_G
#define MLA_G 32
#endif
#ifndef CONV_IN_E
#define CONV_IN_E 1
#endif
#ifndef PROBE_DUP_E
#define PROBE_DUP_E 0
#endif
#ifndef PROBE_DUP_H
#define PROBE_DUP_H 0
#endif
#ifndef USE_THIN
#define USE_THIN 1
#endif
#ifndef PROBE_DUP_ROW
#define PROBE_DUP_ROW 0
#endif
#ifndef PROBE_DUP_C
#define PROBE_DUP_C 0
#endif
#ifndef WGM_A
#define WGM_A 4
#endif
#ifndef WGM_G
#define WGM_G 4
#endif
#ifndef WGM_H
#define WGM_H 4
#endif
#ifndef WGM_I
#define WGM_I 4
#endif
#ifndef WGM_C
#define WGM_C 4
#endif
#ifndef ATT_LAG
#define ATT_LAG 0
#endif
#ifndef FOLD_QC
#define FOLD_QC 1
#endif
#ifndef FOLD_KC
#define FOLD_KC 1
#endif
#ifndef FUSE_B
#define FUSE_B 1
#endif
#ifndef ATT_NEGM
#define ATT_NEGM 1
#endif
#ifndef ATT_PIPE
#define ATT_PIPE 0
#endif
#ifndef MK_ONE_LAUNCH
#define MK_ONE_LAUNCH 1
#endif
__device__ __forceinline__ int fresh_lane() { int l_; asm volatile("v_mbcnt_lo_u32_b32 %0, -1, 0\n\tv_mbcnt_hi_u32_b32 %0, -1, %0" : "=v"(l_)); return l_; }
namespace pg8 {
#define PG8_LAS __attribute__((address_space(3)))
typedef unsigned short bf16_t;
typedef short bf16x8 __attribute__((ext_vector_type(8)));
typedef float f32x4 __attribute__((ext_vector_type(4)));
typedef unsigned u32x4 __attribute__((ext_vector_type(4)));
constexpr int BM = 256, BK = 64, HALF = 128, HTB = HALF * BK * 2  , STAGE_BYTES = 8 * HTB, NXCD = 8;

__host__ __device__ __forceinline__ int lds_byte(int r, int c) { const int st = (r >> 4) * 2 + (c >> 5), rr = r & 15, cc = c & 31, ob = rr * 64 + cc * 2; return st * 1024 + (ob ^ (((ob >> 9) & 1) << 5)); }
__host__ __device__ __forceinline__ void stage_rc(int b, int& R, int& C) { const int st = b / 1024, sb = b % 1024, swz = sb ^ (((sb >> 9) & 1) << 5); R = (st >> 1) * 16 + swz / 64; C = (st & 1) * 32 + (swz % 64) / 2; }
__host__ __device__ __forceinline__ int perm32(int rho) { const int n = rho >> 4, i = rho & 15; return 8 * (i >> 2) + 4 * n + (i & 3); }

struct Unit { int pm, pn; };
struct Gemm { const bf16_t* A; const bf16_t* Bt; int M, N, K, lda, ldb; };

struct StaticOrder {
    int nM, nN, nwg, G, c, WGM;
    __host__ __device__ void init(int M, int N, int G_, int c_, int wgm = 4) { nM = M / BM; nN = N / BM; nwg = nM * nN; G = G_; c = c_; WGM = wgm; }
    __host__ __device__ bool next(int i, Unit& u) const {
        const long L = (long)i * G + c; if (L >= nwg) return false;
        int wgid = (int)L; { const int q = nwg / NXCD, r = nwg % NXCD, xcd = wgid % NXCD, off = wgid / NXCD; wgid = (xcd < r ? xcd * (q + 1) : r * (q + 1) + (xcd - r) * q) + off; }
        const int nig = WGM * nN, gid = wgid / nig, fm = gid * WGM, gsz = (nM - fm) < WGM ? (nM - fm) : WGM;
        u.pm = fm + ((wgid % nig) % gsz); u.pn = (wgid % nig) / gsz; return true;
    }
    __device__ __forceinline__ void a_ready(const Unit&) const {}
    __device__ __forceinline__ void done(const Unit&) const {}
};

__device__ __forceinline__ unsigned cvt_pk_bf16(float lo, float hi) { unsigned r; asm volatile("v_cvt_pk_bf16_f32 %0, %1, %2" : "=v"(r) : "v"(lo), "v"(hi)); return r; }
typedef float f32x2 __attribute__((ext_vector_type(2)));

constexpr float RMS_EPS = 1e-6f;
__device__ __forceinline__ float row_rstd(const float* rowss, int row, int fq, float inv_n) {
    const f32x4 a = *(const f32x4*)(rowss + (size_t)row * 32 + fq * 8), b = *(const f32x4*)(rowss + (size_t)row * 32 + fq * 8 + 4);
    float s = ((a[0] + a[1]) + (a[2] + a[3])) + ((b[0] + b[1]) + (b[2] + b[3]));
    s += __shfl_xor(s, 16); s += __shfl_xor(s, 32);
    return 1.0f / sqrtf(s * inv_n + RMS_EPS);
}
__device__ __forceinline__ void rstd_rows(float (&rsv)[2][4], const float* rowss, int row0, int fr, int fq, float inv_n, PG8_LAS float* tab, unsigned want, int wid) {
    PG8_LAS float* tb = tab + wid * 128; volatile PG8_LAS unsigned* tg = (volatile PG8_LAS unsigned*)(tab + 1024) + wid;
    if ((unsigned)__builtin_amdgcn_readfirstlane((int)*tg) == want) {
#pragma unroll
        for (int ai = 0; ai < 2; ++ai)
#pragma unroll
            for (int m = 0; m < 4; ++m) rsv[ai][m] = tb[ai * 64 + m * 16 + fr];
    } else {
#pragma unroll
        for (int ai = 0; ai < 2; ++ai)
#pragma unroll
            for (int m = 0; m < 4; ++m) { rsv[ai][m] = row_rstd(rowss, row0 + ai * HALF + m * 16, fq, inv_n); tb[ai * 64 + m * 16 + fr] = rsv[ai][m]; }
        *tg = want;
    }
}
__device__ __forceinline__ void unperm_sw(float& a, float& b) {
    asm volatile("s_nop 1\n\tv_permlane16_swap_b32 %0, %1\n\ts_nop 1\n\tv_permlane32_swap_b32 %0, %1" : "+v"(a), "+v"(b)); }
__device__ __forceinline__ void unperm8(f32x4& x, f32x4& y) {
    float a0 = x[0], a1 = x[1], a2 = x[2], a3 = x[3], b0 = y[0], b1 = y[1], b2 = y[2], b3 = y[3];
    unperm_sw(a0, b0); unperm_sw(a1, b1); unperm_sw(a2, b2); unperm_sw(a3, b3);
    x = (f32x4){a0, a1, a2, a3}; y = (f32x4){b0, b1, b2, b3};
}
struct EpiPlain {
    static constexpr bool PERM = true, AFTER_DRAIN = false, WIDE = false;
    bf16_t* O; int ldc;
    __device__ __forceinline__ void operator()(const f32x4 (&acc)[2][2][4][2], const Unit& u, int wr, int wc, int fr, int fq) const {
        const int row0 = u.pm * BM + wr * 64 + fr, col0 = u.pn * BM + wc * 32 + 8 * fq;
#pragma unroll
        for (int ai = 0; ai < 2; ++ai)
#pragma unroll
            for (int m = 0; m < 4; ++m) { bf16_t* rowp = O + (size_t)(row0 + ai * HALF + m * 16) * ldc + col0;
#pragma unroll
                for (int bj = 0; bj < 2; ++bj) { const f32x4 v0 = acc[ai][bj][m][0], v1 = acc[ai][bj][m][1];
                    u32x4 w; w.x = cvt_pk_bf16(v0[0], v0[1]); w.y = cvt_pk_bf16(v0[2], v0[3]); w.z = cvt_pk_bf16(v1[0], v1[1]); w.w = cvt_pk_bf16(v1[2], v1[3]);
                    *(u32x4*)(rowp + bj * HALF) = w; } }
    }
};
struct EpiScaled {
    static constexpr bool PERM = true, AFTER_DRAIN = false, WIDE = false;
    bf16_t* O; int ldc; const float* rowss; float inv_n;
    __device__ __forceinline__ void operator()(const f32x4 (&acc)[2][2][4][2], const Unit& u, int wr, int wc, int fr, int fq) const {
        const int row0 = u.pm * BM + wr * 64 + fr, col0 = u.pn * BM + wc * 32 + 8 * fq;
        float rsv[2][4];
#pragma unroll
        for (int ai = 0; ai < 2; ++ai)
#pragma unroll
            for (int m = 0; m < 4; ++m) rsv[ai][m] = row_rstd(rowss, row0 + ai * HALF + m * 16, fq, inv_n);
#pragma unroll
        for (int ai = 0; ai < 2; ++ai)
#pragma unroll
            for (int m = 0; m < 4; ++m) { const int row = row0 + ai * HALF + m * 16; const float rs = rsv[ai][m];
                bf16_t* rowp = O + (size_t)row * ldc + col0;
#pragma unroll
                for (int bj = 0; bj < 2; ++bj) { const f32x4 v0 = acc[ai][bj][m][0] * rs, v1 = acc[ai][bj][m][1] * rs;
                    u32x4 w; w.x = cvt_pk_bf16(v0[0], v0[1]); w.y = cvt_pk_bf16(v0[2], v0[3]); w.z = cvt_pk_bf16(v1[0], v1[1]); w.w = cvt_pk_bf16(v1[2], v1[3]);
                    *(u32x4*)(rowp + bj * HALF) = w; } }
    }
};
__device__ __forceinline__ void ld8(const float* p, float* x) { const f32x4 a = *(const f32x4*)p, b = *(const f32x4*)(p + 4); x[0] = a[0]; x[1] = a[1]; x[2] = a[2]; x[3] = a[3]; x[4] = b[0]; x[5] = b[1]; x[6] = b[2]; x[7] = b[3]; }
__device__ __forceinline__ float logsig(float v) { return fminf(v, 0.f) - log1pf(__expf(-fabsf(v))); }
struct EpiProj {
    static constexpr bool PERM = true, AFTER_DRAIN = false, WIDE = false;
    bf16_t* O; int ldc; const float* rowss; float inv_n;
    float* o_fv; float* o_sk; float* o_sv; bf16_t* VA; bf16_t* QB; bf16_t* KB; bf16_t* VB; unsigned* kslice; float qs_b;
    int fuse; float* o_fk; float* o_ck; float* o_kr; float* o_fl; bf16_t* QA; bf16_t* KA; bf16_t* CQ; bf16_t* CKVN; float* KROPE; float* LOGF; float* KRSS; float* CQSS;
    const float* gq; const float* gk; const float* gqa; const float* gkv; const float* fbias; PG8_LAS float* xch; unsigned* kslice_a; float qs_a; int ldcq, ldckv; PG8_LAS float* rstab; unsigned tag;
    __device__ __forceinline__ void operator()(const f32x4 (&acc)[2][2][4][2], const Unit& u, int wr, int wc, int fr, int fq) const {
        const int row0 = u.pm * BM + wr * 64 + fr, col0 = u.pn * BM + wc * 32 + 8 * fq;
        float rsv[2][4];
        rstd_rows(rsv, rowss, row0, fr, fq, inv_n, rstab, tag | (unsigned)(u.pm + 1), wr * 4 + wc);
        const int kind = (u.pn >= 4 && u.pn < 12) ? ((u.pn - 4) >> 1) + 1 : 0;
        if (kind == 0 && fuse) {
            if (u.pn < 2) norm_tiles<5>(acc, u, rsv, wr, wc); else if (u.pn < 4) norm_tiles<6>(acc, u, rsv, wr, wc);
            else if (u.pn < 14) cq_tiles(acc, u, rsv, wr, wc); else if (u.pn == 14) norm_tiles<7>(acc, u, rsv, wr, wc); else norm_tiles<8>(acc, u, rsv, wr, wc);
        } else if (kind == 0) {
#pragma unroll
            for (int ai = 0; ai < 2; ++ai)
#pragma unroll
                for (int m = 0; m < 4; ++m) { const int row = row0 + ai * HALF + m * 16; const float rs = rsv[ai][m];
                    bf16_t* rowp = O + (size_t)row * ldc + col0;
#pragma unroll
                    for (int bj = 0; bj < 2; ++bj) { const f32x4 v0 = acc[ai][bj][m][0] * rs, v1 = acc[ai][bj][m][1] * rs;
                        u32x4 w; w.x = cvt_pk_bf16(v0[0], v0[1]); w.y = cvt_pk_bf16(v0[2], v0[3]); w.z = cvt_pk_bf16(v1[0], v1[1]); w.w = cvt_pk_bf16(v1[2], v1[3]);
                        *(u32x4*)(rowp + bj * HALF) = w; } }
        } else if (kind == 1) copy_tiles<1>(acc, u, rsv, row0, wc, fq, fr, o_fv, VA, 1.f);
        else if (kind == 2) copy_tiles<2>(acc, u, rsv, row0, wc, fq, fr, nullptr, QB, qs_b);
        else if (kind == 3) copy_tiles<3>(acc, u, rsv, row0, wc, fq, fr, o_sk, KB, 1.f);
        else copy_tiles<4>(acc, u, rsv, row0, wc, fq, fr, o_sv, VB, 1.f);
    }
    template <int KIND> __device__ __forceinline__ void norm_tiles(const f32x4 (&acc)[2][2][4][2], const Unit& u, const float (&rsv)[2][4], int wr, int wc) const {
        const int ln_ = fresh_lane(), fr = ln_ & 15, fq = ln_ >> 4, rl0 = wr * 64 + fr, row0 = u.pm * BM + rl0, c8 = wc * 32 + 8 * fq;
#pragma unroll
        for (int ai = 0; ai < 2; ++ai)
#pragma unroll
            for (int m = 0; m < 4; ++m) { const float rs = rsv[ai][m];
#pragma unroll
                for (int bj = 0; bj < 2; ++bj) { const f32x4 a0 = acc[ai][bj][m][0] * rs, a1 = acc[ai][bj][m][1] * rs;
                    float p_ = ((a0[0] * a0[0] + a0[1] * a0[1]) + (a0[2] * a0[2] + a0[3] * a0[3])) + ((a1[0] * a1[0] + a1[1] * a1[1]) + (a1[2] * a1[2] + a1[3] * a1[3]));
                    if (KIND == 8 && (bj != 0 || wc >= 2)) p_ = 0.f;
                    p_ += __shfl_xor(p_, 16); p_ += __shfl_xor(p_, 32);
                    if (fq == 0) xch[((ai * HALF + rl0 + m * 16) * 2 + bj) * 4 + wc] = p_; } }
        float g0[8], g1[8];
        if (KIND == 5) { ld8(gq + c8, g0); } else if (KIND == 6) { ld8(gk + c8, g0); } else if (KIND == 7) { ld8(gkv + c8, g0); ld8(gkv + HALF + c8, g1); }
        f32x4 fb = {0.f, 0.f, 0.f, 0.f}; if (KIND == 8) fb = *(const f32x4*)fbias;
        asm volatile("s_waitcnt lgkmcnt(0)\n\ts_barrier" ::: "memory");
        float kmx0 = 0.f, kmx1 = 0.f;
#pragma unroll
        for (int ai = 0; ai < 2; ++ai)
#pragma unroll
            for (int m = 0; m < 4; ++m) { const int row = row0 + ai * HALF + m * 16; const float rs = rsv[ai][m];
                const f32x4 q0 = *(const PG8_LAS f32x4*)(xch + ((ai * HALF + rl0 + m * 16) * 2 + 0) * 4), q1 = *(const PG8_LAS f32x4*)(xch + ((ai * HALF + rl0 + m * 16) * 2 + 1) * 4);
                const float s0 = (q0[0] + q0[1]) + (q0[2] + q0[3]), s1 = (q1[0] + q1[1]) + (q1[2] + q1[3]);
                if (KIND == 5 || KIND == 6) {
#pragma unroll
                    for (int bj = 0; bj < 2; ++bj) { const float rn = rs / sqrtf((bj == 0 ? s0 : s1) * (1.f / 128.f) + RMS_EPS) * (KIND == 5 ? qs_a : 1.f);
                        const f32x4 a0 = acc[ai][bj][m][0] * rn, a1 = acc[ai][bj][m][1] * rn;
                        const f32x4 y0 = {a0[0] * g0[0], a0[1] * g0[1], a0[2] * g0[2], a0[3] * g0[3]}, y1 = {a1[0] * g0[4], a1[1] * g0[5], a1[2] * g0[6], a1[3] * g0[7]};
                        const size_t off = (size_t)row * 512 + (u.pn & 1) * BM + bj * HALF + c8;
                        u32x4 w; w.x = cvt_pk_bf16(y0[0], y0[1]); w.y = cvt_pk_bf16(y0[2], y0[3]); w.z = cvt_pk_bf16(y1[0], y1[1]); w.w = cvt_pk_bf16(y1[2], y1[3]);
                        if (KIND == 5) *(u32x4*)(QA + off) = w;
                        else { *(u32x4*)(KA + off) = w; { f32x4 x = y0, y = y1; unperm8(x, y); float* p = o_fk + (off - 4 * fq); __builtin_nontemporal_store(x, (f32x4*)p); __builtin_nontemporal_store(y, (f32x4*)(p + 16)); }
                            float p_ = ((y0[0] * y0[0] + y0[1] * y0[1]) + (y0[2] * y0[2] + y0[3] * y0[3])) + ((y1[0] * y1[0] + y1[1] * y1[1]) + (y1[2] * y1[2] + y1[3] * y1[3]));
                            p_ += __shfl_xor(p_, 16); p_ += __shfl_xor(p_, 32); if (bj == 0) kmx0 = fmaxf(kmx0, p_); else kmx1 = fmaxf(kmx1, p_); } }
                } else if (KIND == 7) { const float rn = rs / sqrtf((s0 + s1) * (1.f / 256.f) + RMS_EPS);
#pragma unroll
                    for (int bj = 0; bj < 2; ++bj) { const f32x4 a0 = acc[ai][bj][m][0] * rn, a1 = acc[ai][bj][m][1] * rn;
                        const f32x4 y0 = bj == 0 ? (f32x4){a0[0] * g0[0], a0[1] * g0[1], a0[2] * g0[2], a0[3] * g0[3]} : (f32x4){a0[0] * g1[0], a0[1] * g1[1], a0[2] * g1[2], a0[3] * g1[3]};
                        const f32x4 y1 = bj == 0 ? (f32x4){a1[0] * g0[4], a1[1] * g0[5], a1[2] * g0[6], a1[3] * g0[7]} : (f32x4){a1[0] * g1[4], a1[1] * g1[5], a1[2] * g1[6], a1[3] * g1[7]};
                        const int cc = bj * HALF + c8;
                        { f32x4 x = y0, y = y1; unperm8(x, y); float* p = o_ck + (size_t)row * 256 + (cc - 4 * fq); __builtin_nontemporal_store(x, (f32x4*)p); __builtin_nontemporal_store(y, (f32x4*)(p + 16)); }
                        u32x4 w; w.x = cvt_pk_bf16(y0[0], y0[1]); w.y = cvt_pk_bf16(y0[2], y0[3]); w.z = cvt_pk_bf16(y1[0], y1[1]); w.w = cvt_pk_bf16(y1[2], y1[3]);
                        *(u32x4*)(CKVN + (size_t)row * ldckv + cc) = w; }
                } else {
                    const f32x4 a0 = acc[ai][0][m][0] * rs, a1 = acc[ai][0][m][1] * rs;
                    if (wc < 2) { __builtin_nontemporal_store(a0, (f32x4*)(o_kr + (size_t)row * 64 + c8)); __builtin_nontemporal_store(a1, (f32x4*)(o_kr + (size_t)row * 64 + c8 + 4));
                        *(f32x4*)(KROPE + (size_t)row * 64 + c8) = a0; *(f32x4*)(KROPE + (size_t)row * 64 + c8 + 4) = a1;
                        if (wc == 0 && fq == 0) KRSS[row] = s0; }
                    else if (wc == 2 && fq == 0) { const f32x4 lf = {logsig(a0[0] + fb[0]), logsig(a0[1] + fb[1]), logsig(a0[2] + fb[2]), logsig(a0[3] + fb[3])};
                        __builtin_nontemporal_store(lf, (f32x4*)(o_fl + (size_t)row * 4)); *(f32x4*)(LOGF + (size_t)row * 4) = lf; } } }
        if (KIND == 6) {
#pragma unroll
            for (int bj = 0; bj < 2; ++bj) { float mx = bj == 0 ? kmx0 : kmx1;
#pragma unroll
                for (int o_ = 1; o_ < 16; o_ <<= 1) mx = fmaxf(mx, __shfl_xor(mx, o_));
                if (fr == 0 && fq == 0) __hip_atomic_fetch_max(kslice_a + (((u.pn - 2) * 2 + bj) * 4 + wc), __float_as_uint(mx * 1.02f), __ATOMIC_RELAXED, __HIP_MEMORY_SCOPE_AGENT); } }
    }
    __device__ __forceinline__ void cq_tiles(const f32x4 (&acc)[2][2][4][2], const Unit& u, const float (&rsv)[2][4], int wr, int wc) const {
        const int ln_ = fresh_lane(), fr = ln_ & 15, fq = ln_ >> 4, row0 = u.pm * BM + wr * 64 + fr, c8 = wc * 32 + 8 * fq;
        float g0[8], g1[8]; ld8(gqa + (u.pn - 12) * BM + c8, g0); ld8(gqa + (u.pn - 12) * BM + HALF + c8, g1);
#pragma unroll
        for (int ai = 0; ai < 2; ++ai)
#pragma unroll
            for (int m = 0; m < 4; ++m) { const int row = row0 + ai * HALF + m * 16; const float rs = rsv[ai][m];
#pragma unroll
                for (int bj = 0; bj < 2; ++bj) { const f32x4 a0 = acc[ai][bj][m][0] * rs, a1 = acc[ai][bj][m][1] * rs;
                    float p_ = ((a0[0] * a0[0] + a0[1] * a0[1]) + (a0[2] * a0[2] + a0[3] * a0[3])) + ((a1[0] * a1[0] + a1[1] * a1[1]) + (a1[2] * a1[2] + a1[3] * a1[3]));
                    p_ += __shfl_xor(p_, 16); p_ += __shfl_xor(p_, 32);
                    if (fq == 0) CQSS[(size_t)row * 16 + (u.pn - 12) * 8 + bj * 4 + wc] = p_;
                    u32x4 w;
                    if (bj == 0) { w.x = cvt_pk_bf16(a0[0] * g0[0], a0[1] * g0[1]); w.y = cvt_pk_bf16(a0[2] * g0[2], a0[3] * g0[3]); w.z = cvt_pk_bf16(a1[0] * g0[4], a1[1] * g0[5]); w.w = cvt_pk_bf16(a1[2] * g0[6], a1[3] * g0[7]); }
                    else { w.x = cvt_pk_bf16(a0[0] * g1[0], a0[1] * g1[1]); w.y = cvt_pk_bf16(a0[2] * g1[2], a0[3] * g1[3]); w.z = cvt_pk_bf16(a1[0] * g1[4], a1[1] * g1[5]); w.w = cvt_pk_bf16(a1[2] * g1[6], a1[3] * g1[7]); }
                    *(u32x4*)(CQ + (size_t)row * ldcq + (u.pn - 12) * BM + bj * HALF + c8) = w; } }
    }
    template <int KIND> __device__ __forceinline__ void copy_tiles(const f32x4 (&acc)[2][2][4][2], const Unit& u, const float (&rsv)[2][4], int row0, int wc, int fq, int fr, float* of, bf16_t* ob, float sc) const {
        const int dcol0 = ((u.pn - 4) & 1) * BM + wc * 32 + 8 * fq;
        float kmx0 = 0.f, kmx1 = 0.f;
#pragma unroll
        for (int ai = 0; ai < 2; ++ai)
#pragma unroll
            for (int m = 0; m < 4; ++m) { const int row = row0 + ai * HALF + m * 16; const float rs = rsv[ai][m] * sc;
#pragma unroll
                for (int bj = 0; bj < 2; ++bj) { const f32x4 v0 = acc[ai][bj][m][0] * rs, v1 = acc[ai][bj][m][1] * rs; const size_t off = (size_t)row * 512 + dcol0 + bj * HALF;
                    if (KIND != 2) { f32x4 x = v0, y = v1; unperm8(x, y); float* p = of + (off - 4 * fq); __builtin_nontemporal_store(x, (f32x4*)p); __builtin_nontemporal_store(y, (f32x4*)(p + 16)); }
                    u32x4 w; w.x = cvt_pk_bf16(v0[0], v0[1]); w.y = cvt_pk_bf16(v0[2], v0[3]); w.z = cvt_pk_bf16(v1[0], v1[1]); w.w = cvt_pk_bf16(v1[2], v1[3]);
                    *(u32x4*)(ob + off) = w;
                    if (KIND == 3) { float p_ = ((v0[0] * v0[0] + v0[1] * v0[1]) + (v0[2] * v0[2] + v0[3] * v0[3])) + ((v1[0] * v1[0] + v1[1] * v1[1]) + (v1[2] * v1[2] + v1[3] * v1[3]));
                        p_ += __shfl_xor(p_, 16); p_ += __shfl_xor(p_, 32); if (bj == 0) kmx0 = fmaxf(kmx0, p_); else kmx1 = fmaxf(kmx1, p_); } } }
        if (KIND == 3) {
#pragma unroll
            for (int bj = 0; bj < 2; ++bj) { float mx = bj == 0 ? kmx0 : kmx1;
#pragma unroll
                for (int o_ = 1; o_ < 16; o_ <<= 1) mx = fmaxf(mx, __shfl_xor(mx, o_));
                if (fr == 0 && fq == 0) __hip_atomic_fetch_max(kslice + (((u.pn - 8) * 2 + bj) * 4 + wc), __float_as_uint(mx * 1.02f), __ATOMIC_RELAXED, __HIP_MEMORY_SCOPE_AGENT); } }
    }
};
struct EpiKV {
    static constexpr bool PERM = true, AFTER_DRAIN = false, WIDE = false;
    bf16_t* KC; bf16_t* KVR; const float* krss; const float* krope; const float* rope; const float* gk; PG8_LAS float* xch; int seq, skeys;
    __device__ __forceinline__ void operator()(const f32x4 (&acc)[2][2][4][2], const Unit& u, int wr, int wc, int fr_, int fq_) const {
        typedef float f32x2v __attribute__((ext_vector_type(2)));
        const int ln_ = fresh_lane(), fr = ln_ & 15, fq = ln_ >> 4; (void)fr_; (void)fq_;
        const int rl0 = wr * 64 + fr, row0 = u.pm * BM + rl0, h = u.pn, c8 = wc * 32 + 8 * fq, j0 = 2 * (wc * 4 + fq);
#pragma unroll
        for (int ai = 0; ai < 2; ++ai)
#pragma unroll
            for (int m = 0; m < 4; ++m) { const f32x4 a0 = acc[ai][0][m][0], a1 = acc[ai][0][m][1];
                float p_ = ((a0[0] * a0[0] + a0[1] * a0[1]) + (a0[2] * a0[2] + a0[3] * a0[3])) + ((a1[0] * a1[0] + a1[1] * a1[1]) + (a1[2] * a1[2] + a1[3] * a1[3]));
                p_ += __shfl_xor(p_, 16); p_ += __shfl_xor(p_, 32);
                if (fq == 0) xch[(ai * HALF + rl0 + m * 16) * 4 + wc] = p_; }
        float gn[8]; { const f32x4 t0 = *(const f32x4*)(gk + c8), t1 = *(const f32x4*)(gk + c8 + 4); gn[0] = t0[0]; gn[1] = t0[1]; gn[2] = t0[2]; gn[3] = t0[3]; gn[4] = t1[0]; gn[5] = t1[1]; gn[6] = t1[2]; gn[7] = t1[3]; }
        const f32x2v g1 = *(const f32x2v*)(gk + 128 + j0), g2 = *(const f32x2v*)(gk + 160 + j0);
        float kq[4]; f32x2v kr1[4], kr2[4]; f32x4 cs[4];
#define KV_LOADS(ai_) do { _Pragma("unroll") for (int m = 0; m < 4; ++m) { const int row = row0 + (ai_) * HALF + m * 16; const int pos = row < seq ? row : (row - seq) % skeys; \
            kq[m] = krss[row]; kr1[m] = *(const f32x2v*)(krope + (size_t)row * 64 + j0); kr2[m] = *(const f32x2v*)(krope + (size_t)row * 64 + 32 + j0); \
            cs[m] = *(const f32x4*)(rope + ((size_t)pos * 32 + j0) * 2); } } while (0)
        KV_LOADS(0);
        asm volatile("s_waitcnt lgkmcnt(0)\n\ts_barrier" ::: "memory");
#pragma unroll
        for (int ai = 0; ai < 2; ++ai) {
            if (ai == 1) { KV_LOADS(1); asm volatile("" ::: "memory"); }
#pragma unroll
            for (int m = 0; m < 4; ++m) { const int row = row0 + ai * HALF + m * 16;
                const f32x4 pp = *(const PG8_LAS f32x4*)(xch + (ai * HALF + rl0 + m * 16) * 4);
                const float rs = 1.0f / sqrtf((((pp[0] + pp[1]) + (pp[2] + pp[3])) + kq[m]) * (1.f / 192.f) + RMS_EPS);
                { const f32x4 a0 = acc[ai][0][m][0] * rs, a1 = acc[ai][0][m][1] * rs;
                  u32x4 w; w.x = cvt_pk_bf16(a0[0] * gn[0], a0[1] * gn[1]); w.y = cvt_pk_bf16(a0[2] * gn[2], a0[3] * gn[3]); w.z = cvt_pk_bf16(a1[0] * gn[4], a1[1] * gn[5]); w.w = cvt_pk_bf16(a1[2] * gn[6], a1[3] * gn[7]);
                  *(u32x4*)(KC + (size_t)row * 768 + h * 192 + c8) = w; }
                { const f32x4 v0 = acc[ai][1][m][0], v1 = acc[ai][1][m][1];
                  u32x4 w; w.x = cvt_pk_bf16(v0[0], v0[1]); w.y = cvt_pk_bf16(v0[2], v0[3]); w.z = cvt_pk_bf16(v1[0], v1[1]); w.w = cvt_pk_bf16(v1[2], v1[3]);
                  *(u32x4*)(KVR + (size_t)row * 1024 + h * 256 + HALF + c8) = w; }
                { const float u1a = kr1[m].x * rs * g1.x, u2a = kr2[m].x * rs * g2.x, u1b = kr1[m].y * rs * g1.y, u2b = kr2[m].y * rs * g2.y; const f32x4 c = cs[m];
                  *(unsigned*)(KC + (size_t)row * 768 + h * 192 + 128 + j0) = cvt_pk_bf16(u1a * c[0] - u2a * c[1], u1b * c[2] - u2b * c[3]);
                  *(unsigned*)(KC + (size_t)row * 768 + h * 192 + 160 + j0) = cvt_pk_bf16(u2a * c[0] + u1a * c[1], u2b * c[2] + u1b * c[3]); } }
        }
#undef KV_LOADS
    }
};
__device__ __forceinline__ float silu_mul(float g, float u) { return g * u * __builtin_amdgcn_rcpf(1.0f + __builtin_amdgcn_exp2f(-1.4426950408889634f * g)); }
struct EpiSwiGlu {
    static constexpr bool PERM = true, AFTER_DRAIN = false, WIDE = false;
    bf16_t* O; int ldc; const float* rowss; float inv_n; PG8_LAS float* rstab; unsigned tag;
    __device__ __forceinline__ void operator()(const f32x4 (&acc)[2][2][4][2], const Unit& u, int wr, int wc, int fr, int fq) const {
        typedef float f32x2p __attribute__((ext_vector_type(2)));
        const int row0 = u.pm * BM + wr * 64 + fr, col0 = u.pn * HALF + wc * 32 + 8 * fq;
        float rsv[2][4];
        rstd_rows(rsv, rowss, row0, fr, fq, inv_n, rstab, tag | (unsigned)(u.pm + 1), wr * 4 + wc);
#pragma unroll
        for (int ai = 0; ai < 2; ++ai)
#pragma unroll
            for (int m = 0; m < 4; ++m) { const int row = row0 + ai * HALF + m * 16; const float rs = rsv[ai][m], c = -1.4426950408889634f * rs, rs2 = rs * rs;
                unsigned wv_[4];
#pragma unroll
                for (int n = 0; n < 2; ++n)
#pragma unroll
                    for (int h = 0; h < 2; ++h) { const f32x4 G = acc[ai][0][m][n], U = acc[ai][1][m][n];
                        const f32x2p g = {G[2 * h], G[2 * h + 1]}, up = {U[2 * h], U[2 * h + 1]};
                        const f32x2p t = g * c; f32x2p d = {__builtin_amdgcn_exp2f(t.x), __builtin_amdgcn_exp2f(t.y)}; d = d + 1.0f;
                        const f32x2p r = {__builtin_amdgcn_rcpf(d.x), __builtin_amdgcn_rcpf(d.y)}; const f32x2p o = ((g * up) * rs2) * r;
                        wv_[2 * n + h] = cvt_pk_bf16(o.x, o.y); }
                u32x4 w; w.x = wv_[0]; w.y = wv_[1]; w.z = wv_[2]; w.w = wv_[3];
                *(u32x4*)(O + (size_t)row * ldc + col0) = w; }
    }
};
struct EpiResid {
    static constexpr bool PERM = true, AFTER_DRAIN = false, WIDE = true;
    const float* xin32; float* xout32; bf16_t* yb; int ldy;
    float* rowss; int ldc;
    template <bool IN32> __device__ __forceinline__ void run(const f32x4 (&acc)[2][2][4][2], const Unit& u, int wr, int wc, int fr, int fq) const {
        constexpr int MB = IN32 ? 2 : 4;
        const int col0 = u.pn * BM + wc * 64 + 8 * fq;
#pragma unroll
        for (int ai = 0; ai < 2; ++ai)
#pragma unroll
        for (int mb = 0; mb < 4; mb += MB) {
            u32x4 xw[IN32 ? 1 : MB][2]; f32x4 xf[IN32 ? MB : 1][2][2];
#pragma unroll
            for (int mm = 0; mm < MB; ++mm) { const int row = u.pm * BM + ai * HALF + wr * 64 + (mb + mm) * 16 + fr;
#pragma unroll
                for (int bj = 0; bj < 2; ++bj) {
                    if constexpr (IN32) { const float* p = xin32 + (size_t)row * ldc + col0 + bj * 32; xf[mm][bj][0] = *(const f32x4*)p; xf[mm][bj][1] = *(const f32x4*)(p + 4); }
                    else xw[mm][bj] = *(const u32x4*)(yb + (size_t)row * ldy + col0 + bj * 32); } }
            asm volatile("" ::: "memory");
#pragma unroll
            for (int mm = 0; mm < MB; ++mm) { const int m = mb + mm, row = u.pm * BM + ai * HALF + wr * 64 + m * 16 + fr; float ss = 0.f;
#pragma unroll
                for (int bj = 0; bj < 2; ++bj) { f32x4 x0, x1; const int col = col0 + bj * 32;
                    if constexpr (IN32) { x0 = xf[mm][bj][0]; x1 = xf[mm][bj][1]; }
                    else { const u32x4 w = xw[mm][bj];
                        x0 = (f32x4){__uint_as_float(w.x << 16), __uint_as_float(w.x & 0xffff0000u), __uint_as_float(w.y << 16), __uint_as_float(w.y & 0xffff0000u)};
                        x1 = (f32x4){__uint_as_float(w.z << 16), __uint_as_float(w.z & 0xffff0000u), __uint_as_float(w.w << 16), __uint_as_float(w.w & 0xffff0000u)}; }
                    x0 += acc[ai][bj][m][0]; x1 += acc[ai][bj][m][1];
                    if (xout32) { float* p = xout32 + (size_t)row * ldc + col; __builtin_nontemporal_store(x0, (f32x4*)p); __builtin_nontemporal_store(x1, (f32x4*)(p + 4)); }
                    else { u32x4 w; w.x = cvt_pk_bf16(x0[0], x0[1]); w.y = cvt_pk_bf16(x0[2], x0[3]); w.z = cvt_pk_bf16(x1[0], x1[1]); w.w = cvt_pk_bf16(x1[2], x1[3]); *(u32x4*)(yb + (size_t)row * ldy + col) = w; }
                    ss += ((x0[0] * x0[0] + x0[1] * x0[1]) + (x0[2] * x0[2] + x0[3] * x0[3])) + ((x1[0] * x1[0] + x1[1] * x1[1]) + (x1[2] * x1[2] + x1[3] * x1[3]));
                    }
                ss += __shfl_xor(ss, 16); ss += __shfl_xor(ss, 32);
                if (fq == 0) rowss[(size_t)row * 32 + u.pn * 4 + wc] = ss; }
        }
    }
    __device__ __forceinline__ void operator()(const f32x4 (&acc)[2][2][4][2], const Unit& u, int wr, int wc, int fr, int fq) const {
        if (xin32) run<true>(acc, u, wr, wc, fr, fq); else run<false>(acc, u, wr, wc, fr, fq);
    }
};
template <class Epi, class Sched, bool ALIGN_EPI = false, bool SP2 = false>
__device__ __forceinline__ void gemm_phase(PG8_LAS unsigned char* lds, const Gemm g, const Sched& S, const Epi& E, const int wid) {
    const int lane = fresh_lane(), tid = wid * 64 + lane, wr = wid >> 2, wc = wid & 3, fr = lane & 15, fq = lane >> 4;
    const int K = g.K, nt = K / BK;
    unsigned voffA[2], voffB[2];
#pragma unroll
    for (int i = 0; i < 2; ++i) { int R, C; stage_rc(tid * 16 + i * 8192, R, C); const int Rb = Epi::PERM ? ((Epi::WIDE ? 2 * (R & ~31) : (R & ~31)) + perm32(R & 31)) : R;
        voffA[i] = (unsigned)(R * g.lda + C) * 2u; voffB[i] = (unsigned)(Rb * g.ldb + C) * 2u; }
    const size_t kstep = (size_t)(BK * 2);
    const size_t hstepA = (size_t)HALF * g.lda * 2, hstepB = (size_t)(Epi::WIDE ? 32 : HALF) * g.ldb * 2;
    const size_t tstepA = 2 * hstepA, tstepB = (size_t)BM * g.ldb * 2;
    const unsigned ldsw = (unsigned)wid * 1024u;
    const int aoff = lds_byte(wr * 64 + fr, fq * 8), boff = lds_byte(wc * 32 + fr, fq * 8);
#define PG8_SA(b, h) (((b) * 2 + (h)) * HTB)
#define PG8_SB(b, h) ((4 + (b) * 2 + (h)) * HTB)
#define PG8_STAGE(bufoff, gbase, voff) do { _Pragma("unroll") for (int _i = 0; _i < 2; ++_i) \
        __builtin_amdgcn_global_load_lds((const unsigned*)((const char*)(gbase) + (voff)[_i]), (PG8_LAS unsigned*)(lds + (bufoff) + ldsw + _i * 8192), 16, 0, 0); } while (0)
#define PG8_LDA(dst, b, h) do { _Pragma("unroll") for (int m = 0; m < 4; ++m) _Pragma("unroll") for (int k = 0; k < 2; ++k) dst[m][k] = *(const PG8_LAS bf16x8*)(lds + PG8_SA(b, h) + aoff + m * 2048 + k * 1024); } while (0)
#define PG8_LDB(dst, b, h) do { _Pragma("unroll") for (int n = 0; n < 2; ++n) _Pragma("unroll") for (int k = 0; k < 2; ++k) dst[n][k] = *(const PG8_LAS bf16x8*)(lds + PG8_SB(b, h) + boff + n * 2048 + k * 1024); } while (0)
#define PG8_MMA(ai, bj, At, Bt) do { __builtin_amdgcn_s_setprio(1); _Pragma("unroll") for (int m = 0; m < 4; ++m) _Pragma("unroll") for (int n = 0; n < 2; ++n) _Pragma("unroll") for (int k = 0; k < 2; ++k) \
        acc[ai][bj][m][n] = __builtin_amdgcn_mfma_f32_16x16x32_bf16(Bt[n][k], At[m][k], acc[ai][bj][m][n], 0, 0, 0); __builtin_amdgcn_s_setprio(0); } while (0)
#define PG8_WAIT_V(n) asm volatile("s_waitcnt vmcnt(" #n ")" ::: "memory")
#define PG8_WAIT_L(n) asm volatile("s_waitcnt lgkmcnt(" #n ")" ::: "memory")
#define PG8_BAR __builtin_amdgcn_s_barrier()
#define PG8_SCHED __builtin_amdgcn_sched_barrier(0)
    Unit cur, nxt; int ui = 0;
    if (!S.next(0, cur)) return;
    f32x4 acc[2][2][4][2];
#pragma unroll
    for (int a = 0; a < 2; ++a)
#pragma unroll
        for (int b = 0; b < 2; ++b)
#pragma unroll
            for (int m = 0; m < 4; ++m)
#pragma unroll
                for (int n = 0; n < 2; ++n) acc[a][b][m][n] = (f32x4){0.f, 0.f, 0.f, 0.f};
    bf16x8 At[4][2], B0[2][2], B1[2][2];
    const char* cA = (const char*)g.A + (size_t)cur.pm * tstepA; const char* cB = (const char*)g.Bt + (size_t)cur.pn * tstepB;
    S.a_ready(cur);
    if constexpr (SP2) {
        PG8_STAGE(PG8_SB(0, 0), cB, voffB); PG8_STAGE(PG8_SB(0, 1), cB + hstepB, voffB); PG8_STAGE(PG8_SA(0, 0), cA, voffA); PG8_STAGE(PG8_SA(0, 1), cA + hstepA, voffA);
        if (wr == 1) PG8_BAR;
        PG8_WAIT_V(2); PG8_BAR;
        PG8_STAGE(PG8_SB(1, 0), cB + kstep, voffB); PG8_STAGE(PG8_SA(1, 0), cA + kstep, voffA); PG8_STAGE(PG8_SB(1, 1), cB + hstepB + kstep, voffB);
        PG8_WAIT_V(6); PG8_BAR;
    } else {
        PG8_STAGE(PG8_SB(0, 0), cB, voffB); PG8_STAGE(PG8_SA(0, 0), cA, voffA); PG8_STAGE(PG8_SB(0, 1), cB + hstepB, voffB); PG8_STAGE(PG8_SA(0, 1), cA + hstepA, voffA);
        if (wr == 1) PG8_BAR;
        PG8_WAIT_V(4); PG8_BAR;
        PG8_STAGE(PG8_SB(1, 0), cB + kstep, voffB); PG8_STAGE(PG8_SA(1, 0), cA + kstep, voffA); PG8_STAGE(PG8_SB(1, 1), cB + hstepB + kstep, voffB);
        PG8_WAIT_V(6); PG8_BAR;
    }
    for (;;) {
        const bool has_next = S.next(ui + 1, nxt);
        const char* nA = has_next ? (const char*)g.A + (size_t)nxt.pm * tstepA : cA; const char* nB = has_next ? (const char*)g.Bt + (size_t)nxt.pn * tstepB : cB;
        for (int t = 0; t < nt; t += 2) {
            const bool last = (t == nt - 2);
            const char* a1 = cA + (size_t)(t + 1) * kstep;
            const char* a2 = last ? nA : cA + (size_t)(t + 2) * kstep; const char* b2 = last ? nB : cB + (size_t)(t + 2) * kstep;
            const char* a3 = a2 + kstep; const char* b3 = b2 + kstep;
            if (last && has_next) S.a_ready(nxt);
            if constexpr (SP2) {
            PG8_LDB(B0, 0, 0); PG8_LDB(B1, 0, 1); PG8_SCHED; PG8_LDA(At, 0, 0); PG8_STAGE(PG8_SA(1, 1), a1 + hstepA, voffA);
            PG8_WAIT_V(8); PG8_WAIT_L(0); PG8_BAR; PG8_MMA(0, 0, At, B0); PG8_MMA(0, 1, At, B1); PG8_BAR; PG8_SCHED;
            PG8_LDA(At, 0, 1); PG8_STAGE(PG8_SB(0, 0), b2, voffB); PG8_STAGE(PG8_SB(0, 1), b2 + hstepB, voffB); PG8_STAGE(PG8_SA(0, 0), a2, voffA);
            PG8_WAIT_V(8); PG8_WAIT_L(0); PG8_BAR; PG8_MMA(1, 0, At, B0); PG8_MMA(1, 1, At, B1); PG8_BAR; PG8_SCHED;
            PG8_LDB(B0, 1, 0); PG8_LDB(B1, 1, 1); PG8_SCHED; PG8_LDA(At, 1, 0); PG8_STAGE(PG8_SA(0, 1), a2 + hstepA, voffA);
            PG8_WAIT_V(8); PG8_WAIT_L(0); PG8_BAR; PG8_MMA(0, 0, At, B0); PG8_MMA(0, 1, At, B1); PG8_BAR; PG8_SCHED;
            PG8_LDA(At, 1, 1); PG8_STAGE(PG8_SB(1, 0), b3, voffB); PG8_STAGE(PG8_SB(1, 1), b3 + hstepB, voffB); PG8_STAGE(PG8_SA(1, 0), a3, voffA);
            PG8_WAIT_V(8); PG8_WAIT_L(0); PG8_BAR; PG8_MMA(1, 0, At, B0); PG8_MMA(1, 1, At, B1); PG8_BAR; PG8_SCHED;
            } else {
            PG8_LDB(B0, 0, 0); PG8_SCHED; PG8_LDA(At, 0, 0); PG8_STAGE(PG8_SA(1, 1), a1 + hstepA, voffA);
            PG8_WAIT_L(8); PG8_BAR; PG8_WAIT_L(0); PG8_MMA(0, 0, At, B0); PG8_BAR; PG8_SCHED;
            PG8_LDB(B1, 0, 1); PG8_STAGE(PG8_SB(0, 0), b2, voffB);
            PG8_BAR; PG8_WAIT_L(0); PG8_MMA(0, 1, At, B1); PG8_BAR;
            PG8_LDA(At, 0, 1); PG8_STAGE(PG8_SA(0, 0), a2, voffA);
            PG8_BAR; PG8_WAIT_L(0); PG8_MMA(1, 0, At, B0); PG8_BAR; PG8_SCHED;
            PG8_STAGE(PG8_SB(0, 1), b2 + hstepB, voffB);
            PG8_WAIT_V(6); PG8_BAR; PG8_MMA(1, 1, At, B1); PG8_BAR;
            PG8_LDB(B0, 1, 0); PG8_SCHED; PG8_LDA(At, 1, 0); PG8_STAGE(PG8_SA(0, 1), a2 + hstepA, voffA);
            PG8_WAIT_L(8); PG8_BAR; PG8_WAIT_L(0); PG8_MMA(0, 0, At, B0); PG8_BAR; PG8_SCHED;
            PG8_LDB(B1, 1, 1); PG8_STAGE(PG8_SB(1, 0), b3, voffB);
            PG8_BAR; PG8_WAIT_L(0); PG8_MMA(0, 1, At, B1); PG8_BAR;
            PG8_LDA(At, 1, 1); PG8_STAGE(PG8_SA(1, 0), a3, voffA);
            PG8_BAR; PG8_WAIT_L(0); PG8_MMA(1, 0, At, B0); PG8_BAR; PG8_SCHED;
            PG8_STAGE(PG8_SB(1, 1), b3 + hstepB, voffB);
            PG8_WAIT_V(6); PG8_BAR; PG8_MMA(1, 1, At, B1); PG8_BAR;
            }
        }
        if constexpr (ALIGN_EPI) { if (wr == 0) PG8_BAR; }
        if constexpr (!Epi::AFTER_DRAIN) { E(acc, cur, wr, wc, fr, fq); S.done(cur); }
        if (!has_next) break;
#pragma unroll
        for (int a = 0; a < 2; ++a)
#pragma unroll
            for (int b = 0; b < 2; ++b)
#pragma unroll
                for (int m = 0; m < 4; ++m)
#pragma unroll
                    for (int n = 0; n < 2; ++n) acc[a][b][m][n] = (f32x4){0.f, 0.f, 0.f, 0.f};
        cur = nxt; cA = nA; cB = nB; ++ui;
        if constexpr (ALIGN_EPI) { if (wr == 1) PG8_BAR; }
    }
    PG8_WAIT_V(0);
    if constexpr (!ALIGN_EPI) { if (wr == 0) PG8_BAR; }
    PG8_BAR;
    if constexpr (Epi::AFTER_DRAIN) { E.fused(acc, cur, wr, wc, fr, fq, lds, wid, lane); S.done(cur); }
#undef PG8_SA
#undef PG8_SB
#undef PG8_STAGE
#undef PG8_LDA
#undef PG8_LDB
#undef PG8_MMA
#undef PG8_WAIT_V
#undef PG8_WAIT_L
#undef PG8_BAR
#undef PG8_SCHED
}
}
#define GAS __attribute__((address_space(1)))
#define LAS __attribute__((address_space(3)))
typedef unsigned short bf16;
typedef unsigned v4u __attribute__((ext_vector_type(4)));
typedef float f32x4 __attribute__((ext_vector_type(4)));
typedef short bf16x8 __attribute__((ext_vector_type(8)));
typedef GAS unsigned gu32;
typedef GAS unsigned long long gu64;
#define RLX_AGENT __ATOMIC_RELAXED, __HIP_MEMORY_SCOPE_AGENT
#define LDS_WAIT() asm volatile("s_waitcnt lgkmcnt(0)" ::: "memory")
#define VM_WAIT() asm volatile("s_waitcnt vmcnt(0)" ::: "memory")
__device__ __forceinline__ unsigned long long rt() { return __builtin_amdgcn_s_memrealtime(); }
__device__ __forceinline__ unsigned f2bf(float f) { unsigned u = __builtin_bit_cast(unsigned, f); return (u + 0x7fffu + ((u >> 16) & 1u)) >> 16; }
__device__ __forceinline__ unsigned pk2(float lo, float hi) { return f2bf(lo) | (f2bf(hi) << 16); }

#define XB_TMO      128
#define XB_XCNT(j)  (256  + 64 * (j))
#define XB_XSUB(j)  (1280 + 64 * (j))
#define XB_XGEN(j)  (2304 + 64 * (j))
#define XB_TOP      3328
#define XB_TOPGEN   3392
#define XCD_BAR_WORDS 3456
#define XB_SPIN_CAP (1u << 18)

__device__ __forceinline__ unsigned xb_ld(unsigned* p)              { return __hip_atomic_load(p, __ATOMIC_RELAXED, __HIP_MEMORY_SCOPE_AGENT); }
__device__ __forceinline__ unsigned xb_add(unsigned* p, unsigned v) { return __hip_atomic_fetch_add(p, v, __ATOMIC_RELAXED, __HIP_MEMORY_SCOPE_AGENT); }
__device__ __forceinline__ unsigned xb_xcc_id() { return (unsigned)__builtin_amdgcn_s_getreg((3 << 11) | 20) & 0xFu; }
#define XB_SPIN(cond, bar) do { unsigned _sp = 0; while (cond) { __builtin_amdgcn_s_sleep(1); \
    if ((++_sp & 255u) == 0u) { if (xb_ld(&(bar)[XB_TMO])) break; if (_sp > XB_SPIN_CAP) { atomicAdd(&(bar)[XB_TMO], 1u); break; } } } } while (0)

struct XcdBarrier {
    unsigned* bar; unsigned x;
    volatile LAS unsigned* st;
};

__device__ __forceinline__ XcdBarrier xcd_barrier_post(unsigned* bar, volatile LAS unsigned* st, const bool leader  ) {
    XcdBarrier b; b.bar = bar; b.x = xb_xcc_id(); b.st = st;
    if (leader) (void)xb_add(&bar[XB_XCNT(b.x)], 1u);
    return b;
}
__device__ __forceinline__ void xcd_barrier_complete(unsigned* bar, unsigned x, unsigned& nloc, unsigned& nx) {
    const unsigned G = gridDim.x * gridDim.y * gridDim.z;
    unsigned sum, cnt, mine, sp = 0u;
    for (;;) {
        sum = 0u; cnt = 0u; mine = 0u;
#pragma unroll
        for (unsigned j = 0; j < 16; ++j) { const unsigned c = xb_ld(&bar[XB_XCNT(j)]); sum += c; cnt += (c > 0u) ? 1u : 0u; mine = (j == x) ? c : mine; }
        if (sum == G) break;
        __builtin_amdgcn_s_sleep(1);
        if ((++sp & 255u) == 0u) { if (xb_ld(&bar[XB_TMO])) break; if (sp > XB_SPIN_CAP) { atomicAdd(&bar[XB_TMO], 1u); break; } }
    }
    nloc = mine > 0u ? mine : 1u; nx = cnt > 0u ? cnt : 1u;
}

__device__ __forceinline__ void xcd_barrier(const XcdBarrier& b, const bool leader  ) {
    asm volatile("s_waitcnt vmcnt(0)" ::: "memory");
    __syncthreads();
    if (leader) {
        unsigned* bar = b.bar;
        __builtin_amdgcn_s_waitcnt(0);
        unsigned nloc = b.st[0], nx = b.st[1];
        if (nloc == 0u) { xcd_barrier_complete(bar, b.x, nloc, nx); b.st[0] = nloc; b.st[1] = nx; }
        const unsigned old = xb_add(&bar[XB_XSUB(b.x)], 1u);
        const unsigned gen = old / nloc;
        if (old + 1u == (gen + 1u) * nloc) {
            __builtin_amdgcn_fence(__ATOMIC_RELEASE, "agent");
            asm volatile("s_waitcnt vmcnt(0)" ::: "memory");
            const unsigned og = xb_add(&bar[XB_TOP], 1u);
            const unsigned tg = og / nx;
            if (og + 1u == (tg + 1u) * nx) xb_add(&bar[XB_TOPGEN], 1u);
            else XB_SPIN(xb_ld(&bar[XB_TOPGEN]) == tg, bar);
            __builtin_amdgcn_fence(__ATOMIC_ACQUIRE, "agent");
            xb_add(&bar[XB_XGEN(b.x)], 1u);
            asm volatile("s_waitcnt vmcnt(0)" ::: "memory");
        } else {
            XB_SPIN(xb_ld(&bar[XB_XGEN(b.x)]) == gen, bar);
            __builtin_amdgcn_fence(__ATOMIC_ACQUIRE, "agent");
            asm volatile("s_waitcnt vmcnt(0)" ::: "memory");
        }
    }
    __syncthreads();
}

constexpr int NWAVES = 8;
constexpr int DM = 2048, SEQ = 16384, DEPTH = 4, DB = 8, DS = 32, PAST = 1024;
constexpr int MS = DB * DS;
constexpr int M = SEQ + MS;
constexpr int SKEYS = PAST + DS;
constexpr int NKR = SEQ + DB * SKEYS;
constexpr int NKRP = NKR + 128;
constexpr int NIN = 3908, NPROJ = 4096;
constexpr int DFF = 5632, NQC = 768, NKV = 1024, MIXW = 1536, HD = 128, QKD = 192;
constexpr int LDX = DM + 128, LDMIX = MIXW + 128, LDH = DFF + 128, LDCQ = 512 + 128, LDCKV = 256 + 128;
constexpr float EPS = 1e-6f, LOG2E = 1.4426950408889634f, LN2 = 0.6931471805599453f;
constexpr float QS_A = 0.08838834764831845f * LOG2E;
constexpr float QS_B = 0.08838834764831845f;
constexpr float QS_C = 0.07216878364870322f * LOG2E;
constexpr size_t O_Y = 0;
constexpr size_t O_FKP = O_Y + (size_t)M * DM;
constexpr size_t O_FVP = O_FKP + (size_t)DEPTH * SEQ * 512;
constexpr size_t O_FLP = O_FVP + (size_t)DEPTH * SEQ * 512;
constexpr size_t O_SKP = O_FLP + (size_t)DEPTH * SEQ * 4;
constexpr size_t O_SVP = O_SKP + (size_t)DEPTH * SEQ * 512;
constexpr size_t O_CKP = O_SVP + (size_t)DEPTH * SEQ * 512;
constexpr size_t O_KRP = O_CKP + (size_t)DEPTH * SEQ * 256;
constexpr size_t O_FKS = O_KRP + (size_t)DEPTH * SEQ * 64;
constexpr size_t O_FVS = O_FKS + (size_t)DEPTH * MS * 512;
constexpr size_t O_FLS = O_FVS + (size_t)DEPTH * MS * 512;
constexpr size_t O_SKS = O_FLS + (size_t)DEPTH * MS * 4;
constexpr size_t O_SVS = O_SKS + (size_t)DEPTH * MS * 512;
constexpr size_t O_CKS = O_SVS + (size_t)DEPTH * MS * 512;
constexpr size_t O_KRS = O_CKS + (size_t)DEPTH * MS * 256;
constexpr size_t O_END = O_KRS + (size_t)DEPTH * MS * 64;
static_assert(O_END == 191959040ull, "d_out size");
constexpr size_t MiB = 1u << 20;
constexpr size_t WS_CTL = 0, CTL_ZERO_BYTES = 1 * MiB;
constexpr size_t WS_W = 2 * MiB, W_LAYER = 96 * MiB;
constexpr size_t WO_IN = 0, WO_UQ = 17 * MiB, WO_UKV = 18 * MiB, WO_OUT = 19 * MiB, WO_GU = 26 * MiB, WO_DOWN = 73 * MiB;
constexpr size_t WS_ROPE = WS_W + DEPTH * W_LAYER;
constexpr size_t WS_XN = WS_ROPE + 4 * MiB;
constexpr size_t WS_RSS = WS_XN + 70 * MiB;
constexpr size_t WS_QA = WS_RSS + 3 * MiB, WS_QB = WS_QA + 17 * MiB, WS_CQ = WS_QB + 17 * MiB;
constexpr size_t WS_KA = WS_CQ + 21 * MiB, WS_VA = WS_KA + 25 * MiB, WS_KB = WS_VA + 25 * MiB, WS_VB = WS_KB + 25 * MiB;
constexpr size_t WS_CKVN = WS_VB + 25 * MiB;
constexpr size_t WS_KROPE = WS_CKVN + 19 * MiB;
constexpr size_t WS_LOGF = WS_KROPE + 7 * MiB;
constexpr size_t WS_FBIAS = WS_LOGF + 1 * MiB;
constexpr size_t WS_QN = WS_FBIAS + 1 * MiB;
constexpr size_t WS_QC = WS_QN + 1 * MiB;
constexpr size_t WS_KC = WS_QC + 25 * MiB;
constexpr size_t WS_ATT = WS_KC + 37 * MiB;
constexpr size_t WS_MIX = WS_ATT + 49 * MiB;
constexpr size_t WS_R = WS_MIX + 53 * MiB;
constexpr size_t WS_PROJ = WS_R, WS_QCR = WS_R + 130 * MiB, WS_KVR = WS_QCR + 25 * MiB;
constexpr size_t WS_H = WS_R;
constexpr size_t WS_PO = WS_R + 204 * MiB;
constexpr size_t WS_PML = WS_PO + 64 * MiB;
constexpr size_t WS_RSSS = WS_PML + 2 * MiB;
constexpr size_t WS_YB = WS_RSSS + 1 * MiB;
constexpr size_t WS_KRSS = WS_YB + 64 * MiB;
constexpr size_t WS_CQSS = WS_KRSS + 1 * MiB;
constexpr size_t WS_END = WS_CQSS + 2 * MiB;
static_assert((size_t)M * LDX * 2 <= 70 * MiB && (size_t)M * 32 * 4 <= 3 * MiB && (size_t)M * 512 * 2 <= 17 * MiB && (size_t)M * LDCQ * 2 <= 21 * MiB && (size_t)NKRP * 512 * 2 <= 25 * MiB, "ws map 1");
static_assert((size_t)NKRP * LDCKV * 2 <= 19 * MiB && (size_t)NKRP * 64 * 4 <= 7 * MiB && (size_t)NKRP * 16 <= 1 * MiB && (size_t)M * 768 * 2 <= 25 * MiB && (size_t)NKRP * 768 * 2 <= 37 * MiB, "ws map 2");
static_assert((size_t)M * 1536 * 2 <= 49 * MiB && (size_t)M * LDMIX * 2 <= 53 * MiB && (size_t)M * 4096 * 2 <= 130 * MiB && (size_t)NKRP * 1024 * 2 <= 49 * MiB && (size_t)M * LDH * 2 <= 204 * MiB, "ws map 3");
static_assert((size_t)NPROJ * LDX * 2 <= 17 * MiB && (size_t)NQC * LDCQ * 2 <= MiB && (size_t)NKV * LDCKV * 2 <= MiB && (size_t)DM * LDMIX * 2 <= 7 * MiB && (size_t)2 * DFF * LDX * 2 <= 47 * MiB && (size_t)DM * LDH * 2 <= 23 * MiB, "ws map 4");
constexpr int CW_TMO = 0, CW_CODE = 1, CW_BAR = 4096, CW_AQ = 8192, CW_KMAX = 12288;
constexpr int RING_OFF = 0, RING_BYTES = 131072;
constexpr int LDSCTL_OFF = RING_BYTES, MISC_OFF = LDSCTL_OFF + 320;
constexpr int LDS_BYTES = 147456;
constexpr int RSTAB_OFF = RING_BYTES + 1024 + 8192;
static_assert(RSTAB_OFF + 4096 + 32 <= LDS_BYTES, "LDS map");

typedef float f32x2 __attribute__((ext_vector_type(2)));
__device__ __forceinline__ unsigned pkbf(float lo, float hi) { unsigned r; asm("v_cvt_pk_bf16_f32 %0, %1, %2" : "=v"(r) : "v"(lo), "v"(hi)); return r; }
__device__ __forceinline__ void unpack8(v4u w, float* x) {
    x[0] = __uint_as_float(w.x << 16); x[1] = __uint_as_float(w.x & 0xffff0000u); x[2] = __uint_as_float(w.y << 16); x[3] = __uint_as_float(w.y & 0xffff0000u);
    x[4] = __uint_as_float(w.z << 16); x[5] = __uint_as_float(w.z & 0xffff0000u); x[6] = __uint_as_float(w.w << 16); x[7] = __uint_as_float(w.w & 0xffff0000u); }
__device__ __forceinline__ v4u pack8(const float* y) { v4u w; w.x = pkbf(y[0], y[1]); w.y = pkbf(y[2], y[3]); w.z = pkbf(y[4], y[5]); w.w = pkbf(y[6], y[7]); return w; }
__device__ __forceinline__ void ld8f(const float* p, float* x) { const f32x4 a = *(const f32x4*)p, b = *(const f32x4*)(p + 4); x[0] = a[0]; x[1] = a[1]; x[2] = a[2]; x[3] = a[3]; x[4] = b[0]; x[5] = b[1]; x[6] = b[2]; x[7] = b[3]; }
__device__ __forceinline__ void st8f(float* p, const float* x) { *(f32x4*)p = (f32x4){x[0], x[1], x[2], x[3]}; *(f32x4*)(p + 4) = (f32x4){x[4], x[5], x[6], x[7]}; }
__device__ __forceinline__ void st8f_nt(float* p, const float* x) { __builtin_nontemporal_store((f32x4){x[0], x[1], x[2], x[3]}, (f32x4*)p); __builtin_nontemporal_store((f32x4){x[4], x[5], x[6], x[7]}, (f32x4*)(p + 4)); }
__device__ __forceinline__ float sumsq8(const float* x) { return ((x[0] * x[0] + x[1] * x[1]) + (x[2] * x[2] + x[3] * x[3])) + ((x[4] * x[4] + x[5] * x[5]) + (x[6] * x[6] + x[7] * x[7])); }
__device__ __forceinline__ float wsum16(float v) { v += __shfl_xor(v, 1); v += __shfl_xor(v, 2); v += __shfl_xor(v, 4); v += __shfl_xor(v, 8); return v; }
__device__ __forceinline__ float wsum32(float v) { v = wsum16(v); v += __shfl_xor(v, 16); return v; }
__device__ __forceinline__ float wsum64(float v) { v = wsum32(v); v += __shfl_xor(v, 32); return v; }
enum { I_XP = 0, I_XS, I_CFK, I_CFV, I_CFL, I_CSK, I_CSV, I_CCKV, I_CKR, I_NMIX, I_WIN, I_FBIAS, I_FQN, I_FKN, I_QAN, I_WUQ, I_KVAN, I_WUKV, I_QN, I_KN, I_ONA, I_ONB, I_ONC, I_WOUT, I_NFFN, I_WGU, I_WDOWN, N_INPUTS };
struct KArgs { const float* in[N_INPUTS]; float* out; unsigned char* ws; int ph_lo, ph_hi; };
static_assert(sizeof(KArgs) == N_INPUTS * 8 + 8 + 8 + 8, "KArgs has no padding");

template <int MAT> __device__ __forceinline__ int srccol(int n) {
    if (MAT == 0) { if (n < 1536) return n; if (n < 3904) return n + 4; if (n < 3908) return 1536 + (n - 3904); return -1; }
    if (MAT == 1) { const int pn = n >> 8, half = (n >> 7) & 1, j = n & 127; return half * DFF + pn * 128 + j; }
    return n;
}
__device__ __forceinline__ void p0_transpose_item(const float* W, int Nsrc, int Ndst, bf16* WT, int ldw, int mat, int item, int lane, const float* gain) {
    const int nblk = Ndst >> 6, kb = item / nblk, nb = item - kb * nblk, n = 64 * nb + 4 * (lane & 15), k = 64 * kb + 16 * (lane >> 4);
    const int sc0 = srccol<0>(n), sc1 = srccol<1>(n), sc = mat == 0 ? sc0 : mat == 1 ? sc1 : n;
    f32x4 v[16];
    const float* src = W + (size_t)k * Nsrc + (sc >= 0 ? sc : 0);
#pragma unroll
    for (int i = 0; i < 16; ++i) v[i] = __builtin_nontemporal_load((const f32x4*)(src + (size_t)i * Nsrc));
    if (sc < 0) {
#pragma unroll
        for (int i = 0; i < 16; ++i) v[i] = (f32x4){0.f, 0.f, 0.f, 0.f}; }
    if (gain) { const f32x4 g0 = *(const f32x4*)(gain + k), g1 = *(const f32x4*)(gain + k + 4), g2 = *(const f32x4*)(gain + k + 8), g3 = *(const f32x4*)(gain + k + 12);
#pragma unroll
        for (int i = 0; i < 4; ++i) { v[i] *= g0[i]; v[4 + i] *= g1[i]; v[8 + i] *= g2[i]; v[12 + i] *= g3[i]; } }
    bf16* dst = WT + (size_t)n * ldw + k;
#pragma unroll
    for (int j = 0; j < 4; ++j) { v4u o0, o1;
        o0.x = pkbf(v[0][j], v[1][j]); o0.y = pkbf(v[2][j], v[3][j]); o0.z = pkbf(v[4][j], v[5][j]); o0.w = pkbf(v[6][j], v[7][j]);
        o1.x = pkbf(v[8][j], v[9][j]); o1.y = pkbf(v[10][j], v[11][j]); o1.z = pkbf(v[12][j], v[13][j]); o1.w = pkbf(v[14][j], v[15][j]);
        *(GAS v4u*)(dst + (size_t)j * ldw) = o0; *(GAS v4u*)(dst + (size_t)j * ldw + 8) = o1; }
}
constexpr int CI_IN = (DM / 64) * (NPROJ / 64), CI_UQ = (512 / 64) * (NQC / 64), CI_UKV = (256 / 64) * (NKV / 64), CI_OUT = (MIXW / 64) * (DM / 64),
              CI_GU = (DM / 64) * (2 * DFF / 64), CI_DN = (DFF / 64) * (DM / 64), CI_LAYER = CI_IN + CI_UQ + CI_UKV + CI_OUT + CI_GU + CI_DN;
constexpr int CONV_PER_UNIT = 24, NCONV = (CI_LAYER + CONV_PER_UNIT - 1) / CONV_PER_UNIT;
__device__ __forceinline__ void p0_conv_item(const KArgs& a, int l, int r, int lane) {
    const float* W = a.in[I_WIN] + (size_t)l * DM * NIN; int Nsrc = NIN, Ndst = NPROJ, ldw = LDX, mat = 0; size_t wo = WO_IN;
    if (r >= CI_IN) { r -= CI_IN; W = a.in[I_WUQ] + (size_t)l * 512 * NQC; Nsrc = NQC; Ndst = NQC; ldw = LDCQ; mat = 2; wo = WO_UQ;
        if (r >= CI_UQ) { r -= CI_UQ; W = a.in[I_WUKV] + (size_t)l * 256 * NKV; Nsrc = NKV; Ndst = NKV; ldw = LDCKV; wo = WO_UKV;
            if (r >= CI_UKV) { r -= CI_UKV; W = a.in[I_WOUT] + (size_t)l * MIXW * DM; Nsrc = DM; Ndst = DM; ldw = LDMIX; wo = WO_OUT;
                if (r >= CI_OUT) { r -= CI_OUT; W = a.in[I_WGU] + (size_t)l * DM * 2 * DFF; Nsrc = 2 * DFF; Ndst = 2 * DFF; ldw = LDX; mat = 1; wo = WO_GU;
                    if (r >= CI_GU) { r -= CI_GU; W = a.in[I_WDOWN] + (size_t)l * DFF * DM; Nsrc = DM; Ndst = DM; ldw = LDH; mat = 2; wo = WO_DOWN; } } } } }
    p0_transpose_item(W, Nsrc, Ndst, (bf16*)(a.ws + WS_W + (size_t)l * W_LAYER + wo), ldw, mat, r, lane, mat == 0 ? a.in[I_NMIX] + l * DM : mat == 1 ? a.in[I_NFFN] + l * DM : nullptr);
}
__device__ __forceinline__ void p0_prologue(const KArgs& a, LAS unsigned char* lds, int gw, int NGW, int lane, int wave) {
    unsigned char* ws = a.ws;
    for (int it = gw; it < (CONV_IN_E ? 1 : DEPTH) * CI_LAYER; it += NGW) { const int l = it / CI_LAYER; p0_conv_item(a, l, it - l * CI_LAYER, lane); }
    bf16* XN = (bf16*)(ws + WS_XN); float* RSS = (float*)(ws + WS_RSS);
    for (int r = gw; r < M; r += NGW) {
        const float* xr = (r < SEQ ? a.in[I_XP] + (size_t)r * DM : a.in[I_XS] + (size_t)(r - SEQ) * DM) + 4 * lane; float ss = 0.f;
        f32x4 vv[8], gg[8];
#pragma unroll
        for (int j = 0; j < 8; ++j) { vv[j] = *(const f32x4*)(xr + 256 * j); gg[j] = (f32x4){1.f, 1.f, 1.f, 1.f}; }
        asm volatile("" ::: "memory");
#pragma unroll
        for (int j = 0; j < 8; ++j) { const f32x4 v = vv[j], g = gg[j];
            ss += (v[0] * v[0] + v[1] * v[1]) + (v[2] * v[2] + v[3] * v[3]);
            f32x2 o; o.x = __uint_as_float(pkbf(v[0] * g[0], v[1] * g[1])); o.y = __uint_as_float(pkbf(v[2] * g[2], v[3] * g[3]));
            *(f32x2*)(XN + (size_t)r * LDX + 4 * lane + 256 * j) = o; }
        ss = wsum64(ss);
        if (lane < 32) RSS[(size_t)r * 32 + lane] = lane == 0 ? ss : 0.f;
        if (r >= SEQ) { float* rs_ = (float*)(ws + WS_RSSS) + (size_t)(r - SEQ) * 128; rs_[lane] = lane == 0 ? ss : 0.f; rs_[64 + lane] = 0.f; }
    }
    f32x2* ROPE = (f32x2*)(ws + WS_ROPE);
    for (int e = gw * 64 + lane; e < SEQ * 32; e += NGW * 64) { const int pos = e >> 5, j = e & 31;
        const float inv = exp2f(-(float)j * 0.4152410118609203f); const float ang = (float)pos * inv;
        double rv = (double)ang * 0.15915494309189535; rv -= rint(rv);
        ROPE[e] = (f32x2){__builtin_amdgcn_cosf((float)rv), __builtin_amdgcn_sinf((float)rv)}; }
    for (int e = gw * 64 + lane; e < 128 * 64; e += NGW * 64) { const int pr = NKR + (e >> 6), c = (e & 63) * 8; const v4u z = {0u, 0u, 0u, 0u};
        *(v4u*)((bf16*)(ws + WS_KA) + (size_t)pr * 512 + c) = z; *(v4u*)((bf16*)(ws + WS_VA) + (size_t)pr * 512 + c) = z;
        *(v4u*)((bf16*)(ws + WS_KB) + (size_t)pr * 512 + c) = z; *(v4u*)((bf16*)(ws + WS_VB) + (size_t)pr * 512 + c) = z;
        *(v4u*)((bf16*)(ws + WS_KC) + (size_t)pr * 768 + c) = z; if (c < 256) *(v4u*)((bf16*)(ws + WS_KC) + (size_t)pr * 768 + 512 + c) = z;
        *(v4u*)((bf16*)(ws + WS_KVR) + (size_t)pr * 1024 + c) = z; *(v4u*)((bf16*)(ws + WS_KVR) + (size_t)pr * 1024 + 512 + c) = z;
        if (c < 4 * 8) ((float*)(ws + WS_FBIAS))[(size_t)(c >> 3) * NKRP + pr] = 0.f; }
}

__device__ __forceinline__ float log_sigmoid(float v) { return fminf(v, 0.f) - log1pf(__expf(-fabsf(v))); }
struct PbGains { float gq[8], gk[8], gqa[8], gkv[8]; f32x4 fb; };
__device__ __forceinline__ void pb_token_row(const KArgs& a, int l, int r, int lane, const v4u (&w)[8], const PbGains& G_, float& kmA, float& kmB) {
    unsigned char* ws = a.ws; float* out = a.out;
    const bool smp = r >= SEQ; const int rs_ = r - SEQ;
    const int kr = smp ? SEQ + (rs_ >> 5) * SKEYS + PAST + (rs_ & 31) : r;
    const size_t orow = smp ? (size_t)l * MS + rs_ : (size_t)l * SEQ + r;
    float x[8], y[8];
    { unpack8(w[0], x); const float rs = 1.0f / sqrtf(wsum16(sumsq8(x)) * (1.f / 128.f) + EPS);
#pragma unroll
      for (int i = 0; i < 8; ++i) y[i] = x[i] * rs * G_.gq[i] * QS_A;
      *(v4u*)((bf16*)(ws + WS_QA) + (size_t)r * 512 + lane * 8) = pack8(y); }
    { unpack8(w[1], x); const float rs = 1.0f / sqrtf(wsum16(sumsq8(x)) * (1.f / 128.f) + EPS);
#pragma unroll
      for (int i = 0; i < 8; ++i) y[i] = x[i] * rs * G_.gk[i];
      st8f_nt(out + (smp ? O_FKS : O_FKP) + orow * 512 + lane * 8, y); *(v4u*)((bf16*)(ws + WS_KA) + (size_t)kr * 512 + lane * 8) = pack8(y);
      kmA = fmaxf(kmA, wsum16(sumsq8(y))); }
    if (smp) {
    { unpack8(w[2], x); st8f_nt(out + O_FVS + orow * 512 + lane * 8, x); *(v4u*)((bf16*)(ws + WS_VA) + (size_t)kr * 512 + lane * 8) = w[2]; }
    { unpack8(w[3], x);
#pragma unroll
      for (int i = 0; i < 8; ++i) y[i] = x[i] * QS_B;
      *(v4u*)((bf16*)(ws + WS_QB) + (size_t)r * 512 + lane * 8) = pack8(y); }
    { unpack8(w[4], x); st8f_nt(out + O_SKS + orow * 512 + lane * 8, x); *(v4u*)((bf16*)(ws + WS_KB) + (size_t)kr * 512 + lane * 8) = w[4];
      kmB = fmaxf(kmB, wsum16(sumsq8(x))); }
    { unpack8(w[5], x); st8f_nt(out + O_SVS + orow * 512 + lane * 8, x); *(v4u*)((bf16*)(ws + WS_VB) + (size_t)kr * 512 + lane * 8) = w[5]; }
    }
    { unpack8(w[6], x); const float ssq = wsum64(sumsq8(x)); const float rs = FUSE_B ? 1.0f : 1.0f / sqrtf(ssq * (1.f / 512.f) + EPS);
#pragma unroll
      for (int i = 0; i < 8; ++i) y[i] = x[i] * rs * G_.gqa[i];
      *(v4u*)((bf16*)(ws + WS_CQ) + (size_t)r * LDCQ + lane * 8) = pack8(y);
      if (FUSE_B && lane < 16) ((float*)(ws + WS_CQSS))[(size_t)r * 16 + lane] = lane == 0 ? ssq : 0.f; }
    { unpack8(w[7], x);
      const float rs = 1.0f / sqrtf(wsum32(sumsq8(x)) * (1.f / 256.f) + EPS);
      if (lane < 32) {
#pragma unroll
          for (int i = 0; i < 8; ++i) y[i] = x[i] * rs * G_.gkv[i];
          st8f_nt(out + (smp ? O_CKS : O_CKP) + orow * 256 + lane * 8, y); *(v4u*)((bf16*)(ws + WS_CKVN) + (size_t)kr * LDCKV + lane * 8) = pack8(y); }
      else if (lane < 40) { st8f_nt(out + (smp ? O_KRS : O_KRP) + orow * 64 + (lane - 32) * 8, x); st8f((float*)(ws + WS_KROPE) + (size_t)kr * 64 + (lane - 32) * 8, x); }
      else if (lane == 40) { const f32x4 fb = G_.fb;
          const f32x4 lf = {log_sigmoid(x[0] + fb[0]), log_sigmoid(x[1] + fb[1]), log_sigmoid(x[2] + fb[2]), log_sigmoid(x[3] + fb[3])};
          *(f32x4*)(out + (smp ? O_FLS : O_FLP) + orow * 4) = lf; *(f32x4*)((float*)(ws + WS_LOGF) + (size_t)kr * 4) = lf; }
      { float k2 = (lane >= 32 && lane < 40) ? sumsq8(x) : 0.f; k2 += __shfl_xor(k2, 1); k2 += __shfl_xor(k2, 2); k2 += __shfl_xor(k2, 4); if (lane == 32) ((float*)(ws + WS_KRSS))[kr] = k2; }
    }
}
__device__ __forceinline__ void pb_tokens(const KArgs& a, int l, int gw, int NGW, int lane, float& kmA, float& kmB) {
    PbGains G_; ld8f(a.in[I_FQN] + l * 128 + (lane & 15) * 8, G_.gq); ld8f(a.in[I_FKN] + l * 128 + (lane & 15) * 8, G_.gk); ld8f(a.in[I_QAN] + l * 512 + lane * 8, G_.gqa);
    ld8f(a.in[I_KVAN] + l * 256 + (lane & 31) * 8, G_.gkv); G_.fb = *(const f32x4*)(a.in[I_FBIAS] + l * 4);
    const bf16* P = (const bf16*)(a.ws + WS_PROJ) + lane * 8;
    v4u cur[8], nxt[8];
    const int r0 = FUSE_B ? SEQ + gw : gw;
    if (r0 < M) {
#pragma unroll
        for (int s_ = 0; s_ < 8; ++s_) if (r0 >= SEQ || s_ < 2 || s_ > 5) cur[s_] = *(const v4u*)(P + (size_t)r0 * NPROJ + s_ * 512); }
    for (int r = r0; r < M; r += NGW) {
        const int rn = r + NGW < M ? r + NGW : r;
#pragma unroll
        for (int s_ = 0; s_ < 8; ++s_) if (rn >= SEQ || s_ < 2 || s_ > 5) nxt[s_] = *(const v4u*)(P + (size_t)rn * NPROJ + s_ * 512);
        __builtin_amdgcn_sched_barrier(0);
        pb_token_row(a, l, r, lane, cur, G_, kmA, kmB);
        __builtin_amdgcn_sched_barrier(0);
#pragma unroll
        for (int s_ = 0; s_ < 8; ++s_) cur[s_] = nxt[s_];
    }
}
__device__ __forceinline__ void pb_cache_row(const KArgs& a, int l, int cr, int lane, float& kmA, float& kmB) {
    unsigned char* ws = a.ws; const int b = cr >> 10, j = cr & 1023, kr = SEQ + b * SKEYS + j; const size_t src = (size_t)l * DB * PAST + cr;
    float x0[8], x1[8], x2[8], x3[8], x4[8];
    ld8f(a.in[I_CFK] + src * 512 + lane * 8, x0); ld8f(a.in[I_CFV] + src * 512 + lane * 8, x1); ld8f(a.in[I_CSK] + src * 512 + lane * 8, x2); ld8f(a.in[I_CSV] + src * 512 + lane * 8, x3);
    if (lane < 32) ld8f(a.in[I_CCKV] + src * 256 + lane * 8, x4); else if (lane < 40) ld8f(a.in[I_CKR] + src * 64 + (lane - 32) * 8, x4); else if (lane == 40) { const f32x4 t_ = *(const f32x4*)(a.in[I_CFL] + src * 4); x4[0] = t_[0]; x4[1] = t_[1]; x4[2] = t_[2]; x4[3] = t_[3]; }
    __builtin_amdgcn_sched_barrier(0);
    *(v4u*)((bf16*)(ws + WS_KA) + (size_t)kr * 512 + lane * 8) = pack8(x0); kmA = fmaxf(kmA, wsum16(sumsq8(x0)));
    *(v4u*)((bf16*)(ws + WS_VA) + (size_t)kr * 512 + lane * 8) = pack8(x1);
    *(v4u*)((bf16*)(ws + WS_KB) + (size_t)kr * 512 + lane * 8) = pack8(x2); kmB = fmaxf(kmB, wsum16(sumsq8(x2)));
    *(v4u*)((bf16*)(ws + WS_VB) + (size_t)kr * 512 + lane * 8) = pack8(x3);
    if (lane < 32) *(v4u*)((bf16*)(ws + WS_CKVN) + (size_t)kr * LDCKV + lane * 8) = pack8(x4);
    else if (lane < 40) st8f((float*)(ws + WS_KROPE) + (size_t)kr * 64 + (lane - 32) * 8, x4);
    else if (lane == 40) *(f32x4*)((float*)(ws + WS_LOGF) + (size_t)kr * 4) = (f32x4){x4[0], x4[1], x4[2], x4[3]};
    { float k2 = (lane >= 32 && lane < 40) ? sumsq8(x4) : 0.f; k2 += __shfl_xor(k2, 1); k2 += __shfl_xor(k2, 2); k2 += __shfl_xor(k2, 4); if (lane == 32) ((float*)(ws + WS_KRSS))[kr] = k2; }
}
__device__ __forceinline__ void scan_job(unsigned char* ws, LAS float* sm, int job, int tid, int wave, int lane) {
    const int h = job & 3, sq = job >> 2; const int krow0 = sq == 0 ? 0 : SEQ + (sq - 1) * SKEYS, n = sq == 0 ? SEQ : SKEYS, per = sq == 0 ? 32 : 3;
    const float* LOGF = (const float*)(ws + WS_LOGF) + (size_t)krow0 * 4 + h; float* FB = (float*)(ws + WS_FBIAS) + (size_t)h * NKRP + krow0;
    const int i0 = tid * per; float loc = 0.f, v_[32];
#pragma unroll
    for (int i = 0; i < 32; ++i) { v_[i] = (i < per && i0 + i < n) ? LOGF[(size_t)(i0 + i) * 4] : 0.f; loc += v_[i]; }
    float inc = loc;
#pragma unroll
    for (int o = 1; o < 64; o <<= 1) { const float t = __shfl_up(inc, o); if (lane >= o) inc += t; }
    if (lane == 63) sm[wave] = inc;
    __syncthreads();
    float run = inc - loc;
    for (int w = 0; w < wave; ++w) run += sm[w];
#pragma unroll
    for (int i = 0; i < 32; ++i) if (i < per && i0 + i < n) { run += v_[i]; FB[i0 + i] = -LOG2E * run; }
    __syncthreads();
}
template <int SRC> __device__ __forceinline__ void pd_row(const KArgs& a, int l, int r, int lane) {
    unsigned char* ws = a.ws; const int li = lane & 31, hh = lane >> 5;
    const int pos = SRC == 0 ? (r < SEQ ? r : PAST + ((r - SEQ) & 31)) : (r < SEQ ? r : (r - SEQ) % SKEYS);
    const f32x2* rope = (const f32x2*)(ws + WS_ROPE) + (size_t)pos * 32; const float* gn = a.in[SRC == 0 ? I_QN : I_KN] + l * QKD;
    const float qs = SRC == 0 ? QS_C : 1.0f;
    float x1[2][8], x2[2][8], g[8], g2[8]; f32x2 cs[8];
#pragma unroll
    for (int it = 0; it < 2; ++it) { const int head = it * 2 + hh;
        if (SRC == 0) { const bf16* src = (const bf16*)(ws + WS_QCR) + (size_t)r * NQC + head * QKD;
            if (li < 16) unpack8(*(const v4u*)(src + li * 8), x1[it]);
            else if (li < 20) { unpack8(*(const v4u*)(src + 128 + (li - 16) * 8), x1[it]); unpack8(*(const v4u*)(src + 160 + (li - 16) * 8), x2[it]); } }
        else { const bf16* src = (const bf16*)(ws + WS_KVR) + (size_t)r * NKV + head * 256; const float* kro = (const float*)(ws + WS_KROPE) + (size_t)r * 64;
            if (li < 16) unpack8(*(const v4u*)(src + li * 8), x1[it]);
            else if (li < 20) { ld8f(kro + (li - 16) * 8, x1[it]); ld8f(kro + 32 + (li - 16) * 8, x2[it]); } } }
    if (li < 16) ld8f(gn + li * 8, g);
    else if (li < 20) { ld8f(gn + 128 + (li - 16) * 8, g); ld8f(gn + 160 + (li - 16) * 8, g2);
#pragma unroll
        for (int i = 0; i < 8; ++i) cs[i] = rope[(li - 16) * 8 + i]; }
    __builtin_amdgcn_sched_barrier(0);
#pragma unroll
    for (int it = 0; it < 2; ++it) { const int head = it * 2 + hh;
        bf16* dst = (bf16*)(ws + (SRC == 0 ? WS_QC : WS_KC)) + (size_t)r * NQC + head * QKD;
        float ss = 0.f, y[8], y2[8];
        if (li < 16) ss = sumsq8(x1[it]); else if (li < 20) ss = sumsq8(x1[it]) + sumsq8(x2[it]);
        const float rs = 1.0f / sqrtf(wsum32(ss) * (1.f / 192.f) + EPS);
        if (li < 16) {
#pragma unroll
            for (int i = 0; i < 8; ++i) y[i] = x1[it][i] * rs * g[i] * qs;
            *(v4u*)(dst + li * 8) = pack8(y); }
        else if (li < 20) { const int m = li - 16;
#pragma unroll
            for (int i = 0; i < 8; ++i) { const float u1 = x1[it][i] * rs * g[i], u2 = x2[it][i] * rs * g2[i];
                y[i] = (u1 * cs[i].x - u2 * cs[i].y) * qs; y2[i] = (u2 * cs[i].x + u1 * cs[i].y) * qs; }
            *(v4u*)(dst + 128 + m * 8) = pack8(y); *(v4u*)(dst + 160 + m * 8) = pack8(y2); }
    }
}
struct PfRow { v4u w0, w1, w2, wp0, wp1, wp2, wp3; f32x2 ml0, ml1, ml2, ml3; };
__device__ __forceinline__ void pf_load(const KArgs& a, int r, int lane, PfRow& R) {
    unsigned char* ws = a.ws; const bf16* src = (const bf16*)(ws + WS_ATT) + (size_t)r * MIXW + lane * 8;
    const bool merged = r < SEQ && r >= MLA_G * 256;
    const int np = merged ? (MLA_G == 32 ? 2 : (r >> 12) + 1) : 0, head = lane >> 4;
    R.w0 = *(const v4u*)(src); R.w1 = *(const v4u*)(src + 512); R.w2 = (v4u){0u, 0u, 0u, 0u};
    if (!merged) R.w2 = *(const v4u*)(src + 1024);
#define PF_LD(p, WP, ML) if (p < np) { ML = *(const f32x2*)((const float*)(ws + WS_PML) + (((size_t)p * SEQ + r) * 4 + head) * 2); WP = *(const v4u*)((const bf16*)(ws + WS_PO) + ((size_t)p * SEQ + r) * 512 + lane * 8); }
    PF_LD(0, R.wp0, R.ml0) PF_LD(1, R.wp1, R.ml1) PF_LD(2, R.wp2, R.ml2) PF_LD(3, R.wp3, R.ml3)
#undef PF_LD
}
__device__ __forceinline__ void pf_compute(const KArgs& a, int r, int lane, const PfRow& R, const float (&g0)[8], const float (&g1)[8], const float (&g2)[8]) {
    bf16* dst = (bf16*)(a.ws + WS_MIX) + (size_t)r * LDMIX + lane * 8;
    const bool merged = r < SEQ && r >= MLA_G * 256; const int np = merged ? (MLA_G == 32 ? 2 : (r >> 12) + 1) : 0;
    float x[8], y[8];
    { unpack8(R.w0, x); const float rs = 1.0f / sqrtf(wsum64(sumsq8(x)) * (1.f / 512.f) + EPS);
#pragma unroll
      for (int i = 0; i < 8; ++i) y[i] = x[i] * rs * g0[i];
      *(v4u*)(dst) = pack8(y); }
    { unpack8(R.w1, x); const float rs = 1.0f / sqrtf(wsum64(sumsq8(x)) * (1.f / 512.f) + EPS);
#pragma unroll
      for (int i = 0; i < 8; ++i) y[i] = x[i] * rs * g1[i];
      *(v4u*)(dst + 512) = pack8(y); }
    { if (merged) { float mx = -3.0e38f, den = 0.f;
          if (0 < np) mx = fmaxf(mx, R.ml0.x); if (1 < np) mx = fmaxf(mx, R.ml1.x); if (2 < np) mx = fmaxf(mx, R.ml2.x); if (3 < np) mx = fmaxf(mx, R.ml3.x);
#pragma unroll
          for (int i = 0; i < 8; ++i) x[i] = 0.f;
#define PF_ACC(p, WP, ML) if (p < np) { const float w = __builtin_amdgcn_exp2f(ML.x - mx) * ML.y; den += w; float xp[8]; unpack8(WP, xp); _Pragma("unroll") for (int i = 0; i < 8; ++i) x[i] += w * xp[i]; }
          PF_ACC(0, R.wp0, R.ml0) PF_ACC(1, R.wp1, R.ml1) PF_ACC(2, R.wp2, R.ml2) PF_ACC(3, R.wp3, R.ml3)
#undef PF_ACC
          const float rd = 1.0f / den;
#pragma unroll
          for (int i = 0; i < 8; ++i) x[i] *= rd; }
      else unpack8(R.w2, x);
      const float rs = 1.0f / sqrtf(wsum64(sumsq8(x)) * (1.f / 512.f) + EPS);
#pragma unroll
      for (int i = 0; i < 8; ++i) y[i] = x[i] * rs * g2[i];
      *(v4u*)(dst + 1024) = pack8(y); }
}
__device__ __forceinline__ void pf_rows(const KArgs& a, int l, int gw, int NGW, int lane) {
    float g0[8], g1[8], g2[8];
    ld8f(a.in[I_ONA] + l * 512 + lane * 8, g0); ld8f(a.in[I_ONB] + l * 512 + lane * 8, g1); ld8f(a.in[I_ONC] + l * 512 + lane * 8, g2);
    for (int r = gw; r < M; r += 2 * NGW) {
        PfRow A, B; const int r2 = r + NGW; const bool two = r2 < M;
        pf_load(a, r, lane, A); if (two) pf_load(a, r2, lane, B);
        __builtin_amdgcn_sched_barrier(0);
        pf_compute(a, r, lane, A, g0, g1, g2); if (two) pf_compute(a, r2, lane, B, g0, g1, g2);
    }
}

namespace att {
typedef float f32x16 __attribute__((ext_vector_type(16)));
typedef short s16x4 __attribute__((ext_vector_type(4)));
constexpr int OFF_K = 0, OFF_V = 24576, OFF_B = 40960, BUF = 41216, WSC = 3 * BUF;
constexpr int FLG = WSC + NWAVES * 256, ATT_LDS = FLG + 64;
static_assert(ATT_LDS <= RING_BYTES, "attention LDS");
__device__ __forceinline__ int v_st(int k, int c) { const int kk = (k & ~0xC) | ((k & 4) << 1) | ((k & 8) >> 1); return ((kk >> 3) * 4 + (c >> 5)) * 512 + ((kk & 7) * 32 + (c & 31)) * 2; }
__device__ __forceinline__ int v_rd_base(int lane) { return ((lane & 3) << 3) | (((lane >> 2) & 3) << 6) | (((lane >> 4) & 1) << 5) | (((lane >> 5) & 1) << 8); }
constexpr int v_rd_off(int d0, int ks, int half) { return d0 * 512 + ks * 4096 + half * 2048; }
__device__ __forceinline__ int crow(int r, int hi) { return (r & 3) + 8 * (r >> 2) + 4 * hi; }
__device__ __forceinline__ bf16x8 mk8(s16x4 l, s16x4 h) { return (bf16x8){l[0], l[1], l[2], l[3], h[0], h[1], h[2], h[3]}; }
__device__ __forceinline__ void pv_tile(f32x16* o, unsigned vb, bf16x8 pa0, bf16x8 pa1, bf16x8 pa2, bf16x8 pa3) {
#define TRRD(dst, off) asm volatile("ds_read_b64_tr_b16 %0, %1 offset:%2" : "=&v"(dst) : "v"(vb), "i"(off) : "memory")
#define PV_D0(d0) do { s16x4 l0, l1, l2, l3, h0, h1, h2, h3; constexpr int b_ = v_rd_off(d0, 0, 0); \
        TRRD(l0, b_); TRRD(h0, b_ + 2048); TRRD(l1, b_ + 4096); TRRD(h1, b_ + 6144); TRRD(l2, b_ + 8192); TRRD(h2, b_ + 10240); TRRD(l3, b_ + 12288); TRRD(h3, b_ + 14336); \
        asm volatile("s_waitcnt lgkmcnt(0)" ::: "memory"); __builtin_amdgcn_sched_barrier(0); \
        o[d0] = __builtin_amdgcn_mfma_f32_32x32x16_bf16(pa0, mk8(l0, h0), o[d0], 0, 0, 0); \
        o[d0] = __builtin_amdgcn_mfma_f32_32x32x16_bf16(pa1, mk8(l1, h1), o[d0], 0, 0, 0); \
        o[d0] = __builtin_amdgcn_mfma_f32_32x32x16_bf16(pa2, mk8(l2, h2), o[d0], 0, 0, 0); \
        o[d0] = __builtin_amdgcn_mfma_f32_32x32x16_bf16(pa3, mk8(l3, h3), o[d0], 0, 0, 0); } while (0)
    __builtin_amdgcn_s_setprio(1); PV_D0(0); PV_D0(1); PV_D0(2); PV_D0(3); __builtin_amdgcn_s_setprio(0);
#undef PV_D0
#undef TRRD
}
__device__ __forceinline__ void glds16(const void* gsrc, unsigned lds_dst) { unsigned keep;
    asm volatile("s_mov_b32 %0, m0\n\ts_mov_b32 m0, %2\n\ts_nop 0\n\tglobal_load_lds_dwordx4 %1, off\n\ts_mov_b32 m0, %0" : "=&s"(keep) : "v"(gsrc), "s"(lds_dst) : "memory"); }
__device__ __forceinline__ void glds4(const void* gsrc, unsigned lds_dst) { unsigned keep;
    asm volatile("s_mov_b32 %0, m0\n\ts_mov_b32 m0, %2\n\ts_nop 0\n\tglobal_load_lds_dword %1, off\n\ts_mov_b32 m0, %0" : "=&s"(keep) : "v"(gsrc), "s"(lds_dst) : "memory"); }
typedef short v4i16_t __attribute__((ext_vector_type(4)));
__device__ __forceinline__ s16x4 vtr(const LAS unsigned char* p) { return __builtin_bit_cast(s16x4, __builtin_amdgcn_ds_read_tr16_b64_v4i16((LAS v4i16_t*)p)); }
__device__ __forceinline__ void pack_p(const f32x16& p0, const f32x16& p1, bf16x8& pa0, bf16x8& pa1, bf16x8& pa2, bf16x8& pa3) {
#define PK4(P, B_, OUT) do { unsigned a0 = pkbf(P[B_ + 0], P[B_ + 1]), a1 = pkbf(P[B_ + 2], P[B_ + 3]), b0 = pkbf(P[B_ + 4], P[B_ + 5]), b1 = pkbf(P[B_ + 6], P[B_ + 7]); \
        auto r0 = __builtin_amdgcn_permlane32_swap(a0, b0, false, false); auto r1 = __builtin_amdgcn_permlane32_swap(a1, b1, false, false); \
        v4u w = {r0[0], r1[0], r0[1], r1[1]}; OUT = __builtin_bit_cast(bf16x8, w); } while (0)
    PK4(p0, 0, pa0); PK4(p0, 8, pa1); PK4(p1, 0, pa2); PK4(p1, 8, pa3);
#undef PK4
}
struct UnitDesc { int h, qrow0, nq, krow0, qpos0, nkeys, t_lo, t_hi, part; };
template <int TYPE  >
__device__ __forceinline__ void attn_unit(LAS unsigned char* L, unsigned char* ws, const UnitDesc U, const float kmax, const int wid, const float* gq = nullptr) {
    constexpr int DK = TYPE == 2 ? QKD : HD, ND = DK / 16, NKC = DK / 64, CPR = DK / 8, KROWB = DK * 2;
    constexpr int QP = TYPE == 2 ? NQC : 512, KP = QP, VP = TYPE == 2 ? NKV : 512;
    const int lane = fresh_lane(), tid = wid * 64 + lane, r32 = lane & 31, hi = lane >> 5;
    const bf16* Qg = (const bf16*)(ws + (TYPE == 0 ? WS_QA : TYPE == 1 ? WS_QB : (FOLD_QC ? WS_QCR : WS_QC))) + (size_t)U.qrow0 * QP + U.h * DK;
    const bf16* Kg = (const bf16*)(ws + (TYPE == 0 ? WS_KA : TYPE == 1 ? WS_KB : WS_KC)) + (size_t)U.krow0 * KP + U.h * DK;
    const bf16* Vg = (const bf16*)(ws + (TYPE == 0 ? WS_VA : TYPE == 1 ? WS_VB : WS_KVR)) + (size_t)U.krow0 * VP + (TYPE == 2 ? U.h * 256 + 128 : U.h * HD);
    const float* FBh = (const float*)(ws + WS_FBIAS) + (size_t)U.h * NKRP + U.krow0;
    const bool wact = wid * 32 < U.nq;
    const int qlo = U.qpos0 + wid * 32, qpos = qlo + r32;
    const int NT = U.t_hi - U.t_lo;
    int kgoff[NKC], vgoff[2];
#pragma unroll
    for (int j = 0; j < NKC; ++j) { const int p = 64 * (wid + 8 * j) + lane, row = p / CPR, cpos = p % CPR, cc = CPR == 16 ? (cpos ^ (row & 15)) : ((cpos & ~7) | ((cpos ^ (row >> 1)) & 7)); kgoff[j] = row * KP + cc * 8; }
#pragma unroll
    for (int j = 0; j < 2; ++j) { const int p = 64 * (wid + 8 * j) + lane, st = p >> 5, q = p & 31, kk = ((st >> 2) << 3) | (q >> 2), c = (st & 3) * 32 + (q & 3) * 8;
        const int k = (kk & ~0xC) | ((kk & 4) << 1) | ((kk & 8) >> 1); vgoff[j] = k * VP + c; }
#define ST_DMA(t, bf) do { const int kb_ = (t) * 64; const unsigned B_ = (unsigned)__builtin_amdgcn_readfirstlane((int)(unsigned)(size_t)(L + (bf) * BUF)); \
        _Pragma("unroll") for (int j = 0; j < NKC; ++j) glds16(Kg + (size_t)kb_ * KP + kgoff[j], B_ + OFF_K + (wid + 8 * j) * 1024); \
        _Pragma("unroll") for (int j = 0; j < 2; ++j) glds16(Vg + (size_t)kb_ * VP + vgoff[j], B_ + OFF_V + (wid + 8 * j) * 1024); \
        if (TYPE == 0 && wid == 0) glds4(FBh + kb_ + lane, B_ + OFF_B); } while (0)
    constexpr int DIST = ATT_LAG ? 1 : 2;
    ST_DMA(U.t_hi - 1, 0); if (DIST == 2 && NT > 1) ST_DMA(U.t_hi - 2, 1);
    bf16x8 qr[ND];
    if (wact) {
#pragma unroll
        for (int d0 = 0; d0 < ND; ++d0) qr[d0] = *(const bf16x8*)(Qg + (size_t)(wid * 32 + r32) * QP + d0 * 16 + hi * 8);
        if constexpr (TYPE == 2 && FOLD_QC) {
            float ss = 0.f;
#pragma unroll
            for (int d0 = 0; d0 < ND; ++d0)
#pragma unroll
                for (int e = 0; e < 8; ++e) { const float f_ = __uint_as_float((unsigned)(unsigned short)qr[d0][e] << 16); ss += f_ * f_; }
            { auto rr = __builtin_amdgcn_permlane32_swap(__float_as_uint(ss), __float_as_uint(ss), false, false); ss = __uint_as_float(rr[0]) + __uint_as_float(rr[1]); }
            float rc = 1.f;
            if (FUSE_B) { const float* cs_ = (const float*)(ws + WS_CQSS) + (size_t)(U.qrow0 + wid * 32 + r32) * 16; float t_ = 0.f;
#pragma unroll
                for (int i = 0; i < 4; ++i) { const f32x4 v_ = *(const f32x4*)(cs_ + 4 * i); t_ += (v_[0] + v_[1]) + (v_[2] + v_[3]); }
                rc = 1.0f / sqrtf(t_ * (1.f / 512.f) + EPS); }
            const float rs = rc / sqrtf(ss * rc * rc * (1.f / 192.f) + EPS) * QS_C;
            const f32x2* rope = (const f32x2*)(ws + WS_ROPE) + (size_t)(U.qpos0 + wid * 32 + r32) * 32;
#pragma unroll
            for (int d0 = 0; d0 < 8; ++d0) { float g[8], y[8]; ld8f(gq + d0 * 16 + hi * 8, g);
#pragma unroll
                for (int e = 0; e < 8; ++e) y[e] = __uint_as_float((unsigned)(unsigned short)qr[d0][e] << 16) * rs * g[e];
                const v4u w_ = pack8(y); qr[d0] = __builtin_bit_cast(bf16x8, w_); }
#pragma unroll
            for (int d0 = 8; d0 < 10; ++d0) { float g1[8], g2[8], y1[8], y2[8]; ld8f(gq + d0 * 16 + hi * 8, g1); ld8f(gq + (d0 + 2) * 16 + hi * 8, g2);
#pragma unroll
                for (int e = 0; e < 8; ++e) { const f32x2 cs = rope[(d0 - 8) * 16 + hi * 8 + e];
                    const float u1 = __uint_as_float((unsigned)(unsigned short)qr[d0][e] << 16) * rs * g1[e], u2 = __uint_as_float((unsigned)(unsigned short)qr[d0 + 2][e] << 16) * rs * g2[e];
                    y1[e] = u1 * cs.x - u2 * cs.y; y2[e] = u2 * cs.x + u1 * cs.y; }
                const v4u w1_ = pack8(y1), w2_ = pack8(y2); qr[d0] = __builtin_bit_cast(bf16x8, w1_); qr[d0 + 2] = __builtin_bit_cast(bf16x8, w2_); }
        }
    } else {
#pragma unroll
        for (int d0 = 0; d0 < ND; ++d0) qr[d0] = (bf16x8){0, 0, 0, 0, 0, 0, 0, 0};
    }
    LAS float* wsc = (LAS float*)(L + WSC + wid * 256);
    constexpr bool NEGM = ATT_NEGM && TYPE != 1;
    float m_reg = NEGM ? 0.f : -1e30f, l_reg = 0.f, Rsum = 0.f; f32x16 o[4];
    f32x16 negm = (f32x16){}; bool fresh = true;
    constexpr float EXIT_FOX = -60.f, EXIT_SB = -42.f;
    float zb = 0.f; bool wdone = !wact; LAS int* flg = (LAS int*)(L + FLG);
    if (TYPE != 2 && wact) { float q2 = 0.f;
#pragma unroll
        for (int d0 = 0; d0 < ND; ++d0)
#pragma unroll
            for (int e = 0; e < 8; ++e) { const float f_ = __uint_as_float((unsigned)(unsigned short)qr[d0][e] << 16); q2 += f_ * f_; }
        { auto rr = __builtin_amdgcn_permlane32_swap(__float_as_uint(q2), __float_as_uint(q2), false, false); q2 = __uint_as_float(rr[0]) + __uint_as_float(rr[1]); }
        zb = sqrtf(q2) * kmax * 1.02f + 0.1f; }
#pragma unroll
    for (int d = 0; d < 4; ++d) o[d] = (f32x16){};
    int kbase[4];
#pragma unroll
    for (int dd = 0; dd < 4; ++dd) kbase[dd] = r32 * KROWB + (((dd * 2 + hi) ^ (CPR == 16 ? (r32 & 15) : ((r32 >> 1) & 7))) << 4);
    const unsigned vrd = (unsigned)(size_t)(L + OFF_V) + (unsigned)v_rd_base(lane);
    VM_WAIT(); __syncthreads();
    int bf = 0, bf2 = DIST;
    const bool lagw = ATT_LAG == 1 ? wid >= 4 : ATT_LAG == 2 ? (wid & 1) != 0 : false;
    bool have_prev = false; int bfp = 0; bf16x8 pa0, pa1, pa2, pa3;
    pa0 = pa1 = pa2 = pa3 = (bf16x8){0, 0, 0, 0, 0, 0, 0, 0};
    for (int i = 0; i < NT; ++i) {
        const int t = U.t_hi - 1 - i, kb = t * 64;
        if (TYPE != 2 && i > 0) { const LAS int* f_ = flg + ((i - 1) & 1) * 8; if ((f_[0] & f_[1] & f_[2] & f_[3] & f_[4] & f_[5] & f_[6] & f_[7]) != 0) break; }
        if (i + DIST < NT) ST_DMA(t - DIST, bf2);
        float bnext = 0.f; if (TYPE == 0) bnext = *(const LAS float*)(L + bf * BUF + OFF_B);
        bool act, needmask;
        if (TYPE == 0) { act = kb <= qlo + 31; needmask = kb + 63 > qlo; }
        else if (TYPE == 1) { act = kb < qlo + 31; needmask = kb + 63 >= qlo; }
        else { act = t <= (qlo >> 6); needmask = kb + 64 > U.nkeys; }
        act = act && !wdone;
        if (ATT_LAG && have_prev) { pv_tile(o, vrd + (unsigned)(bfp * BUF), pa0, pa1, pa2, pa3); have_prev = false; }
        if (ATT_PIPE && act && TYPE != 1 && !needmask) {
            LAS unsigned char* Bf = L + bf * BUF;
            f32x16 p0 = (f32x16){}, p1 = (f32x16){};
            bf16x8 kf[4]; float al0 = 1.f, al1 = 1.f, pmx = 0.f, mn_ = 0.f, ps_ = 0.f;
#define KFR(d0_, half_) (*(const LAS bf16x8*)(Bf + OFF_K + (CPR == 16 ? (kbase[(d0_) & 3] ^ (((d0_) >> 2) * 128)) : (kbase[(d0_) & 3] + ((d0_) >> 2) * 128)) + (half_) * 32 * KROWB))
#define SB0() __builtin_amdgcn_sched_barrier(0)
#define QK_MF(P, half_, j_) do { P = __builtin_amdgcn_mfma_f32_32x32x16_bf16(kf[(j_) & 3], qr[j_], P, 0, 0, 0); if ((j_) + 4 < ND) kf[(j_) & 3] = KFR((j_) + 4, half_); } while (0)
#define SMSTEP(k_, P, KOFF, AL, PA, PB) do { \
            if ((k_) == 0) { if (TYPE == 0) { _Pragma("unroll") for (int g = 0; g < 4; ++g) { const f32x4 b_ = *(const LAS f32x4*)(Bf + OFF_B + ((KOFF) + 8 * g + 4 * hi) * 4); \
                                 _Pragma("unroll") for (int e = 0; e < 4; ++e) P[4 * g + e] += b_[e]; } } } \
            else if ((k_) == 1) { pmx = fmaxf(fmaxf(fmaxf(P[0], P[1]), fmaxf(P[2], P[3])), fmaxf(fmaxf(P[4], P[5]), fmaxf(P[6], P[7]))); } \
            else if ((k_) == 2) { pmx = fmaxf(pmx, fmaxf(fmaxf(fmaxf(P[8], P[9]), fmaxf(P[10], P[11])), fmaxf(fmaxf(P[12], P[13]), fmaxf(P[14], P[15])))); \
                auto rr_ = __builtin_amdgcn_permlane32_swap(__float_as_uint(pmx), __float_as_uint(pmx), false, false); pmx = fmaxf(__uint_as_float(rr_[0]), __uint_as_float(rr_[1])); \
                mn_ = fmaxf(m_reg, pmx); AL = __builtin_amdgcn_exp2f(m_reg - mn_); m_reg = mn_; } \
            else if ((k_) == 3) { _Pragma("unroll") for (int r = 0; r < 6; ++r) P[r] = __builtin_amdgcn_exp2f(P[r] - mn_); } \
            else if ((k_) == 4) { _Pragma("unroll") for (int r = 6; r < 11; ++r) P[r] = __builtin_amdgcn_exp2f(P[r] - mn_); } \
            else if ((k_) == 5) { _Pragma("unroll") for (int r = 11; r < 16; ++r) P[r] = __builtin_amdgcn_exp2f(P[r] - mn_); } \
            else if ((k_) == 6) { ps_ = ((P[0] + P[1]) + (P[2] + P[3])) + ((P[4] + P[5]) + (P[6] + P[7])) + (((P[8] + P[9]) + (P[10] + P[11])) + ((P[12] + P[13]) + (P[14] + P[15]))); \
                auto rr_ = __builtin_amdgcn_permlane32_swap(__float_as_uint(ps_), __float_as_uint(ps_), false, false); ps_ = __uint_as_float(rr_[0]) + __uint_as_float(rr_[1]); l_reg = l_reg * AL + ps_; } \
            else if ((k_) == 7) { \
                { unsigned a0_ = pkbf(P[0], P[1]), a1_ = pkbf(P[2], P[3]), b0_ = pkbf(P[4], P[5]), b1_ = pkbf(P[6], P[7]); auto r0_ = __builtin_amdgcn_permlane32_swap(a0_, b0_, false, false); auto r1_ = __builtin_amdgcn_permlane32_swap(a1_, b1_, false, false); \
                  v4u w_ = {r0_[0], r1_[0], r0_[1], r1_[1]}; PA = __builtin_bit_cast(bf16x8, w_); } \
                { unsigned a0_ = pkbf(P[8], P[9]), a1_ = pkbf(P[10], P[11]), b0_ = pkbf(P[12], P[13]), b1_ = pkbf(P[14], P[15]); auto r0_ = __builtin_amdgcn_permlane32_swap(a0_, b0_, false, false); auto r1_ = __builtin_amdgcn_permlane32_swap(a1_, b1_, false, false); \
                  v4u w_ = {r0_[0], r1_[0], r0_[1], r1_[1]}; PB = __builtin_bit_cast(bf16x8, w_); } } } while (0)
#define RESC_O(AL) do { if (__any((AL) < 1.f)) { if (hi == 0) wsc[r32] = (AL); LDS_WAIT(); \
                _Pragma("unroll") for (int g = 0; g < 4; ++g) { const f32x4 al_ = *(const LAS f32x4*)(wsc + 8 * g + 4 * hi); \
                    _Pragma("unroll") for (int d = 0; d < 4; ++d) _Pragma("unroll") for (int e = 0; e < 4; ++e) o[d][4 * g + e] *= al_[e]; } } } while (0)
            kf[0] = KFR(0, 0); kf[1] = KFR(1, 0); kf[2] = KFR(2, 0); kf[3] = KFR(3, 0); SB0();
#pragma unroll
            for (int j = 0; j < ND; ++j) { QK_MF(p0, 0, j); SB0(); }
            kf[0] = KFR(0, 1); kf[1] = KFR(1, 1); kf[2] = KFR(2, 1); kf[3] = KFR(3, 1); SB0();
#pragma unroll
            for (int j = 0; j < ND; ++j) { QK_MF(p1, 1, j);
#pragma unroll
                for (int k = 0; k < 8; ++k) if ((k * ND) / 8 == j) SMSTEP(k, p0, 0, al0, pa0, pa1);
                SB0(); }
            RESC_O(al0);
            const LAS unsigned char* vb_ = L + OFF_V + bf * BUF + v_rd_base(lane);
            s16x4 vl[2][4];
#define VRD_(set_, d0_, h_) do { vl[set_][0] = vtr(vb_ + v_rd_off(d0_, 2 * (h_), 0)); vl[set_][1] = vtr(vb_ + v_rd_off(d0_, 2 * (h_), 1)); \
                                 vl[set_][2] = vtr(vb_ + v_rd_off(d0_, 2 * (h_) + 1, 0)); vl[set_][3] = vtr(vb_ + v_rd_off(d0_, 2 * (h_) + 1, 1)); } while (0)
            VRD_(0, 0, 0); SB0();
#pragma unroll
            for (int d0 = 0; d0 < 4; ++d0) { if (d0 + 1 < 4) VRD_((d0 + 1) & 1, d0 + 1, 0); SB0();
                o[d0] = __builtin_amdgcn_mfma_f32_32x32x16_bf16(pa0, mk8(vl[d0 & 1][0], vl[d0 & 1][1]), o[d0], 0, 0, 0); SMSTEP(2 * d0, p1, 32, al1, pa2, pa3); SB0();
                o[d0] = __builtin_amdgcn_mfma_f32_32x32x16_bf16(pa1, mk8(vl[d0 & 1][2], vl[d0 & 1][3]), o[d0], 0, 0, 0); SMSTEP(2 * d0 + 1, p1, 32, al1, pa2, pa3); SB0(); }
            RESC_O(al1);
            VRD_(0, 0, 1); SB0();
#pragma unroll
            for (int d0 = 0; d0 < 4; ++d0) { if (d0 + 1 < 4) VRD_((d0 + 1) & 1, d0 + 1, 1); SB0();
                o[d0] = __builtin_amdgcn_mfma_f32_32x32x16_bf16(pa2, mk8(vl[d0 & 1][0], vl[d0 & 1][1]), o[d0], 0, 0, 0);
                o[d0] = __builtin_amdgcn_mfma_f32_32x32x16_bf16(pa3, mk8(vl[d0 & 1][2], vl[d0 & 1][3]), o[d0], 0, 0, 0); SB0(); }
#undef KFR
#undef QK_MF
#undef SMSTEP
#undef RESC_O
#undef VRD_
#undef SB0
        } else if (act) {
            LAS unsigned char* Bf = L + bf * BUF;
            f32x16 p0 = (f32x16){}, p1 = (f32x16){};
            if (NEGM) { p0 = negm; p1 = negm; }
#define KFR(d0_, half_) (*(const LAS bf16x8*)(Bf + OFF_K + (CPR == 16 ? (kbase[(d0_) & 3] ^ (((d0_) >> 2) * 128)) : (kbase[(d0_) & 3] + ((d0_) >> 2) * 128)) + (half_) * 32 * KROWB))
            bf16x8 kA[4], kB[4];
            kA[0] = KFR(0, 0); kA[1] = KFR(0, 1); kA[2] = KFR(1, 0); kA[3] = KFR(1, 1);
            __builtin_amdgcn_s_setprio(1);
#pragma unroll
            for (int d0 = 0; d0 < ND; d0 += 4) {
                kB[0] = KFR(d0 + 2, 0); kB[1] = KFR(d0 + 2, 1); kB[2] = KFR(d0 + 3, 0); kB[3] = KFR(d0 + 3, 1);
                __builtin_amdgcn_sched_barrier(0);
                p0 = __builtin_amdgcn_mfma_f32_32x32x16_bf16(kA[0], qr[d0], p0, 0, 0, 0); p1 = __builtin_amdgcn_mfma_f32_32x32x16_bf16(kA[1], qr[d0], p1, 0, 0, 0);
                p0 = __builtin_amdgcn_mfma_f32_32x32x16_bf16(kA[2], qr[d0 + 1], p0, 0, 0, 0); p1 = __builtin_amdgcn_mfma_f32_32x32x16_bf16(kA[3], qr[d0 + 1], p1, 0, 0, 0);
                __builtin_amdgcn_sched_barrier(0);
                if (d0 + 4 < ND) { kA[0] = KFR(d0 + 4, 0); kA[1] = KFR(d0 + 4, 1); kA[2] = KFR(d0 + 5, 0); kA[3] = KFR(d0 + 5, 1); }
                __builtin_amdgcn_sched_barrier(0);
                p0 = __builtin_amdgcn_mfma_f32_32x32x16_bf16(kB[0], qr[d0 + 2], p0, 0, 0, 0); p1 = __builtin_amdgcn_mfma_f32_32x32x16_bf16(kB[1], qr[d0 + 2], p1, 0, 0, 0);
                p0 = __builtin_amdgcn_mfma_f32_32x32x16_bf16(kB[2], qr[d0 + 3], p0, 0, 0, 0); p1 = __builtin_amdgcn_mfma_f32_32x32x16_bf16(kB[3], qr[d0 + 3], p1, 0, 0, 0);
                __builtin_amdgcn_sched_barrier(0);
            }
            __builtin_amdgcn_s_setprio(0);
#undef KFR
            if (TYPE != 1) {
                if (TYPE == 0) {
#pragma unroll
                    for (int g = 0; g < 4; ++g) { const f32x4 b0 = *(const LAS f32x4*)(Bf + OFF_B + (8 * g + 4 * hi) * 4), b1 = *(const LAS f32x4*)(Bf + OFF_B + (32 + 8 * g + 4 * hi) * 4);
#pragma unroll
                        for (int e = 0; e < 4; ++e) { p0[4 * g + e] += b0[e]; p1[4 * g + e] += b1[e]; } }
                }
                if (needmask) { const float NEG = -__builtin_inff();
#pragma unroll
                    for (int r = 0; r < 16; ++r) { const int kv = kb + crow(r, hi);
                        if (TYPE == 0) { if (kv > qpos) p0[r] = NEG; if (kv + 32 > qpos) p1[r] = NEG; }
                        else { if (kv >= U.nkeys) p0[r] = NEG; if (kv + 32 >= U.nkeys) p1[r] = NEG; } } }
                float pmax = p0[0];
#pragma unroll
                for (int r = 1; r < 16; ++r) pmax = fmaxf(pmax, p0[r]);
#pragma unroll
                for (int r = 0; r < 16; ++r) pmax = fmaxf(pmax, p1[r]);
                { auto rr = __builtin_amdgcn_permlane32_swap(__float_as_uint(pmax), __float_as_uint(pmax), false, false); pmax = fmaxf(__uint_as_float(rr[0]), __uint_as_float(rr[1])); }
                float alpha = 1.f, ps = 0.f;
                if (NEGM) {
                    const bool upd = pmax > -__builtin_inff() && (fresh || pmax > 8.0f);
                    if (__any(upd)) { const float dl = upd ? pmax : 0.f; alpha = (upd && !fresh) ? __builtin_amdgcn_exp2f(-dl) : 1.f; m_reg += dl; fresh = fresh && !upd;
#pragma unroll
                        for (int r = 0; r < 16; ++r) { p0[r] -= dl; p1[r] -= dl; negm[r] = -m_reg; } }
#pragma unroll
                    for (int r = 0; r < 16; ++r) { p0[r] = __builtin_amdgcn_exp2f(p0[r]); p1[r] = __builtin_amdgcn_exp2f(p1[r]); ps += p0[r] + p1[r]; }
                } else {
                const float mn = pmax > m_reg + 8.0f ? pmax : m_reg; alpha = __builtin_amdgcn_exp2f(m_reg - mn); m_reg = mn;
#pragma unroll
                for (int r = 0; r < 16; ++r) { p0[r] = __builtin_amdgcn_exp2f(p0[r] - mn); p1[r] = __builtin_amdgcn_exp2f(p1[r] - mn); ps += p0[r] + p1[r]; }
                }
                { auto rr = __builtin_amdgcn_permlane32_swap(__float_as_uint(ps), __float_as_uint(ps), false, false); ps = __uint_as_float(rr[0]) + __uint_as_float(rr[1]); }
                l_reg = l_reg * alpha + ps;
                if (__any(alpha < 1.f)) { if (hi == 0) wsc[r32] = alpha; LDS_WAIT();
#pragma unroll
                    for (int g = 0; g < 4; ++g) { const f32x4 al = *(const LAS f32x4*)(wsc + 8 * g + 4 * hi);
#pragma unroll
                        for (int d = 0; d < 4; ++d)
#pragma unroll
                            for (int e = 0; e < 4; ++e) o[d][4 * g + e] *= al[e]; } }
            } else {
                f32x16 k0, k1;
#pragma unroll
                for (int r = 0; r < 16; ++r) { const int kv = kb + crow(r, hi); const bool v0 = !needmask || kv < qpos, v1 = !needmask || kv + 32 < qpos;
                    const float z0 = p0[r], z1 = p1[r];
                    const float s0 = fmaxf(z0, 0.f) + LN2 * __builtin_amdgcn_logf(1.0f + __builtin_amdgcn_exp2f(-LOG2E * fabsf(z0)));
                    const float s1 = fmaxf(z1, 0.f) + LN2 * __builtin_amdgcn_logf(1.0f + __builtin_amdgcn_exp2f(-LOG2E * fabsf(z1)));
                    k0[r] = v0 ? -s0 : 0.f; k1[r] = v1 ? -s1 : 0.f; }
                float G[8], T[8], X[8];
#pragma unroll
                for (int g = 0; g < 4; ++g) { G[g] = (k0[4 * g] + k0[4 * g + 1]) + (k0[4 * g + 2] + k0[4 * g + 3]); G[4 + g] = (k1[4 * g] + k1[4 * g + 1]) + (k1[4 * g + 2] + k1[4 * g + 3]); }
#pragma unroll
                for (int g = 0; g < 8; ++g) { auto rr = __builtin_amdgcn_permlane32_swap(__float_as_uint(G[g]), __float_as_uint(G[g]), false, false);
                    const float a_lo = __uint_as_float(rr[0]), a_hi = __uint_as_float(rr[1]);
                    T[g] = a_lo + a_hi; X[g] = hi == 0 ? a_hi : 0.f; }
                float later = Rsum;
#pragma unroll
                for (int g = 7; g >= 0; --g) { const float base = later + X[g];
                    if (g >= 4) { float s = base;
#pragma unroll
                        for (int e = 3; e >= 0; --e) { s += k1[4 * (g - 4) + e]; k1[4 * (g - 4) + e] = s; } }
                    else { float s = base;
#pragma unroll
                        for (int e = 3; e >= 0; --e) { s += k0[4 * g + e]; k0[4 * g + e] = s; } }
                    later += T[g]; }
                Rsum = later;
#pragma unroll
                for (int r = 0; r < 16; ++r) { const int kv = kb + crow(r, hi); const bool v0 = !needmask || kv < qpos, v1 = !needmask || kv + 32 < qpos;
                    const float a0 = __builtin_amdgcn_exp2f(LOG2E * (p0[r] + k0[r])), a1 = __builtin_amdgcn_exp2f(LOG2E * (p1[r] + k1[r]));
                    p0[r] = v0 ? a0 : 0.f; p1[r] = v1 ? a1 : 0.f; }
            }
            pack_p(p0, p1, pa0, pa1, pa2, pa3);
            if (ATT_LAG && lagw) { have_prev = true; bfp = bf; } else pv_tile(o, vrd + (unsigned)(bf * BUF), pa0, pa1, pa2, pa3);
        }
        if (TYPE != 2) { if (!wdone && kb > 0) wdone = TYPE == 1 ? __all(zb + Rsum < EXIT_SB) : __all(!(NEGM && fresh) && zb + bnext - m_reg < EXIT_FOX); if (lane == 0) flg[(i & 1) * 8 + wid] = wdone ? 1 : 0; }
        if (DIST == 2 && i + 2 < NT) { if (NKC == 2) asm volatile("s_waitcnt vmcnt(4)" ::: "memory"); else asm volatile("s_waitcnt vmcnt(5)" ::: "memory"); } else VM_WAIT();
        __syncthreads();
        bf = bf == 2 ? 0 : bf + 1; bf2 = bf2 == 2 ? 0 : bf2 + 1;
    }
    if (ATT_LAG && have_prev) pv_tile(o, vrd + (unsigned)(bfp * BUF), pa0, pa1, pa2, pa3);
    VM_WAIT(); __syncthreads();
#undef ST_DMA
    if (wact) {
        float rli[16];
        if (TYPE != 1) { if (hi == 0) wsc[r32] = l_reg; LDS_WAIT();
#pragma unroll
            for (int g = 0; g < 4; ++g) { const f32x4 lv = *(const LAS f32x4*)(wsc + 8 * g + 4 * hi);
#pragma unroll
                for (int e = 0; e < 4; ++e) rli[4 * g + e] = 1.0f / lv[e]; } }
        else {
#pragma unroll
            for (int r = 0; r < 16; ++r) rli[r] = 1.f; }
        const bool partial = TYPE == 2 && U.part >= 0;
        bf16* Ow = partial ? (bf16*)(ws + WS_PO) + ((size_t)U.part * SEQ + U.qrow0 + wid * 32) * 512 + U.h * HD
                           : (bf16*)(ws + WS_ATT) + (size_t)(U.qrow0 + wid * 32) * MIXW + TYPE * 512 + U.h * HD;
        const int opitch = partial ? 512 : MIXW;
        if (partial && hi == 0) *(f32x2*)((float*)(ws + WS_PML) + (((size_t)U.part * SEQ + U.qrow0 + wid * 32 + r32) * 4 + U.h) * 2) = (f32x2){m_reg, l_reg};
#pragma unroll
        for (int r = 0; r < 16; ++r) { const int orow = crow(r, hi);
#pragma unroll
            for (int d0 = 0; d0 < 4; ++d0) { const float v = o[d0][r] * rli[r]; const float vn = __shfl_xor(v, 1);
                if ((r32 & 1) == 0) *(unsigned*)(Ow + (size_t)orow * opitch + d0 * 32 + r32) = pkbf(v, vn); } }
    }
}
constexpr int NU_MLA_FULL = MLA_G == 32 ? 4 * 32 : 4 * 96, NU_MLA = NU_MLA_FULL + 4 * 64, NU_PROMPT = NU_MLA + 2 * 4 * (SEQ / 256), NU_SAMPLE = 3 * DB * 4, NU = NU_PROMPT + NU_SAMPLE;
}

__device__ __forceinline__ float rstd_sample(const float* rsss, int srow, int kq) {
    const float* p = rsss + (size_t)srow * 128 + kq * 32; float s = 0.f;
#pragma unroll
    for (int i = 0; i < 8; ++i) { const f32x4 v = *(const f32x4*)(p + 4 * i); s += (v[0] + v[1]) + (v[2] + v[3]); }
    s += __shfl_xor(s, 16); s += __shfl_xor(s, 32);
    return 1.0f / sqrtf(s * (1.f / DM) + EPS);
}
struct ThinArgs { const bf16* A; const bf16* Bt; int K, lda, ldb; int ncs; bf16* Ob; int ldo; const float* rsss_in; const float* xin; float* xout; bf16* xn; const float* gain; float* rsss_out; };
template <int MODE  , int NBF, int KC>
__device__ __forceinline__ void thin_gemm(const ThinArgs T, LAS unsigned char* L, int wave, int bx) {
    constexpr int KSN = KC / 32, PITCH = KC * 2 + 16, BUFB = NBF * 16 * PITCH, PPR = KC / 8, NPT = NBF * KC / 256;
    static_assert(3 * BUFB <= RING_BYTES, "thin LDS");
    const int lane = fresh_lane(), tid = wave * 64 + lane, m16 = lane & 15, kq = lane >> 4, K = T.K, nch = K / KC;
    for (int q = bx; q < T.ncs * 2; q += gridDim.x) {
        const int cs = q % T.ncs, rh = q / T.ncs, row0 = rh * 128 + wave * 16;
        const bf16* ap = T.A + (size_t)(row0 + m16) * T.lda + kq * 8;
        const bf16* bsrc[NPT]; int bdst[NPT];
#pragma unroll
        for (int i = 0; i < NPT; ++i) { const int p = tid + 512 * i, row = p / PPR, kc = p % PPR, b = row >> 4, m = row & 15; size_t brow;
            if (MODE == 1) { const int f = cs * (NBF / 2) * 16 + (b % (NBF / 2)) * 16 + m; brow = (size_t)(f >> 7) * 256 + (f & 127) + (b >= NBF / 2 ? 128 : 0); }
            else brow = (size_t)cs * NBF * 16 + row;
            bsrc[i] = T.Bt + brow * T.ldb + kc * 8; bdst[i] = row * PITCH + kc * 16; }
        f32x4 acc[NBF];
#pragma unroll
        for (int b = 0; b < NBF; ++b) acc[b] = (f32x4){0.f, 0.f, 0.f, 0.f};
        bf16x8 fa[3][KSN]; v4u stb[3][NPT];
#define T2_LOAD(S_, k0) do { _Pragma("unroll") for (int i = 0; i < NPT; ++i) stb[S_][i] = *(const v4u*)(bsrc[i] + (k0)); \
            _Pragma("unroll") for (int j = 0; j < KSN; ++j) fa[S_][j] = *(const bf16x8*)(ap + (k0) + 32 * j); } while (0)
#define T2_WRITE(S_) do { _Pragma("unroll") for (int i = 0; i < NPT; ++i) *(LAS v4u*)(L + (S_) * BUFB + bdst[i]) = stb[S_][i]; } while (0)
#define T2_MMA(S_) do { _Pragma("unroll") for (int j = 0; j < KSN; ++j) _Pragma("unroll") for (int b = 0; b < NBF; ++b) \
            acc[b] = __builtin_amdgcn_mfma_f32_16x16x32_bf16(*(const LAS bf16x8*)(L + (S_) * BUFB + (b * 16 + m16) * PITCH + j * 64 + kq * 16), fa[S_][j], acc[b], 0, 0, 0); } while (0)
#define T2_BAR() asm volatile("s_waitcnt lgkmcnt(0)\n\ts_barrier" ::: "memory")
#define T2_STEP(cc, SC, SN, SL) do { if ((cc) + 2 < nch) { T2_LOAD(SL, ((cc) + 2) * KC); } __builtin_amdgcn_sched_barrier(0); \
            T2_MMA(SC); __builtin_amdgcn_sched_barrier(0); \
            if ((cc) + 1 < nch) { T2_WRITE(SN); } T2_BAR(); } while (0)
        T2_LOAD(0, 0); if (nch > 1) { T2_LOAD(1, KC); } __builtin_amdgcn_sched_barrier(0);
        T2_WRITE(0); T2_BAR();
#pragma unroll 1
        for (int c = 0; c < nch; c += 3) {
            T2_STEP(c, 0, 1, 2);
            if (c + 1 < nch) T2_STEP(c + 1, 1, 2, 0);
            if (c + 2 < nch) T2_STEP(c + 2, 2, 0, 1);
        }
#undef T2_LOAD
#undef T2_WRITE
#undef T2_MMA
#undef T2_BAR
#undef T2_STEP
        const int srow = row0 + m16; const size_t grow = (size_t)SEQ + srow;
        if (MODE == 0) { const float rs = rstd_sample(T.rsss_in, srow, kq);
#pragma unroll
            for (int b = 0; b < NBF; ++b) { const int col = (cs * NBF + b) * 16 + 4 * kq; const f32x4 v = acc[b] * rs;
                f32x2 o; o.x = __uint_as_float(pkbf(v[0], v[1])); o.y = __uint_as_float(pkbf(v[2], v[3])); *(f32x2*)(T.Ob + grow * T.ldo + col) = o; } }
        else if (MODE == 1) { const float rs = rstd_sample(T.rsss_in, srow, kq);
#pragma unroll
            for (int b = 0; b < NBF / 2; ++b) { const int col = (cs * (NBF / 2) + b) * 16 + 4 * kq; const f32x4 g = acc[b] * rs, u = acc[b + NBF / 2] * rs;
                f32x2 o; o.x = __uint_as_float(pkbf(pg8::silu_mul(g[0], u[0]), pg8::silu_mul(g[1], u[1]))); o.y = __uint_as_float(pkbf(pg8::silu_mul(g[2], u[2]), pg8::silu_mul(g[3], u[3])));
                *(f32x2*)(T.Ob + grow * T.ldo + col) = o; } }
        else {
#pragma unroll
            for (int b = 0; b < NBF; ++b) { const int cg = cs * NBF + b, col = cg * 16 + 4 * kq;
                const f32x4 x1 = *(const f32x4*)(T.xin + (size_t)srow * DM + col) + acc[b]; *(f32x4*)(T.xout + (size_t)srow * DM + col) = x1;
                const f32x4 y = x1;
                f32x2 o; o.x = __uint_as_float(pkbf(y[0], y[1])); o.y = __uint_as_float(pkbf(y[2], y[3])); *(f32x2*)(T.xn + grow * LDX + col) = o;
                float ss = (x1[0] * x1[0] + x1[1] * x1[1]) + (x1[2] * x1[2] + x1[3] * x1[3]); ss += __shfl_xor(ss, 16); ss += __shfl_xor(ss, 32);
                if (kq == 0) T.rsss_out[(size_t)srow * 128 + cg] = ss; } }
    }
}

template <int KC>
__device__ __forceinline__ void thin_gemm_ks(const ThinArgs T, LAS unsigned char* L, int wave, int bx) {
    constexpr int NBF = 2, VB = 2 * NBF, KSN = KC / 32, PITCH = KC * 2 + 16, BUFB = VB * 16 * PITCH, PPR = KC / 8, NPT = VB * KC / 256, NCS = DM / (NBF * 16);
    static_assert(2 * BUFB + 4 * NBF * 64 * 16 <= RING_BYTES, "thin LDS");
    const int lane = fresh_lane(), tid = wave * 64 + lane, m16 = lane & 15, kq = lane >> 4, KH = T.K / 2, nch = KH / KC, wh = wave >> 2, w4 = wave & 3;
    LAS f32x4* red = (LAS f32x4*)(L + 2 * BUFB);
    for (int q = bx; q < NCS * 4; q += gridDim.x) {
        const int cs = q % NCS, rg = q / NCS, row0 = rg * 64 + w4 * 16;
        const bf16* ap = T.A + (size_t)(row0 + m16) * T.lda + wh * KH + kq * 8;
        const bf16* bsrc[NPT]; int bdst[NPT];
#pragma unroll
        for (int i = 0; i < NPT; ++i) { const int p = tid + 512 * i, row = p / PPR, kc = p % PPR, vb = row >> 4, m = row & 15;
            bsrc[i] = T.Bt + (size_t)(cs * NBF * 16 + (vb % NBF) * 16 + m) * T.ldb + (vb / NBF) * KH + kc * 8; bdst[i] = row * PITCH + kc * 16; }
        f32x4 acc[NBF];
#pragma unroll
        for (int b = 0; b < NBF; ++b) acc[b] = (f32x4){0.f, 0.f, 0.f, 0.f};
        bf16x8 fa[3][KSN]; v4u stb[3][NPT];
#define T3_LOAD(S_, k0) do { _Pragma("unroll") for (int i = 0; i < NPT; ++i) stb[S_][i] = *(const v4u*)(bsrc[i] + (k0)); \
            _Pragma("unroll") for (int j = 0; j < KSN; ++j) fa[S_][j] = *(const bf16x8*)(ap + (k0) + 32 * j); } while (0)
#define T3_WRITE(S_, cc_) do { _Pragma("unroll") for (int i = 0; i < NPT; ++i) *(LAS v4u*)(L + ((cc_) & 1) * BUFB + bdst[i]) = stb[S_][i]; } while (0)
#define T3_MMA(S_, cc_) do { _Pragma("unroll") for (int j = 0; j < KSN; ++j) _Pragma("unroll") for (int b = 0; b < NBF; ++b) \
            acc[b] = __builtin_amdgcn_mfma_f32_16x16x32_bf16(*(const LAS bf16x8*)(L + ((cc_) & 1) * BUFB + ((wh * NBF + b) * 16 + m16) * PITCH + j * 64 + kq * 16), fa[S_][j], acc[b], 0, 0, 0); } while (0)
#define T3_BAR() asm volatile("s_waitcnt lgkmcnt(0)\n\ts_barrier" ::: "memory")
#define T3_STEP(cc, SC, SN, SL) do { if ((cc) + 2 < nch) { T3_LOAD(SL, ((cc) + 2) * KC); } __builtin_amdgcn_sched_barrier(0); \
            T3_MMA(SC, cc); __builtin_amdgcn_sched_barrier(0); \
            if ((cc) + 1 < nch) { T3_WRITE(SN, (cc) + 1); } T3_BAR(); } while (0)
        T3_LOAD(0, 0); if (nch > 1) { T3_LOAD(1, KC); } __builtin_amdgcn_sched_barrier(0);
        T3_WRITE(0, 0); T3_BAR();
#pragma unroll 1
        for (int c = 0; c < nch; c += 3) {
            T3_STEP(c, 0, 1, 2);
            if (c + 1 < nch) T3_STEP(c + 1, 1, 2, 0);
            if (c + 2 < nch) T3_STEP(c + 2, 2, 0, 1);
        }
#undef T3_LOAD
#undef T3_WRITE
#undef T3_MMA
#undef T3_STEP
        if (wh == 1) {
#pragma unroll
            for (int b = 0; b < NBF; ++b) red[(w4 * NBF + b) * 64 + lane] = acc[b]; }
        T3_BAR();
#undef T3_BAR
        if (wh == 0) {
            const int srow = row0 + m16; const size_t grow = (size_t)SEQ + srow;
#pragma unroll
            for (int b = 0; b < NBF; ++b) { const int cg = cs * NBF + b, col = cg * 16 + 4 * kq;
                const f32x4 x1 = *(const f32x4*)(T.xin + (size_t)srow * DM + col) + (acc[b] + red[(w4 * NBF + b) * 64 + lane]); *(f32x4*)(T.xout + (size_t)srow * DM + col) = x1;
                f32x2 o; o.x = __uint_as_float(pkbf(x1[0], x1[1])); o.y = __uint_as_float(pkbf(x1[2], x1[3])); *(f32x2*)(T.xn + grow * LDX + col) = o;
                float ss = (x1[0] * x1[0] + x1[1] * x1[1]) + (x1[2] * x1[2] + x1[3] * x1[3]); ss += __shfl_xor(ss, 16); ss += __shfl_xor(ss, 32);
                if (kq == 0) T.rsss_out[(size_t)srow * 128 + cg] = ss; } }
    }
}

static_assert(USE_THIN == 1, "the residual epilogue carries only the prompt rows' stream (bf16)");
constexpr int MG = USE_THIN ? SEQ : M;
constexpr int NPH = 1 + 9 * DEPTH;
__global__ void __launch_bounds__(NWAVES * 64, 2) trunk_fwd(KArgs a) {
    extern __shared__ __attribute__((aligned(16))) unsigned char lds_raw[];
    LAS unsigned char* lds = (LAS unsigned char*)lds_raw;
    volatile LAS unsigned* MISC = (volatile LAS unsigned*)(lds + MISC_OFF);
    const int wave = __builtin_amdgcn_readfirstlane(threadIdx.x >> 6);
    const int G = gridDim.x, gw = blockIdx.x * NWAVES + wave, NGW = G * NWAVES;
    unsigned char* ws = a.ws;
    gu32* ctl = (gu32*)(ws + WS_CTL);
    for (int u = wave * 64 + fresh_lane(); u < (LDS_BYTES - LDSCTL_OFF) / 4; u += NWAVES * 64) ((LAS unsigned*)(lds + LDSCTL_OFF))[u] = 0u;
    __syncthreads();
    XcdBarrier bar; bar.bar = (unsigned*)(ctl + CW_BAR); bar.x = 0; bar.st = nullptr;
    if (MK_ONE_LAUNCH) bar = xcd_barrier_post((unsigned*)(ctl + CW_BAR), MISC + 8, wave == 0 && fresh_lane() == 0);
    const int lo = a.ph_lo, hi = a.ph_hi;
#define IN(k) (lo <= (k) && (k) < hi)
#define SEAM(k) do { if (IN(k) && IN((k) + 1)) xcd_barrier(bar, wave == 0 && fresh_lane() == 0); } while (0)

    if (IN(0)) { p0_prologue(a, lds, gw, NGW, fresh_lane(), wave); SEAM(0); }

    for (int l = 0; l < DEPTH; ++l) {
        const int pb = 1 + 9 * l;
        int bx = (int)blockIdx.x, wv = wave; asm volatile("" : "+s"(bx), "+s"(wv));
        unsigned char* wl = ws + WS_W + (size_t)l * W_LAYER;
        if (IN(pb + 0)) {
            pg8::Gemm g{(const bf16*)(ws + WS_XN), (const bf16*)(wl + WO_IN), MG, NPROJ, DM, LDX, LDX}; pg8::StaticOrder S; S.init(MG, NPROJ, G, bx, WGM_A);
            pg8::EpiProj E{(bf16*)(ws + WS_PROJ), NPROJ, (const float*)(ws + WS_RSS), 1.f / DM, a.out + O_FVP + (size_t)l * SEQ * 512, a.out + O_SKP + (size_t)l * SEQ * 512, a.out + O_SVP + (size_t)l * SEQ * 512,
                           (bf16*)(ws + WS_VA), (bf16*)(ws + WS_QB), (bf16*)(ws + WS_KB), (bf16*)(ws + WS_VB), (unsigned*)(ctl + CW_KMAX + 64 * l + 8), QS_B,
                           FUSE_B, a.out + O_FKP + (size_t)l * SEQ * 512, a.out + O_CKP + (size_t)l * SEQ * 256, a.out + O_KRP + (size_t)l * SEQ * 64, a.out + O_FLP + (size_t)l * SEQ * 4,
                           (bf16*)(ws + WS_QA), (bf16*)(ws + WS_KA), (bf16*)(ws + WS_CQ), (bf16*)(ws + WS_CKVN), (float*)(ws + WS_KROPE), (float*)(ws + WS_LOGF), (float*)(ws + WS_KRSS), (float*)(ws + WS_CQSS),
                           a.in[I_FQN] + l * 128, a.in[I_FKN] + l * 128, a.in[I_QAN] + l * 512, a.in[I_KVAN] + l * 256, a.in[I_FBIAS] + l * 4, (LAS float*)(lds + RING_BYTES + 1024), (unsigned*)(ctl + CW_KMAX + 64 * l + 24), QS_A, LDCQ, LDCKV, (LAS float*)(lds + RSTAB_OFF), (unsigned)(pb + 0) << 8};
            pg8::gemm_phase<pg8::EpiProj, pg8::StaticOrder, true, true>(lds + RING_OFF, g, S, E, wv);
            __syncthreads();
            { const ThinArgs T{(const bf16*)(ws + WS_XN) + (size_t)SEQ * LDX, (const bf16*)(wl + WO_IN), DM, LDX, LDX, NPROJ / 32, (bf16*)(ws + WS_PROJ), NPROJ, (const float*)(ws + WS_RSSS), nullptr, nullptr, nullptr, nullptr, nullptr};
              if (USE_THIN) thin_gemm<0, 2, 256>(T, lds + RING_OFF, wv, bx); }
            SEAM(pb + 0);
        }
        if (IN(pb + 1)) {
            const int ln = fresh_lane();
            float kmA = 0.f, kmB = 0.f;
            for (int rep_ = 0; rep_ < 1 + PROBE_DUP_ROW; ++rep_)
            { pb_tokens(a, l, gw, NGW, ln, kmA, kmB); for (int r = gw; r < DB * PAST; r += NGW) pb_cache_row(a, l, r, ln, kmA, kmB); }
            { LAS float* km = (LAS float*)(lds + RING_OFF);
              if ((ln & 15) == 0) { km[wv * 8 + (ln >> 4)] = kmA; km[wv * 8 + 4 + (ln >> 4)] = kmB; }
              __syncthreads();
              if (wv == 0 && ln < 8) { float m = km[ln];
#pragma unroll
                  for (int w = 1; w < NWAVES; ++w) m = fmaxf(m, km[w * 8 + ln]);
                  __hip_atomic_fetch_max(ctl + CW_KMAX + 64 * l + ln, __float_as_uint(m), RLX_AGENT); }
              __syncthreads(); }
            SEAM(pb + 1);
        }
        if (IN(pb + 2)) {
          for (int rep_ = 0; rep_ < 1 + PROBE_DUP_C; ++rep_) {
            { const int ln_ = fresh_lane(); for (int j = G >= 72 ? bx - (G - 36) : bx; j < 36; j += G) if (j >= 0) scan_job(ws, (LAS float*)(lds + RING_OFF), j, wv * 64 + ln_, wv, ln_); }
            { pg8::Gemm g{(const bf16*)(ws + WS_CQ), (const bf16*)(wl + WO_UQ), M, NQC, 512, LDCQ, LDCQ}; pg8::StaticOrder S; S.init(M, NQC, G, bx, WGM_C);
              pg8::EpiPlain E{(bf16*)(ws + WS_QCR), NQC};
              pg8::gemm_phase<pg8::EpiPlain, pg8::StaticOrder, true, true>(lds + RING_OFF, g, S, E, wv); }
            __syncthreads();
            { pg8::Gemm g{(const bf16*)(ws + WS_CKVN), (const bf16*)(wl + WO_UKV), NKR, NKV, 256, LDCKV, LDCKV}; pg8::StaticOrder S; S.init(NKR, NKV, G, bx, WGM_C);
              if (FOLD_KC) { pg8::EpiKV E{(bf16*)(ws + WS_KC), (bf16*)(ws + WS_KVR), (const float*)(ws + WS_KRSS), (const float*)(ws + WS_KROPE), (const float*)(ws + WS_ROPE), a.in[I_KN] + l * QKD, (LAS float*)(lds + RING_BYTES + 1024), SEQ, SKEYS};
                  pg8::gemm_phase<pg8::EpiKV, pg8::StaticOrder, true, true>(lds + RING_OFF, g, S, E, wv); }
              else { pg8::EpiPlain E{(bf16*)(ws + WS_KVR), NKV};
                  pg8::gemm_phase<pg8::EpiPlain, pg8::StaticOrder, true, true>(lds + RING_OFF, g, S, E, wv); } }
            if (PROBE_DUP_C) __syncthreads();
          }
            SEAM(pb + 2);
        }
        if (IN(pb + 3) && !(FOLD_QC && FOLD_KC)) {
            const int ln = fresh_lane();
            for (int rep_ = 0; rep_ < 1 + PROBE_DUP_ROW; ++rep_)
            for (int r = gw + (FOLD_QC ? M : 0); r < M + NKR; r += NGW) { if (r < M) pd_row<0>(a, l, r, ln); else pd_row<1>(a, l, r - M, ln); }
            SEAM(pb + 3);
        }
        if (IN(pb + 4)) {
          for (int rep_ = 0; rep_ < 1 + PROBE_DUP_E; ++rep_) {
            gu32* head = ctl + CW_AQ + 64 * l + 16 * rep_;
            const int nconv = (CONV_IN_E && l + 1 < DEPTH) ? NCONV : 0; static_assert(2 * NCONV <= att::NU && NCONV * CONV_PER_UNIT >= CI_LAYER && CONV_PER_UNIT % NWAVES == 0, "conversion units fit between the attention units");
            for (;;) {
                if (wv == 0 && fresh_lane() == 0) MISC[12] = __hip_atomic_fetch_add(head, 1u, RLX_AGENT);
                __syncthreads();
                const int t_ = (int)MISC[12];
                __syncthreads();
                if (t_ >= att::NU + nconv) break;
                int u = t_ - nconv;
                if (t_ < 3 * nconv) {
                    if (t_ % 3 == 2) { const int c_ = t_ / 3, ln_ = fresh_lane();
#pragma unroll 1
                        for (int j_ = 0; j_ < CONV_PER_UNIT / NWAVES; ++j_) { const int it_ = (c_ * (CONV_PER_UNIT / NWAVES) + j_) * NWAVES + wv; if (it_ < CI_LAYER) p0_conv_item(a, l + 1, it_, ln_); }
                        continue; }
                    u = t_ - t_ / 3; }
                att::UnitDesc U; int type;
                U.part = -1; U.t_lo = 0;
                if (u < att::NU_MLA) { type = 2; U.h = u & 3; int qb, p;
#if MLA_G == 32
                    if (u < att::NU_MLA_FULL) { qb = 63 - (u >> 2); p = 0; U.t_lo = 0; U.t_hi = 128; U.part = 0; }
                    else { const int k = (u - att::NU_MLA_FULL) >> 2; qb = (k & 1) * 32 + 31 - (k >> 1); p = qb >> 5; U.t_lo = 128 * p; U.t_hi = 4 * (qb + 1); U.part = p > 0 ? p : -1; }
#else
                    if (u < att::NU_MLA_FULL) { const int idx = u >> 2; if (idx < 48) { qb = 63 - idx / 3; p = idx % 3; } else if (idx < 80) { qb = 47 - (idx - 48) / 2; p = (idx - 48) & 1; } else { qb = 31 - (idx - 80); p = 0; }
                        U.t_lo = 64 * p; U.t_hi = 64 * p + 64; U.part = p; }
                    else { const int k = (u - att::NU_MLA_FULL) >> 2; qb = (k & 3) * 16 + 15 - (k >> 2); p = qb >> 4; U.t_lo = 64 * p; U.t_hi = 4 * (qb + 1); U.part = p > 0 ? p : -1; }
#endif
                    U.qrow0 = qb * 256; U.nq = 256; U.krow0 = 0; U.qpos0 = qb * 256; U.nkeys = SEQ; }
                else if (u < att::NU_PROMPT) { const int v = u - att::NU_MLA; type = v >> 8;
                    U.h = v & 3; const int qb = 63 - ((v & 255) >> 2); U.qrow0 = qb * 256; U.nq = 256; U.krow0 = 0; U.qpos0 = qb * 256; U.nkeys = SEQ; U.t_hi = 4 * (qb + 1); }
                else { const int v = u - att::NU_PROMPT; const int k = v >> 5, b = (v & 31) >> 2; type = k == 0 ? 2 : k == 1 ? 0 : 1;
                    U.h = v & 3; U.qrow0 = SEQ + b * DS; U.nq = DS; U.krow0 = SEQ + b * SKEYS; U.qpos0 = PAST; U.nkeys = SKEYS; U.t_hi = (PAST + DS - 1) / 64 + 1; }
                if (type == 2) att::attn_unit<2>(lds + RING_OFF, ws, U, 0.f, wv, a.in[I_QN] + l * QKD);
                else if (type == 0) { const gu32* ks_ = ctl + CW_KMAX + 64 * l + 24 + U.h * 4;
                    const float ka2 = (__uint_as_float(__hip_atomic_load(ks_, RLX_AGENT)) + __uint_as_float(__hip_atomic_load(ks_ + 1, RLX_AGENT))) + (__uint_as_float(__hip_atomic_load(ks_ + 2, RLX_AGENT)) + __uint_as_float(__hip_atomic_load(ks_ + 3, RLX_AGENT)));
                    att::attn_unit<0>(lds + RING_OFF, ws, U, sqrtf(fmaxf(ka2, __uint_as_float(__hip_atomic_load(ctl + CW_KMAX + 64 * l + U.h, RLX_AGENT)))), wv); }
                else { const gu32* ks_ = ctl + CW_KMAX + 64 * l + 8 + U.h * 4;
                    const float kb2 = (__uint_as_float(__hip_atomic_load(ks_, RLX_AGENT)) + __uint_as_float(__hip_atomic_load(ks_ + 1, RLX_AGENT))) + (__uint_as_float(__hip_atomic_load(ks_ + 2, RLX_AGENT)) + __uint_as_float(__hip_atomic_load(ks_ + 3, RLX_AGENT)));
                    att::attn_unit<1>(lds + RING_OFF, ws, U, sqrtf(fmaxf(kb2, __uint_as_float(__hip_atomic_load(ctl + CW_KMAX + 64 * l + 4 + U.h, RLX_AGENT)))), wv); }
            }
            if (PROBE_DUP_E) xcd_barrier(bar, wv == 0 && fresh_lane() == 0);
          }
            SEAM(pb + 4);
        }
        if (IN(pb + 5)) {
            const int ln = fresh_lane();
            for (int rep_ = 0; rep_ < 1 + PROBE_DUP_ROW; ++rep_)
            pf_rows(a, l, gw, NGW, ln);
            SEAM(pb + 5);
        }
        if (IN(pb + 6)) {
            pg8::Gemm g{(const bf16*)(ws + WS_MIX), (const bf16*)(wl + WO_OUT), MG, DM, MIXW, LDMIX, LDMIX}; pg8::StaticOrder S; S.init(MG, DM, G, bx, WGM_G);
            pg8::EpiResid E{l == 0 ? a.in[I_XP] : nullptr, nullptr, (bf16*)(ws + WS_XN), LDX, (float*)(ws + WS_RSS), DM};
            pg8::gemm_phase<pg8::EpiResid, pg8::StaticOrder, true, true>(lds + RING_OFF, g, S, E, wv);
            __syncthreads();
            { const ThinArgs T{(const bf16*)(ws + WS_MIX) + (size_t)SEQ * LDMIX, (const bf16*)(wl + WO_OUT), MIXW, LDMIX, LDMIX, DM / 16, nullptr, 0, nullptr, l == 0 ? a.in[I_XS] : a.out + O_Y + (size_t)SEQ * DM, a.out + O_Y + (size_t)SEQ * DM,
                               (bf16*)(ws + WS_XN), a.in[I_NFFN] + l * DM, (float*)(ws + WS_RSSS)};
              if (USE_THIN) thin_gemm_ks<256>(T, lds + RING_OFF, wv, bx); }
            SEAM(pb + 6);
        }
        if (IN(pb + 7)) {
            pg8::Gemm g{(const bf16*)(ws + WS_XN), (const bf16*)(wl + WO_GU), MG, 2 * DFF, DM, LDX, LDX}; pg8::StaticOrder S; S.init(MG, 2 * DFF, G, bx, WGM_H);
            pg8::EpiSwiGlu E{(bf16*)(ws + WS_H), LDH, (const float*)(ws + WS_RSS), 1.f / DM, (LAS float*)(lds + RSTAB_OFF), (unsigned)(pb + 7) << 8};
            for (int rep_ = 0; rep_ < 1 + PROBE_DUP_H; ++rep_) { pg8::gemm_phase<pg8::EpiSwiGlu, pg8::StaticOrder, true, true>(lds + RING_OFF, g, S, E, wv); if (PROBE_DUP_H) xcd_barrier(bar, wv == 0 && fresh_lane() == 0); }
            __syncthreads();
            { const ThinArgs T{(const bf16*)(ws + WS_XN) + (size_t)SEQ * LDX, (const bf16*)(wl + WO_GU), DM, LDX, LDX, DFF / 32, (bf16*)(ws + WS_H), LDH, (const float*)(ws + WS_RSSS), nullptr, nullptr, nullptr, nullptr, nullptr};
              if (USE_THIN) thin_gemm<1, 4, 256>(T, lds + RING_OFF, wv, bx); }
            SEAM(pb + 7);
        }
        if (IN(pb + 8)) {
            pg8::Gemm g{(const bf16*)(ws + WS_H), (const bf16*)(wl + WO_DOWN), MG, DM, DFF, LDH, LDH}; pg8::StaticOrder S; S.init(MG, DM, G, bx, WGM_I);
            pg8::EpiResid E{nullptr, l + 1 == DEPTH ? a.out + O_Y : nullptr, (bf16*)(ws + WS_XN), LDX, (float*)(ws + WS_RSS), DM};
            pg8::gemm_phase<pg8::EpiResid, pg8::StaticOrder, true, true>(lds + RING_OFF, g, S, E, wv);
            __syncthreads();
            { const ThinArgs T{(const bf16*)(ws + WS_H) + (size_t)SEQ * LDH, (const bf16*)(wl + WO_DOWN), DFF, LDH, LDH, DM / 16, nullptr, 0, nullptr, a.out + O_Y + (size_t)SEQ * DM, a.out + O_Y + (size_t)SEQ * DM,
                               (bf16*)(ws + WS_XN), a.in[I_NMIX] + (l + 1 < DEPTH ? l + 1 : l) * DM, (float*)(ws + WS_RSSS)};
              if (USE_THIN) thin_gemm_ks<256>(T, lds + RING_OFF, wv, bx); }
            SEAM(pb + 8);
        }
    }
#undef IN
#undef SEAM
}

extern "C" void kernel_launch(void* const* d_in, const int* in_sizes, int n_in, void* d_out, int out_size, void* d_ws, size_t ws_size, hipStream_t stream) {
    static int grid = 0;
    if (grid == 0) {
        if (n_in != N_INPUTS || (size_t)out_size != O_END || ws_size < WS_END) { fprintf(stderr, "kernel_launch: unexpected shapes (n_in %d, out %d, ws %zu; need ws >= %zu)\n", n_in, out_size, ws_size, (size_t)WS_END); grid = -1; return; }
        int dev = 0, cus = 0, per_cu = 0;
        if (hipGetDevice(&dev) != hipSuccess || hipDeviceGetAttribute(&cus, hipDeviceAttributeMultiprocessorCount, dev) != hipSuccess) { grid = -1; return; }
        if (hipFuncSetAttribute((const void*)trunk_fwd, hipFuncAttributeMaxDynamicSharedMemorySize, LDS_BYTES) != hipSuccess) { fprintf(stderr, "kernel_launch: hipFuncSetAttribute failed\n"); grid = -1; return; }
        if (hipOccupancyMaxActiveBlocksPerMultiprocessor(&per_cu, (const void*)trunk_fwd, NWAVES * 64, LDS_BYTES) != hipSuccess || per_cu < 1) { fprintf(stderr, "kernel_launch: occupancy query says %d blocks per CU\n", per_cu); }
        (void)hipGetLastError();
        grid = cus;
    }
    if (grid < 0) return;
    (void)in_sizes;
    if (hipMemsetAsync((char*)d_ws + WS_CTL, 0, CTL_ZERO_BYTES, stream) != hipSuccess) { fprintf(stderr, "kernel_launch: memset failed\n"); return; }
    KArgs a{};
    for (int i = 0; i < N_INPUTS; ++i) a.in[i] = (const float*)d_in[i];
    a.out = (float*)d_out; a.ws = (unsigned char*)d_ws;
#if MK_ONE_LAUNCH
    a.ph_lo = 0; a.ph_hi = NPH;
    hipLaunchKernelGGL(trunk_fwd, dim3(grid), dim3(NWAVES * 64), LDS_BYTES, stream, a);
#else
    for (int p = 0; p < NPH; ++p) { a.ph_lo = p; a.ph_hi = p + 1; hipLaunchKernelGGL(trunk_fwd, dim3(grid), dim3(NWAVES * 64), LDS_BYTES, stream, a); }
#endif
    const hipError_t le = hipPeekAtLastError();
    if (le != hipSuccess) fprintf(stderr, "kernel_launch: launch failed: %s\n", hipGetErrorName(le));
}
```

```cpp
#include <hip/hip_runtime.h>
#include <cstdio>
#include <cstdint>
#ifndef MLA_G
#define MLA_G 32
#endif
#ifndef CONV_IN_E
#define CONV_IN_E 1
#endif
#ifndef PROBE_DUP_E
#define PROBE_DUP_E 0
#endif
#ifndef PROBE_DUP_H
#define PROBE_DUP_H 0
#endif
#ifndef USE_THIN
#define USE_THIN 1
#endif
#ifndef PROBE_DUP_ROW
#define PROBE_DUP_ROW 0
#endif
#ifndef PROBE_DUP_C
#define PROBE_DUP_C 0
#endif
#ifndef WGM_A
#define WGM_A 4
#endif
#ifndef WGM_G
#define WGM_G 4
#endif
#ifndef WGM_H
#define WGM_H 4
#endif
#ifndef WGM_I
#define WGM_I 4
#endif
#ifndef WGM_C
#define WGM_C 4
#endif
#ifndef ATT_LAG
#define ATT_LAG 0
#endif
#ifndef FOLD_QC
#define FOLD_QC 1
#endif
#ifndef FOLD_KC
#define FOLD_KC 1
#endif
#ifndef FUSE_B
#define FUSE_B 1
#endif
#ifndef ATT_NEGM
#define ATT_NEGM 1
#endif
#ifndef ATT_PIPE
#define ATT_PIPE 0
#endif
#ifndef MK_ONE_LAUNCH
#define MK_ONE_LAUNCH 1
#endif
__device__ __forceinline__ int fresh_lane() { int l_; asm volatile("v_mbcnt_lo_u32_b32 %0, -1, 0\n\tv_mbcnt_hi_u32_b32 %0, -1, %0" : "=v"(l_)); return l_; }
namespace pg8 {
#define PG8_LAS __attribute__((address_space(3)))
typedef unsigned short bf16_t;
typedef short bf16x8 __attribute__((ext_vector_type(8)));
typedef float f32x4 __attribute__((ext_vector_type(4)));
typedef unsigned u32x4 __attribute__((ext_vector_type(4)));
constexpr int BM = 256, BK = 64, HALF = 128, HTB = HALF * BK * 2  , STAGE_BYTES = 8 * HTB, NXCD = 8;

__host__ __device__ __forceinline__ int lds_byte(int r, int c) { const int st = (r >> 4) * 2 + (c >> 5), rr = r & 15, cc = c & 31, ob = rr * 64 + cc * 2; return st * 1024 + (ob ^ (((ob >> 9) & 1) << 5)); }
__host__ __device__ __forceinline__ void stage_rc(int b, int& R, int& C) { const int st = b / 1024, sb = b % 1024, swz = sb ^ (((sb >> 9) & 1) << 5); R = (st >> 1) * 16 + swz / 64; C = (st & 1) * 32 + (swz % 64) / 2; }
__host__ __device__ __forceinline__ int perm32(int rho) { const int n = rho >> 4, i = rho & 15; return 8 * (i >> 2) + 4 * n + (i & 3); }

struct Unit { int pm, pn; };
struct Gemm { const bf16_t* A; const bf16_t* Bt; int M, N, K, lda, ldb; };

struct StaticOrder {
    int nM, nN, nwg, G, c, WGM;
    __host__ __device__ void init(int M, int N, int G_, int c_, int wgm = 4) { nM = M / BM; nN = N / BM; nwg = nM * nN; G = G_; c = c_; WGM = wgm; }
    __host__ __device__ bool next(int i, Unit& u) const {
        const long L = (long)i * G + c; if (L >= nwg) return false;
        int wgid = (int)L; { const int q = nwg / NXCD, r = nwg % NXCD, xcd = wgid % NXCD, off = wgid / NXCD; wgid = (xcd < r ? xcd * (q + 1) : r * (q + 1) + (xcd - r) * q) + off; }
        const int nig = WGM * nN, gid = wgid / nig, fm = gid * WGM, gsz = (nM - fm) < WGM ? (nM - fm) : WGM;
        u.pm = fm + ((wgid % nig) % gsz); u.pn = (wgid % nig) / gsz; return true;
    }
    __device__ __forceinline__ void a_ready(const Unit&) const {}
    __device__ __forceinline__ void done(const Unit&) const {}
};

__device__ __forceinline__ unsigned cvt_pk_bf16(float lo, float hi) { unsigned r; asm volatile("v_cvt_pk_bf16_f32 %0, %1, %2" : "=v"(r) : "v"(lo), "v"(hi)); return r; }
typedef float f32x2 __attribute__((ext_vector_type(2)));

constexpr float RMS_EPS = 1e-6f;
__device__ __forceinline__ float row_rstd(const float* rowss, int row, int fq, float inv_n) {
    const f32x4 a = *(const f32x4*)(rowss + (size_t)row * 32 + fq * 8), b = *(const f32x4*)(rowss + (size_t)row * 32 + fq * 8 + 4);
    float s = ((a[0] + a[1]) + (a[2] + a[3])) + ((b[0] + b[1]) + (b[2] + b[3]));
    s += __shfl_xor(s, 16); s += __shfl_xor(s, 32);
    return 1.0f / sqrtf(s * inv_n + RMS_EPS);
}
__device__ __forceinline__ void rstd_rows(float (&rsv)[2][4], const float* rowss, int row0, int fr, int fq, float inv_n, PG8_LAS float* tab, unsigned want, int wid) {
    PG8_LAS float* tb = tab + wid * 128; volatile PG8_LAS unsigned* tg = (volatile PG8_LAS unsigned*)(tab + 1024) + wid;
    if ((unsigned)__builtin_amdgcn_readfirstlane((int)*tg) == want) {
#pragma unroll
        for (int ai = 0; ai < 2; ++ai)
#pragma unroll
            for (int m = 0; m < 4; ++m) rsv[ai][m] = tb[ai * 64 + m * 16 + fr];
    } else {
#pragma unroll
        for (int ai = 0; ai < 2; ++ai)
#pragma unroll
            for (int m = 0; m < 4; ++m) { rsv[ai][m] = row_rstd(rowss, row0 + ai * HALF + m * 16, fq, inv_n); tb[ai * 64 + m * 16 + fr] = rsv[ai][m]; }
        *tg = want;
    }
}
__device__ __forceinline__ void unperm_sw(float& a, float& b) {
    asm volatile("s_nop 1\n\tv_permlane16_swap_b32 %0, %1\n\ts_nop 1\n\tv_permlane32_swap_b32 %0, %1" : "+v"(a), "+v"(b)); }
__device__ __forceinline__ void unperm8(f32x4& x, f32x4& y) {
    float a0 = x[0], a1 = x[1], a2 = x[2], a3 = x[3], b0 = y[0], b1 = y[1], b2 = y[2], b3 = y[3];
    unperm_sw(a0, b0); unperm_sw(a1, b1); unperm_sw(a2, b2); unperm_sw(a3, b3);
    x = (f32x4){a0, a1, a2, a3}; y = (f32x4){b0, b1, b2, b3};
}
struct EpiPlain {
    static constexpr bool PERM = true, AFTER_DRAIN = false, WIDE = false;
    bf16_t* O; int ldc;
    __device__ __forceinline__ void operator()(const f32x4 (&acc)[2][2][4][2], const Unit& u, int wr, int wc, int fr, int fq) const {
        const int row0 = u.pm * BM + wr * 64 + fr, col0 = u.pn * BM + wc * 32 + 8 * fq;
#pragma unroll
        for (int ai = 0; ai < 2; ++ai)
#pragma unroll
            for (int m = 0; m < 4; ++m) { bf16_t* rowp = O + (size_t)(row0 + ai * HALF + m * 16) * ldc + col0;
#pragma unroll
                for (int bj = 0; bj < 2; ++bj) { const f32x4 v0 = acc[ai][bj][m][0], v1 = acc[ai][bj][m][1];
                    u32x4 w; w.x = cvt_pk_bf16(v0[0], v0[1]); w.y = cvt_pk_bf16(v0[2], v0[3]); w.z = cvt_pk_bf16(v1[0], v1[1]); w.w = cvt_pk_bf16(v1[2], v1[3]);
                    *(u32x4*)(rowp + bj * HALF) = w; } }
    }
};
struct EpiScaled {
    static constexpr bool PERM = true, AFTER_DRAIN = false, WIDE = false;
    bf16_t* O; int ldc; const float* rowss; float inv_n;
    __device__ __forceinline__ void operator()(const f32x4 (&acc)[2][2][4][2], const Unit& u, int wr, int wc, int fr, int fq) const {
        const int row0 = u.pm * BM + wr * 64 + fr, col0 = u.pn * BM + wc * 32 + 8 * fq;
        float rsv[2][4];
#pragma unroll
        for (int ai = 0; ai < 2; ++ai)
#pragma unroll
            for (int m = 0; m < 4; ++m) rsv[ai][m] = row_rstd(rowss, row0 + ai * HALF + m * 16, fq, inv_n);
#pragma unroll
        for (int ai = 0; ai < 2; ++ai)
#pragma unroll
            for (int m = 0; m < 4; ++m) { const int row = row0 + ai * HALF + m * 16; const float rs = rsv[ai][m];
                bf16_t* rowp = O + (size_t)row * ldc + col0;
#pragma unroll
                for (int bj = 0; bj < 2; ++bj) { const f32x4 v0 = acc[ai][bj][m][0] * rs, v1 = acc[ai][bj][m][1] * rs;
                    u32x4 w; w.x = cvt_pk_bf16(v0[0], v0[1]); w.y = cvt_pk_bf16(v0[2], v0[3]); w.z = cvt_pk_bf16(v1[0], v1[1]); w.w = cvt_pk_bf16(v1[2], v1[3]);
                    *(u32x4*)(rowp + bj * HALF) = w; } }
    }
};
__device__ __forceinline__ void ld8(const float* p, float* x) { const f32x4 a = *(const f32x4*)p, b = *(const f32x4*)(p + 4); x[0] = a[0]; x[1] = a[1]; x[2] = a[2]; x[3] = a[3]; x[4] = b[0]; x[5] = b[1]; x[6] = b[2]; x[7] = b[3]; }
__device__ __forceinline__ float logsig(float v) { return fminf(v, 0.f) - log1pf(__expf(-fabsf(v))); }
struct EpiProj {
    static constexpr bool PERM = true, AFTER_DRAIN = false, WIDE = false;
    bf16_t* O; int ldc; const float* rowss; float inv_n;
    float* o_fv; float* o_sk; float* o_sv; bf16_t* VA; bf16_t* QB; bf16_t* KB; bf16_t* VB; unsigned* kslice; float qs_b;
    int fuse; float* o_fk; float* o_ck; float* o_kr; float* o_fl; bf16_t* QA; bf16_t* KA; bf16_t* CQ; bf16_t* CKVN; float* KROPE; float* LOGF; float* KRSS; float* CQSS;
    const float* gq; const float* gk; const float* gqa; const float* gkv; const float* fbias; PG8_LAS float* xch; unsigned* kslice_a; float qs_a; int ldcq, ldckv; PG8_LAS float* rstab; unsigned tag;
    __device__ __forceinline__ void operator()(const f32x4 (&acc)[2][2][4][2], const Unit& u, int wr, int wc, int fr, int fq) const {
        const int row0 = u.pm * BM + wr * 64 + fr, col0 = u.pn * BM + wc * 32 + 8 * fq;
        float rsv[2][4];
        rstd_rows(rsv, rowss, row0, fr, fq, inv_n, rstab, tag | (unsigned)(u.pm + 1), wr * 4 + wc);
        const int kind = (u.pn >= 4 && u.pn < 12) ? ((u.pn - 4) >> 1) + 1 : 0;
        if (kind == 0 && fuse) {
            if (u.pn < 2) norm_tiles<5>(acc, u, rsv, wr, wc); else if (u.pn < 4) norm_tiles<6>(acc, u, rsv, wr, wc);
            else if (u.pn < 14) cq_tiles(acc, u, rsv, wr, wc); else if (u.pn == 14) norm_tiles<7>(acc, u, rsv, wr, wc); else norm_tiles<8>(acc, u, rsv, wr, wc);
        } else if (kind == 0) {
#pragma unroll
            for (int ai = 0; ai < 2; ++ai)
#pragma unroll
                for (int m = 0; m < 4; ++m) { const int row = row0 + ai * HALF + m * 16; const float rs = rsv[ai][m];
                    bf16_t* rowp = O + (size_t)row * ldc + col0;
#pragma unroll
                    for (int bj = 0; bj < 2; ++bj) { const f32x4 v0 = acc[ai][bj][m][0] * rs, v1 = acc[ai][bj][m][1] * rs;
                        u32x4 w; w.x = cvt_pk_bf16(v0[0], v0[1]); w.y = cvt_pk_bf16(v0[2], v0[3]); w.z = cvt_pk_bf16(v1[0], v1[1]); w.w = cvt_pk_bf16(v1[2], v1[3]);
                        *(u32x4*)(rowp + bj * HALF) = w; } }
        } else if (kind == 1) copy_tiles<1>(acc, u, rsv, row0, wc, fq, fr, o_fv, VA, 1.f);
        else if (kind == 2) copy_tiles<2>(acc, u, rsv, row0, wc, fq, fr, nullptr, QB, qs_b);
        else if (kind == 3) copy_tiles<3>(acc, u, rsv, row0, wc, fq, fr, o_sk, KB, 1.f);
        else copy_tiles<4>(acc, u, rsv, row0, wc, fq, fr, o_sv, VB, 1.f);
    }
    template <int KIND> __device__ __forceinline__ void norm_tiles(const f32x4 (&acc)[2][2][4][2], const Unit& u, const float (&rsv)[2][4], int wr, int wc) const {
        const int ln_ = fresh_lane(), fr = ln_ & 15, fq = ln_ >> 4, rl0 = wr * 64 + fr, row0 = u.pm * BM + rl0, c8 = wc * 32 + 8 * fq;
#pragma unroll
        for (int ai = 0; ai < 2; ++ai)
#pragma unroll
            for (int m = 0; m < 4; ++m) { const float rs = rsv[ai][m];
#pragma unroll
                for (int bj = 0; bj < 2; ++bj) { const f32x4 a0 = acc[ai][bj][m][0] * rs, a1 = acc[ai][bj][m][1] * rs;
                    float p_ = ((a0[0] * a0[0] + a0[1] * a0[1]) + (a0[2] * a0[2] + a0[3] * a0[3])) + ((a1[0] * a1[0] + a1[1] * a1[1]) + (a1[2] * a1[2] + a1[3] * a1[3]));
                    if (KIND == 8 && (bj != 0 || wc >= 2)) p_ = 0.f;
                    p_ += __shfl_xor(p_, 16); p_ += __shfl_xor(p_, 32);
                    if (fq == 0) xch[((ai * HALF + rl0 + m * 16) * 2 + bj) * 4 + wc] = p_; } }
        float g0[8], g1[8];
        if (KIND == 5) { ld8(gq + c8, g0); } else if (KIND == 6) { ld8(gk + c8, g0); } else if (KIND == 7) { ld8(gkv + c8, g0); ld8(gkv + HALF + c8, g1); }
        f32x4 fb = {0.f, 0.f, 0.f, 0.f}; if (KIND == 8) fb = *(const f32x4*)fbias;
        asm volatile("s_waitcnt lgkmcnt(0)\n\ts_barrier" ::: "memory");
        float kmx0 = 0.f, kmx1 = 0.f;
#pragma unroll
        for (int ai = 0; ai < 2; ++ai)
#pragma unroll
            for (int m = 0; m < 4; ++m) { const int row = row0 + ai * HALF + m * 16; const float rs = rsv[ai][m];
                const f32x4 q0 = *(const PG8_LAS f32x4*)(xch + ((ai * HALF + rl0 + m * 16) * 2 + 0) * 4), q1 = *(const PG8_LAS f32x4*)(xch + ((ai * HALF + rl0 + m * 16) * 2 + 1) * 4);
                const float s0 = (q0[0] + q0[1]) + (q0[2] + q0[3]), s1 = (q1[0] + q1[1]) + (q1[2] + q1[3]);
                if (KIND == 5 || KIND == 6) {
#pragma unroll
                    for (int bj = 0; bj < 2; ++bj) { const float rn = rs / sqrtf((bj == 0 ? s0 : s1) * (1.f / 128.f) + RMS_EPS) * (KIND == 5 ? qs_a : 1.f);
                        const f32x4 a0 = acc[ai][bj][m][0] * rn, a1 = acc[ai][bj][m][1] * rn;
                        const f32x4 y0 = {a0[0] * g0[0], a0[1] * g0[1], a0[2] * g0[2], a0[3] * g0[3]}, y1 = {a1[0] * g0[4], a1[1] * g0[5], a1[2] * g0[6], a1[3] * g0[7]};
                        const size_t off = (size_t)row * 512 + (u.pn & 1) * BM + bj * HALF + c8;
                        u32x4 w; w.x = cvt_pk_bf16(y0[0], y0[1]); w.y = cvt_pk_bf16(y0[2], y0[3]); w.z = cvt_pk_bf16(y1[0], y1[1]); w.w = cvt_pk_bf16(y1[2], y1[3]);
                        if (KIND == 5) *(u32x4*)(QA + off) = w;
                        else { *(u32x4*)(KA + off) = w; { f32x4 x = y0, y = y1; unperm8(x, y); float* p = o_fk + (off - 4 * fq); __builtin_nontemporal_store(x, (f32x4*)p); __builtin_nontemporal_store(y, (f32x4*)(p + 16)); }
                            float p_ = ((y0[0] * y0[0] + y0[1] * y0[1]) + (y0[2] * y0[2] + y0[3] * y0[3])) + ((y1[0] * y1[0] + y1[1] * y1[1]) + (y1[2] * y1[2] + y1[3] * y1[3]));
                            p_ += __shfl_xor(p_, 16); p_ += __shfl_xor(p_, 32); if (bj == 0) kmx0 = fmaxf(kmx0, p_); else kmx1 = fmaxf(kmx1, p_); } }
                } else if (KIND == 7) { const float rn = rs / sqrtf((s0 + s1) * (1.f / 256.f) + RMS_EPS);
#pragma unroll
                    for (int bj = 0; bj < 2; ++bj) { const f32x4 a0 = acc[ai][bj][m][0] * rn, a1 = acc[ai][bj][m][1] * rn;
                        const f32x4 y0 = bj == 0 ? (f32x4){a0[0] * g0[0], a0[1] * g0[1], a0[2] * g0[2], a0[3] * g0[3]} : (f32x4){a0[0] * g1[0], a0[1] * g1[1], a0[2] * g1[2], a0[3] * g1[3]};
                        const f32x4 y1 = bj == 0 ? (f32x4){a1[0] * g0[4], a1[1] * g0[5], a1[2] * g0[6], a1[3] * g0[7]} : (f32x4){a1[0] * g1[4], a1[1] * g1[5], a1[2] * g1[6], a1[3] * g1[7]};
                        const int cc = bj * HALF + c8;
                        { f32x4 x = y0, y = y1; unperm8(x, y); float* p = o_ck + (size_t)row * 256 + (cc - 4 * fq); __builtin_nontemporal_store(x, (f32x4*)p); __builtin_nontemporal_store(y, (f32x4*)(p + 16)); }
                        u32x4 w; w.x = cvt_pk_bf16(y0[0], y0[1]); w.y = cvt_pk_bf16(y0[2], y0[3]); w.z = cvt_pk_bf16(y1[0], y1[1]); w.w = cvt_pk_bf16(y1[2], y1[3]);
                        *(u32x4*)(CKVN + (size_t)row * ldckv + cc) = w; }
                } else {
                    const f32x4 a0 = acc[ai][0][m][0] * rs, a1 = acc[ai][0][m][1] * rs;
                    if (wc < 2) { __builtin_nontemporal_store(a0, (f32x4*)(o_kr + (size_t)row * 64 + c8)); __builtin_nontemporal_store(a1, (f32x4*)(o_kr + (size_t)row * 64 + c8 + 4));
                        *(f32x4*)(KROPE + (size_t)row * 64 + c8) = a0; *(f32x4*)(KROPE + (size_t)row * 64 + c8 + 4) = a1;
                        if (wc == 0 && fq == 0) KRSS[row] = s0; }
                    else if (wc == 2 && fq == 0) { const f32x4 lf = {logsig(a0[0] + fb[0]), logsig(a0[1] + fb[1]), logsig(a0[2] + fb[2]), logsig(a0[3] + fb[3])};
                        __builtin_nontemporal_store(lf, (f32x4*)(o_fl + (size_t)row * 4)); *(f32x4*)(LOGF + (size_t)row * 4) = lf; } } }
        if (KIND == 6) {
#pragma unroll
            for (int bj = 0; bj < 2; ++bj) { float mx = bj == 0 ? kmx0 : kmx1;
#pragma unroll
                for (int o_ = 1; o_ < 16; o_ <<= 1) mx = fmaxf(mx, __shfl_xor(mx, o_));
                if (fr == 0 && fq == 0) __hip_atomic_fetch_max(kslice_a + (((u.pn - 2) * 2 + bj) * 4 + wc), __float_as_uint(mx * 1.02f), __ATOMIC_RELAXED, __HIP_MEMORY_SCOPE_AGENT); } }
    }
    __device__ __forceinline__ void cq_tiles(const f32x4 (&acc)[2][2][4][2], const Unit& u, const float (&rsv)[2][4], int wr, int wc) const {
        const int ln_ = fresh_lane(), fr = ln_ & 15, fq = ln_ >> 4, row0 = u.pm * BM + wr * 64 + fr, c8 = wc * 32 + 8 * fq;
        float g0[8], g1[8]; ld8(gqa + (u.pn - 12) * BM + c8, g0); ld8(gqa + (u.pn - 12) * BM + HALF + c8, g1);
#pragma unroll
        for (int ai = 0; ai < 2; ++ai)
#pragma unroll
            for (int m = 0; m < 4; ++m) { const int row = row0 + ai * HALF + m * 16; const float rs = rsv[ai][m];
#pragma unroll
                for (int bj = 0; bj < 2; ++bj) { const f32x4 a0 = acc[ai][bj][m][0] * rs, a1 = acc[ai][bj][m][1] * rs;
                    float p_ = ((a0[0] * a0[0] + a0[1] * a0[1]) + (a0[2] * a0[2] + a0[3] * a0[3])) + ((a1[0] * a1[0] + a1[1] * a1[1]) + (a1[2] * a1[2] + a1[3] * a1[3]));
                    p_ += __shfl_xor(p_, 16); p_ += __shfl_xor(p_, 32);
                    if (fq == 0) CQSS[(size_t)row * 16 + (u.pn - 12) * 8 + bj * 4 + wc] = p_;
                    u32x4 w;
                    if (bj == 0) { w.x = cvt_pk_bf16(a0[0] * g0[0], a0[1] * g0[1]); w.y = cvt_pk_bf16(a0[2] * g0[2], a0[3] * g0[3]); w.z = cvt_pk_bf16(a1[0] * g0[4], a1[1] * g0[5]); w.w = cvt_pk_bf16(a1[2] * g0[6], a1[3] * g0[7]); }
                    else { w.x = cvt_pk_bf16(a0[0] * g1[0], a0[1] * g1[1]); w.y = cvt_pk_bf16(a0[2] * g1[2], a0[3] * g1[3]); w.z = cvt_pk_bf16(a1[0] * g1[4], a1[1] * g1[5]); w.w = cvt_pk_bf16(a1[2] * g1[6], a1[3] * g1[7]); }
                    *(u32x4*)(CQ + (size_t)row * ldcq + (u.pn - 12) * BM + bj * HALF + c8) = w; } }
    }
    template <int KIND> __device__ __forceinline__ void copy_tiles(const f32x4 (&acc)[2][2][4][2], const Unit& u, const float (&rsv)[2][4], int row0, int wc, int fq, int fr, float* of, bf16_t* ob, float sc) const {
        const int dcol0 = ((u.pn - 4) & 1) * BM + wc * 32 + 8 * fq;
        float kmx0 = 0.f, kmx1 = 0.f;
#pragma unroll
        for (int ai = 0; ai < 2; ++ai)
#pragma unroll
            for (int m = 0; m < 4; ++m) { const int row = row0 + ai * HALF + m * 16; const float rs = rsv[ai][m] * sc;
#pragma unroll
                for (int bj = 0; bj < 2; ++bj) { const f32x4 v0 = acc[ai][bj][m][0] * rs, v1 = acc[ai][bj][m][1] * rs; const size_t off = (size_t)row * 512 + dcol0 + bj * HALF;
                    if (KIND != 2) { f32x4 x = v0, y = v1; unperm8(x, y); float* p = of + (off - 4 * fq); __builtin_nontemporal_store(x, (f32x4*)p); __builtin_nontemporal_store(y, (f32x4*)(p + 16)); }
                    u32x4 w; w.x = cvt_pk_bf16(v0[0], v0[1]); w.y = cvt_pk_bf16(v0[2], v0[3]); w.z = cvt_pk_bf16(v1[0], v1[1]); w.w = cvt_pk_bf16(v1[2], v1[3]);
                    *(u32x4*)(ob + off) = w;
                    if (KIND == 3) { float p_ = ((v0[0] * v0[0] + v0[1] * v0[1]) + (v0[2] * v0[2] + v0[3] * v0[3])) + ((v1[0] * v1[0] + v1[1] * v1[1]) + (v1[2] * v1[2] + v1[3] * v1[3]));
                        p_ += __shfl_xor(p_, 16); p_ += __shfl_xor(p_, 32); if (bj == 0) kmx0 = fmaxf(kmx0, p_); else kmx1 = fmaxf(kmx1, p_); } } }
        if (KIND == 3) {
#pragma unroll
            for (int bj = 0; bj < 2; ++bj) { float mx = bj == 0 ? kmx0 : kmx1;
#pragma unroll
                for (int o_ = 1; o_ < 16; o_ <<= 1) mx = fmaxf(mx, __shfl_xor(mx, o_));
                if (fr == 0 && fq == 0) __hip_atomic_fetch_max(kslice + (((u.pn - 8) * 2 + bj) * 4 + wc), __float_as_uint(mx * 1.02f), __ATOMIC_RELAXED, __HIP_MEMORY_SCOPE_AGENT); } }
    }
};
struct EpiKV {
    static constexpr bool PERM = true, AFTER_DRAIN = false, WIDE = false;
    bf16_t* KC; bf16_t* KVR; const float* krss; const float* krope; const float* rope; const float* gk; PG8_LAS float* xch; int seq, skeys;
    __device__ __forceinline__ void operator()(const f32x4 (&acc)[2][2][4][2], const Unit& u, int wr, int wc, int fr_, int fq_) const {
        typedef float f32x2v __attribute__((ext_vector_type(2)));
        const int ln_ = fresh_lane(), fr = ln_ & 15, fq = ln_ >> 4; (void)fr_; (void)fq_;
        const int rl0 = wr * 64 + fr, row0 = u.pm * BM + rl0, h = u.pn, c8 = wc * 32 + 8 * fq, j0 = 2 * (wc * 4 + fq);
#pragma unroll
        for (int ai = 0; ai < 2; ++ai)
#pragma unroll
            for (int m = 0; m < 4; ++m) { const f32x4 a0 = acc[ai][0][m][0], a1 = acc[ai][0][m][1];
                float p_ = ((a0[0] * a0[0] + a0[1] * a0[1]) + (a0[2] * a0[2] + a0[3] * a0[3])) + ((a1[0] * a1[0] + a1[1] * a1[1]) + (a1[2] * a1[2] + a1[3] * a1[3]));
                p_ += __shfl_xor(p_, 16); p_ += __shfl_xor(p_, 32);
                if (fq == 0) xch[(ai * HALF + rl0 + m * 16) * 4 + wc] = p_; }
        float gn[8]; { const f32x4 t0 = *(const f32x4*)(gk + c8), t1 = *(const f32x4*)(gk + c8 + 4); gn[0] = t0[0]; gn[1] = t0[1]; gn[2] = t0[2]; gn[3] = t0[3]; gn[4] = t1[0]; gn[5] = t1[1]; gn[6] = t1[2]; gn[7] = t1[3]; }
        const f32x2v g1 = *(const f32x2v*)(gk + 128 + j0), g2 = *(const f32x2v*)(gk + 160 + j0);
        float kq[4]; f32x2v kr1[4], kr2[4]; f32x4 cs[4];
#define KV_LOADS(ai_) do { _Pragma("unroll") for (int m = 0; m < 4; ++m) { const int row = row0 + (ai_) * HALF + m * 16; const int pos = row < seq ? row : (row - seq) % skeys; \
            kq[m] = krss[row]; kr1[m] = *(const f32x2v*)(krope + (size_t)row * 64 + j0); kr2[m] = *(const f32x2v*)(krope + (size_t)row * 64 + 32 + j0); \
            cs[m] = *(const f32x4*)(rope + ((size_t)pos * 32 + j0) * 2); } } while (0)
        KV_LOADS(0);
        asm volatile("s_waitcnt lgkmcnt(0)\n\ts_barrier" ::: "memory");
#pragma unroll
        for (int ai = 0; ai < 2; ++ai) {
            if (ai == 1) { KV_LOADS(1); asm volatile("" ::: "memory"); }
#pragma unroll
            for (int m = 0; m < 4; ++m) { const int row = row0 + ai * HALF + m * 16;
                const f32x4 pp = *(const PG8_LAS f32x4*)(xch + (ai * HALF + rl0 + m * 16) * 4);
                const float rs = 1.0f / sqrtf((((pp[0] + pp[1]) + (pp[2] + pp[3])) + kq[m]) * (1.f / 192.f) + RMS_EPS);
                { const f32x4 a0 = acc[ai][0][m][0] * rs, a1 = acc[ai][0][m][1] * rs;
                  u32x4 w; w.x = cvt_pk_bf16(a0[0] * gn[0], a0[1] * gn[1]); w.y = cvt_pk_bf16(a0[2] * gn[2], a0[3] * gn[3]); w.z = cvt_pk_bf16(a1[0] * gn[4], a1[1] * gn[5]); w.w = cvt_pk_bf16(a1[2] * gn[6], a1[3] * gn[7]);
                  *(u32x4*)(KC + (size_t)row * 768 + h * 192 + c8) = w; }
                { const f32x4 v0 = acc[ai][1][m][0], v1 = acc[ai][1][m][1];
                  u32x4 w; w.x = cvt_pk_bf16(v0[0], v0[1]); w.y = cvt_pk_bf16(v0[2], v0[3]); w.z = cvt_pk_bf16(v1[0], v1[1]); w.w = cvt_pk_bf16(v1[2], v1[3]);
                  *(u32x4*)(KVR + (size_t)row * 1024 + h * 256 + HALF + c8) = w; }
                { const float u1a = kr1[m].x * rs * g1.x, u2a = kr2[m].x * rs * g2.x, u1b = kr1[m].y * rs * g1.y, u2b = kr2[m].y * rs * g2.y; const f32x4 c = cs[m];
                  *(unsigned*)(KC + (size_t)row * 768 + h * 192 + 128 + j0) = cvt_pk_bf16(u1a * c[0] - u2a * c[1], u1b * c[2] - u2b * c[3]);
                  *(unsigned*)(KC + (size_t)row * 768 + h * 192 + 160 + j0) = cvt_pk_bf16(u2a * c[0] + u1a * c[1], u2b * c[2] + u1b * c[3]); } }
        }
#undef KV_LOADS
    }
};
__device__ __forceinline__ float silu_mul(float g, float u) { return g * u * __builtin_amdgcn_rcpf(1.0f + __builtin_amdgcn_exp2f(-1.4426950408889634f * g)); }
struct EpiSwiGlu {
    static constexpr bool PERM = true, AFTER_DRAIN = false, WIDE = false;
    bf16_t* O; int ldc; const float* rowss; float inv_n; PG8_LAS float* rstab; unsigned tag;
    __device__ __forceinline__ void operator()(const f32x4 (&acc)[2][2][4][2], const Unit& u, int wr, int wc, int fr, int fq) const {
        typedef float f32x2p __attribute__((ext_vector_type(2)));
        const int row0 = u.pm * BM + wr * 64 + fr, col0 = u.pn * HALF + wc * 32 + 8 * fq;
        float rsv[2][4];
        rstd_rows(rsv, rowss, row0, fr, fq, inv_n, rstab, tag | (unsigned)(u.pm + 1), wr * 4 + wc);
#pragma unroll
        for (int ai = 0; ai < 2; ++ai)
#pragma unroll
            for (int m = 0; m < 4; ++m) { const int row = row0 + ai * HALF + m * 16; const float rs = rsv[ai][m], c = -1.4426950408889634f * rs, rs2 = rs * rs;
                unsigned wv_[4];
#pragma unroll
                for (int n = 0; n < 2; ++n)
#pragma unroll
                    for (int h = 0; h < 2; ++h) { const f32x4 G = acc[ai][0][m][n], U = acc[ai][1][m][n];
                        const f32x2p g = {G[2 * h], G[2 * h + 1]}, up = {U[2 * h], U[2 * h + 1]};
                        const f32x2p t = g * c; f32x2p d = {__builtin_amdgcn_exp2f(t.x), __builtin_amdgcn_exp2f(t.y)}; d = d + 1.0f;
                        const f32x2p r = {__builtin_amdgcn_rcpf(d.x), __builtin_amdgcn_rcpf(d.y)}; const f32x2p o = ((g * up) * rs2) * r;
                        wv_[2 * n + h] = cvt_pk_bf16(o.x, o.y); }
                u32x4 w; w.x = wv_[0]; w.y = wv_[1]; w.z = wv_[2]; w.w = wv_[3];
                *(u32x4*)(O + (size_t)row * ldc + col0) = w; }
    }
};
struct EpiResid {
    static constexpr bool PERM = true, AFTER_DRAIN = false, WIDE = true;
    const float* xin32; float* xout32; bf16_t* yb; int ldy;
    float* rowss; int ldc;
    template <bool IN32> __device__ __forceinline__ void run(const f32x4 (&acc)[2][2][4][2], const Unit& u, int wr, int wc, int fr, int fq) const {
        constexpr int MB = IN32 ? 2 : 4;
        const int col0 = u.pn * BM + wc * 64 + 8 * fq;
#pragma unroll
        for (int ai = 0; ai < 2; ++ai)
#pragma unroll
        for (int mb = 0; mb < 4; mb += MB) {
            u32x4 xw[IN32 ? 1 : MB][2]; f32x4 xf[IN32 ? MB : 1][2][2];
#pragma unroll
            for (int mm = 0; mm < MB; ++mm) { const int row = u.pm * BM + ai * HALF + wr * 64 + (mb + mm) * 16 + fr;
#pragma unroll
                for (int bj = 0; bj < 2; ++bj) {
                    if constexpr (IN32) { const float* p = xin32 + (size_t)row * ldc + col0 + bj * 32; xf[mm][bj][0] = *(const f32x4*)p; xf[mm][bj][1] = *(const f32x4*)(p + 4); }
                    else xw[mm][bj] = *(const u32x4*)(yb + (size_t)row * ldy + col0 + bj * 32); } }
            asm volatile("" ::: "memory");
#pragma unroll
            for (int mm = 0; mm < MB; ++mm) { const int m = mb + mm, row = u.pm * BM + ai * HALF + wr * 64 + m * 16 + fr; float ss = 0.f;
#pragma unroll
                for (int bj = 0; bj < 2; ++bj) { f32x4 x0, x1; const int col = col0 + bj * 32;
                    if constexpr (IN32) { x0 = xf[mm][bj][0]; x1 = xf[mm][bj][1]; }
                    else { const u32x4 w = xw[mm][bj];
                        x0 = (f32x4){__uint_as_float(w.x << 16), __uint_as_float(w.x & 0xffff0000u), __uint_as_float(w.y << 16), __uint_as_float(w.y & 0xffff0000u)};
                        x1 = (f32x4){__uint_as_float(w.z << 16), __uint_as_float(w.z & 0xffff0000u), __uint_as_float(w.w << 16), __uint_as_float(w.w & 0xffff0000u)}; }
                    x0 += acc[ai][bj][m][0]; x1 += acc[ai][bj][m][1];
                    if (xout32) { float* p = xout32 + (size_t)row * ldc + col; __builtin_nontemporal_store(x0, (f32x4*)p); __builtin_nontemporal_store(x1, (f32x4*)(p + 4)); }
                    else { u32x4 w; w.x = cvt_pk_bf16(x0[0], x0[1]); w.y = cvt_pk_bf16(x0[2], x0[3]); w.z = cvt_pk_bf16(x1[0], x1[1]); w.w = cvt_pk_bf16(x1[2], x1[3]); *(u32x4*)(yb + (size_t)row * ldy + col) = w; }
                    ss += ((x0[0] * x0[0] + x0[1] * x0[1]) + (x0[2] * x0[2] + x0[3] * x0[3])) + ((x1[0] * x1[0] + x1[1] * x1[1]) + (x1[2] * x1[2] + x1[3] * x1[3]));
                    }
                ss += __shfl_xor(ss, 16); ss += __shfl_xor(ss, 32);
                if (fq == 0) rowss[(size_t)row * 32 + u.pn * 4 + wc] = ss; }
        }
    }
    __device__ __forceinline__ void operator()(const f32x4 (&acc)[2][2][4][2], const Unit& u, int wr, int wc, int fr, int fq) const {
        if (xin32) run<true>(acc, u, wr, wc, fr, fq); else run<false>(acc, u, wr, wc, fr, fq);
    }
};
template <class Epi, class Sched, bool ALIGN_EPI = false, bool SP2 = false>
__device__ __forceinline__ void gemm_phase(PG8_LAS unsigned char* lds, const Gemm g, const Sched& S, const Epi& E, const int wid) {
    const int lane = fresh_lane(), tid = wid * 64 + lane, wr = wid >> 2, wc = wid & 3, fr = lane & 15, fq = lane >> 4;
    const int K = g.K, nt = K / BK;
    unsigned voffA[2], voffB[2];
#pragma unroll
    for (int i = 0; i < 2; ++i) { int R, C; stage_rc(tid * 16 + i * 8192, R, C); const int Rb = Epi::PERM ? ((Epi::WIDE ? 2 * (R & ~31) : (R & ~31)) + perm32(R & 31)) : R;
        voffA[i] = (unsigned)(R * g.lda + C) * 2u; voffB[i] = (unsigned)(Rb * g.ldb + C) * 2u; }
    const size_t kstep = (size_t)(BK * 2);
    const size_t hstepA = (size_t)HALF * g.lda * 2, hstepB = (size_t)(Epi::WIDE ? 32 : HALF) * g.ldb * 2;
    const size_t tstepA = 2 * hstepA, tstepB = (size_t)BM * g.ldb * 2;
    const unsigned ldsw = (unsigned)wid * 1024u;
    const int aoff = lds_byte(wr * 64 + fr, fq * 8), boff = lds_byte(wc * 32 + fr, fq * 8);
#define PG8_SA(b, h) (((b) * 2 + (h)) * HTB)
#define PG8_SB(b, h) ((4 + (b) * 2 + (h)) * HTB)
#define PG8_STAGE(bufoff, gbase, voff) do { _Pragma("unroll") for (int _i = 0; _i < 2; ++_i) \
        __builtin_amdgcn_global_load_lds((const unsigned*)((const char*)(gbase) + (voff)[_i]), (PG8_LAS unsigned*)(lds + (bufoff) + ldsw + _i * 8192), 16, 0, 0); } while (0)
#define PG8_LDA(dst, b, h) do { _Pragma("unroll") for (int m = 0; m < 4; ++m) _Pragma("unroll") for (int k = 0; k < 2; ++k) dst[m][k] = *(const PG8_LAS bf16x8*)(lds + PG8_SA(b, h) + aoff + m * 2048 + k * 1024); } while (0)
#define PG8_LDB(dst, b, h) do { _Pragma("unroll") for (int n = 0; n < 2; ++n) _Pragma("unroll") for (int k = 0; k < 2; ++k) dst[n][k] = *(const PG8_LAS bf16x8*)(lds + PG8_SB(b, h) + boff + n * 2048 + k * 1024); } while (0)
#define PG8_MMA(ai, bj, At, Bt) do { __builtin_amdgcn_s_setprio(1); _Pragma("unroll") for (int m = 0; m < 4; ++m) _Pragma("unroll") for (int n = 0; n < 2; ++n) _Pragma("unroll") for (int k = 0; k < 2; ++k) \
        acc[ai][bj][m][n] = __builtin_amdgcn_mfma_f32_16x16x32_bf16(Bt[n][k], At[m][k], acc[ai][bj][m][n], 0, 0, 0); __builtin_amdgcn_s_setprio(0); } while (0)
#define PG8_WAIT_V(n) asm volatile("s_waitcnt vmcnt(" #n ")" ::: "memory")
#define PG8_WAIT_L(n) asm volatile("s_waitcnt lgkmcnt(" #n ")" ::: "memory")
#define PG8_BAR __builtin_amdgcn_s_barrier()
#define PG8_SCHED __builtin_amdgcn_sched_barrier(0)
    Unit cur, nxt; int ui = 0;
    if (!S.next(0, cur)) return;
    f32x4 acc[2][2][4][2];
#pragma unroll
    for (int a = 0; a < 2; ++a)
#pragma unroll
        for (int b = 0; b < 2; ++b)
#pragma unroll
            for (int m = 0; m < 4; ++m)
#pragma unroll
                for (int n = 0; n < 2; ++n) acc[a][b][m][n] = (f32x4){0.f, 0.f, 0.f, 0.f};
    bf16x8 At[4][2], B0[2][2], B1[2][2];
    const char* cA = (const char*)g.A + (size_t)cur.pm * tstepA; const char* cB = (const char*)g.Bt + (size_t)cur.pn * tstepB;
    S.a_ready(cur);
    if constexpr (SP2) {
        PG8_STAGE(PG8_SB(0, 0), cB, voffB); PG8_STAGE(PG8_SB(0, 1), cB + hstepB, voffB); PG8_STAGE(PG8_SA(0, 0), cA, voffA); PG8_STAGE(PG8_SA(0, 1), cA + hstepA, voffA);
        if (wr == 1) PG8_BAR;
        PG8_WAIT_V(2); PG8_BAR;
        PG8_STAGE(PG8_SB(1, 0), cB + kstep, voffB); PG8_STAGE(PG8_SA(1, 0), cA + kstep, voffA); PG8_STAGE(PG8_SB(1, 1), cB + hstepB + kstep, voffB);
        PG8_WAIT_V(6); PG8_BAR;
    } else {
        PG8_STAGE(PG8_SB(0, 0), cB, voffB); PG8_STAGE(PG8_SA(0, 0), cA, voffA); PG8_STAGE(PG8_SB(0, 1), cB + hstepB, voffB); PG8_STAGE(PG8_SA(0, 1), cA + hstepA, voffA);
        if (wr == 1) PG8_BAR;
        PG8_WAIT_V(4); PG8_BAR;
        PG8_STAGE(PG8_SB(1, 0), cB + kstep, voffB); PG8_STAGE(PG8_SA(1, 0), cA + kstep, voffA); PG8_STAGE(PG8_SB(1, 1), cB + hstepB + kstep, voffB);
        PG8_WAIT_V(6); PG8_BAR;
    }
    for (;;) {
        const bool has_next = S.next(ui + 1, nxt);
        const char* nA = has_next ? (const char*)g.A + (size_t)nxt.pm * tstepA : cA; const char* nB = has_next ? (const char*)g.Bt + (size_t)nxt.pn * tstepB : cB;
        for (int t = 0; t < nt; t += 2) {
            const bool last = (t == nt - 2);
            const char* a1 = cA + (size_t)(t + 1) * kstep;
            const char* a2 = last ? nA : cA + (size_t)(t + 2) * kstep; const char* b2 = last ? nB : cB + (size_t)(t + 2) * kstep;
            const char* a3 = a2 + kstep; const char* b3 = b2 + kstep;
            if (last && has_next) S.a_ready(nxt);
            if constexpr (SP2) {
            PG8_LDB(B0, 0, 0); PG8_LDB(B1, 0, 1); PG8_SCHED; PG8_LDA(At, 0, 0); PG8_STAGE(PG8_SA(1, 1), a1 + hstepA, voffA);
            PG8_WAIT_V(8); PG8_WAIT_L(0); PG8_BAR; PG8_MMA(0, 0, At, B0); PG8_MMA(0, 1, At, B1); PG8_BAR; PG8_SCHED;
            PG8_LDA(At, 0, 1); PG8_STAGE(PG8_SB(0, 0), b2, voffB); PG8_STAGE(PG8_SB(0, 1), b2 + hstepB, voffB); PG8_STAGE(PG8_SA(0, 0), a2, voffA);
            PG8_WAIT_V(8); PG8_WAIT_L(0); PG8_BAR; PG8_MMA(1, 0, At, B0); PG8_MMA(1, 1, At, B1); PG8_BAR; PG8_SCHED;
            PG8_LDB(B0, 1, 0); PG8_LDB(B1, 1, 1); PG8_SCHED; PG8_LDA(At, 1, 0); PG8_STAGE(PG8_SA(0, 1), a2 + hstepA, voffA);
            PG8_WAIT_V(8); PG8_WAIT_L(0); PG8_BAR; PG8_MMA(0, 0, At, B0); PG8_MMA(0, 1, At, B1); PG8_BAR; PG8_SCHED;
            PG8_LDA(At, 1, 1); PG8_STAGE(PG8_SB(1, 0), b3, voffB); PG8_STAGE(PG8_SB(1, 1), b3 + hstepB, voffB); PG8_STAGE(PG8_SA(1, 0), a3, voffA);
            PG8_WAIT_V(8); PG8_WAIT_L(0); PG8_BAR; PG8_MMA(1, 0, At, B0); PG8_MMA(1, 1, At, B1); PG8_BAR; PG8_SCHED;
            } else {
            PG8_LDB(B0, 0, 0); PG8_SCHED; PG8_LDA(At, 0, 0); PG8_STAGE(PG8_SA(1, 1), a1 + hstepA, voffA);
            PG8_WAIT_L(8); PG8_BAR; PG8_WAIT_L(0); PG8_MMA(0, 0, At, B0); PG8_BAR; PG8_SCHED;
            PG8_LDB(B1, 0, 1); PG8_STAGE(PG8_SB(0, 0), b2, voffB);
            PG8_BAR; PG8_WAIT_L(0); PG8_MMA(0, 1, At, B1); PG8_BAR;
            PG8_LDA(At, 0, 1); PG8_STAGE(PG8_SA(0, 0), a2, voffA);
            PG8_BAR; PG8_WAIT_L(0); PG8_MMA(1, 0, At, B0); PG8_BAR; PG8_SCHED;
            PG8_STAGE(PG8_SB(0, 1), b2 + hstepB, voffB);
            PG8_WAIT_V(6); PG8_BAR; PG8_MMA(1, 1, At, B1); PG8_BAR;
            PG8_LDB(B0, 1, 0); PG8_SCHED; PG8_LDA(At, 1, 0); PG8_STAGE(PG8_SA(0, 1), a2 + hstepA, voffA);
            PG8_WAIT_L(8); PG8_BAR; PG8_WAIT_L(0); PG8_MMA(0, 0, At, B0); PG8_BAR; PG8_SCHED;
            PG8_LDB(B1, 1, 1); PG8_STAGE(PG8_SB(1, 0), b3, voffB);
            PG8_BAR; PG8_WAIT_L(0); PG8_MMA(0, 1, At, B1); PG8_BAR;
            PG8_LDA(At, 1, 1); PG8_STAGE(PG8_SA(1, 0), a3, voffA);
            PG8_BAR; PG8_WAIT_L(0); PG8_MMA(1, 0, At, B0); PG8_BAR; PG8_SCHED;
            PG8_STAGE(PG8_SB(1, 1), b3 + hstepB, voffB);
            PG8_WAIT_V(6); PG8_BAR; PG8_MMA(1, 1, At, B1); PG8_BAR;
            }
        }
        if constexpr (ALIGN_EPI) { if (wr == 0) PG8_BAR; }
        if constexpr (!Epi::AFTER_DRAIN) { E(acc, cur, wr, wc, fr, fq); S.done(cur); }
        if (!has_next) break;
#pragma unroll
        for (int a = 0; a < 2; ++a)
#pragma unroll
            for (int b = 0; b < 2; ++b)
#pragma unroll
                for (int m = 0; m < 4; ++m)
#pragma unroll
                    for (int n = 0; n < 2; ++n) acc[a][b][m][n] = (f32x4){0.f, 0.f, 0.f, 0.f};
        cur = nxt; cA = nA; cB = nB; ++ui;
        if constexpr (ALIGN_EPI) { if (wr == 1) PG8_BAR; }
    }
    PG8_WAIT_V(0);
    if constexpr (!ALIGN_EPI) { if (wr == 0) PG8_BAR; }
    PG8_BAR;
    if constexpr (Epi::AFTER_DRAIN) { E.fused(acc, cur, wr, wc, fr, fq, lds, wid, lane); S.done(cur); }
#undef PG8_SA
#undef PG8_SB
#undef PG8_STAGE
#undef PG8_LDA
#undef PG8_LDB
#undef PG8_MMA
#undef PG8_WAIT_V
#undef PG8_WAIT_L
#undef PG8_BAR
#undef PG8_SCHED
}
}
#define GAS __attribute__((address_space(1)))
#define LAS __attribute__((address_space(3)))
typedef unsigned short bf16;
typedef unsigned v4u __attribute__((ext_vector_type(4)));
typedef float f32x4 __attribute__((ext_vector_type(4)));
typedef short bf16x8 __attribute__((ext_vector_type(8)));
typedef GAS unsigned gu32;
typedef GAS unsigned long long gu64;
#define RLX_AGENT __ATOMIC_RELAXED, __HIP_MEMORY_SCOPE_AGENT
#define LDS_WAIT() asm volatile("s_waitcnt lgkmcnt(0)" ::: "memory")
#define VM_WAIT() asm volatile("s_waitcnt vmcnt(0)" ::: "memory")
__device__ __forceinline__ unsigned long long rt() { return __builtin_amdgcn_s_memrealtime(); }
__device__ __forceinline__ unsigned f2bf(float f) { unsigned u = __builtin_bit_cast(unsigned, f); return (u + 0x7fffu + ((u >> 16) & 1u)) >> 16; }
__device__ __forceinline__ unsigned pk2(float lo, float hi) { return f2bf(lo) | (f2bf(hi) << 16); }

#define XB_TMO      128
#define XB_XCNT(j)  (256  + 64 * (j))
#define XB_XSUB(j)  (1280 + 64 * (j))
#define XB_XGEN(j)  (2304 + 64 * (j))
#define XB_TOP      3328
#define XB_TOPGEN   3392
#define XCD_BAR_WORDS 3456
#define XB_SPIN_CAP (1u << 18)

__device__ __forceinline__ unsigned xb_ld(unsigned* p)              { return __hip_atomic_load(p, __ATOMIC_RELAXED, __HIP_MEMORY_SCOPE_AGENT); }
__device__ __forceinline__ unsigned xb_add(unsigned* p, unsigned v) { return __hip_atomic_fetch_add(p, v, __ATOMIC_RELAXED, __HIP_MEMORY_SCOPE_AGENT); }
__device__ __forceinline__ unsigned xb_xcc_id() { return (unsigned)__builtin_amdgcn_s_getreg((3 << 11) | 20) & 0xFu; }
#define XB_SPIN(cond, bar) do { unsigned _sp = 0; while (cond) { __builtin_amdgcn_s_sleep(1); \
    if ((++_sp & 255u) == 0u) { if (xb_ld(&(bar)[XB_TMO])) break; if (_sp > XB_SPIN_CAP) { atomicAdd(&(bar)[XB_TMO], 1u); break; } } } } while (0)

struct XcdBarrier {
    unsigned* bar; unsigned x;
    volatile LAS unsigned* st;
};

__device__ __forceinline__ XcdBarrier xcd_barrier_post(unsigned* bar, volatile LAS unsigned* st, const bool leader  ) {
    XcdBarrier b; b.bar = bar; b.x = xb_xcc_id(); b.st = st;
    if (leader) (void)xb_add(&bar[XB_XCNT(b.x)], 1u);
    return b;
}
__device__ __forceinline__ void xcd_barrier_complete(unsigned* bar, unsigned x, unsigned& nloc, unsigned& nx) {
    const unsigned G = gridDim.x * gridDim.y * gridDim.z;
    unsigned sum, cnt, mine, sp = 0u;
    for (;;) {
        sum = 0u; cnt = 0u; mine = 0u;
#pragma unroll
        for (unsigned j = 0; j < 16; ++j) { const unsigned c = xb_ld(&bar[XB_XCNT(j)]); sum += c; cnt += (c > 0u) ? 1u : 0u; mine = (j == x) ? c : mine; }
        if (sum == G) break;
        __builtin_amdgcn_s_sleep(1);
        if ((++sp & 255u) == 0u) { if (xb_ld(&bar[XB_TMO])) break; if (sp > XB_SPIN_CAP) { atomicAdd(&bar[XB_TMO], 1u); break; } }
    }
    nloc = mine > 0u ? mine : 1u; nx = cnt > 0u ? cnt : 1u;
}

__device__ __forceinline__ void xcd_barrier(const XcdBarrier& b, const bool leader  ) {
    asm volatile("s_waitcnt vmcnt(0)" ::: "memory");
    __syncthreads();
    if (leader) {
        unsigned* bar = b.bar;
        __builtin_amdgcn_s_waitcnt(0);
        unsigned nloc = b.st[0], nx = b.st[1];
        if (nloc == 0u) { xcd_barrier_complete(bar, b.x, nloc, nx); b.st[0] = nloc; b.st[1] = nx; }
        const unsigned old = xb_add(&bar[XB_XSUB(b.x)], 1u);
        const unsigned gen = old / nloc;
        if (old + 1u == (gen + 1u) * nloc) {
            __builtin_amdgcn_fence(__ATOMIC_RELEASE, "agent");
            asm volatile("s_waitcnt vmcnt(0)" ::: "memory");
            const unsigned og = xb_add(&bar[XB_TOP], 1u);
            const unsigned tg = og / nx;
            if (og + 1u == (tg + 1u) * nx) xb_add(&bar[XB_TOPGEN], 1u);
            else XB_SPIN(xb_ld(&bar[XB_TOPGEN]) == tg, bar);
            __builtin_amdgcn_fence(__ATOMIC_ACQUIRE, "agent");
            xb_add(&bar[XB_XGEN(b.x)], 1u);
            asm volatile("s_waitcnt vmcnt(0)" ::: "memory");
        } else {
            XB_SPIN(xb_ld(&bar[XB_XGEN(b.x)]) == gen, bar);
            __builtin_amdgcn_fence(__ATOMIC_ACQUIRE, "agent");
            asm volatile("s_waitcnt vmcnt(0)" ::: "memory");
        }
    }
    __syncthreads();
}

constexpr int NWAVES = 8;
constexpr int DM = 2048, SEQ = 16384, DEPTH = 4, DB = 8, DS = 32, PAST = 1024;
constexpr int MS = DB * DS;
constexpr int M = SEQ + MS;
constexpr int SKEYS = PAST + DS;
constexpr int NKR = SEQ + DB * SKEYS;
constexpr int NKRP = NKR + 128;
constexpr int NIN = 3908, NPROJ = 4096;
constexpr int DFF = 5632, NQC = 768, NKV = 1024, MIXW = 1536, HD = 128, QKD = 192;
constexpr int LDX = DM + 128, LDMIX = MIXW + 128, LDH = DFF + 128, LDCQ = 512 + 128, LDCKV = 256 + 128;
constexpr float EPS = 1e-6f, LOG2E = 1.4426950408889634f, LN2 = 0.6931471805599453f;
constexpr float QS_A = 0.08838834764831845f * LOG2E;
constexpr float QS_B = 0.08838834764831845f;
constexpr float QS_C = 0.07216878364870322f * LOG2E;
constexpr size_t O_Y = 0;
constexpr size_t O_FKP = O_Y + (size_t)M * DM;
constexpr size_t O_FVP = O_FKP + (size_t)DEPTH * SEQ * 512;
constexpr size_t O_FLP = O_FVP + (size_t)DEPTH * SEQ * 512;
constexpr size_t O_SKP = O_FLP + (size_t)DEPTH * SEQ * 4;
constexpr size_t O_SVP = O_SKP + (size_t)DEPTH * SEQ * 512;
constexpr size_t O_CKP = O_SVP + (size_t)DEPTH * SEQ * 512;
constexpr size_t O_KRP = O_CKP + (size_t)DEPTH * SEQ * 256;
constexpr size_t O_FKS = O_KRP + (size_t)DEPTH * SEQ * 64;
constexpr size_t O_FVS = O_FKS + (size_t)DEPTH * MS * 512;
constexpr size_t O_FLS = O_FVS + (size_t)DEPTH * MS * 512;
constexpr size_t O_SKS = O_FLS + (size_t)DEPTH * MS * 4;
constexpr size_t O_SVS = O_SKS + (size_t)DEPTH * MS * 512;
constexpr size_t O_CKS = O_SVS + (size_t)DEPTH * MS * 512;
constexpr size_t O_KRS = O_CKS + (size_t)DEPTH * MS * 256;
constexpr size_t O_END = O_KRS + (size_t)DEPTH * MS * 64;
static_assert(O_END == 191959040ull, "d_out size");
constexpr size_t MiB = 1u << 20;
constexpr size_t WS_CTL = 0, CTL_ZERO_BYTES = 1 * MiB;
constexpr size_t WS_W = 2 * MiB, W_LAYER = 96 * MiB;
constexpr size_t WO_IN = 0, WO_UQ = 17 * MiB, WO_UKV = 18 * MiB, WO_OUT = 19 * MiB, WO_GU = 26 * MiB, WO_DOWN = 73 * MiB;
constexpr size_t WS_ROPE = WS_W + DEPTH * W_LAYER;
constexpr size_t WS_XN = WS_ROPE + 4 * MiB;
constexpr size_t WS_RSS = WS_XN + 70 * MiB;
constexpr size_t WS_QA = WS_RSS + 3 * MiB, WS_QB = WS_QA + 17 * MiB, WS_CQ = WS_QB + 17 * MiB;
constexpr size_t WS_KA = WS_CQ + 21 * MiB, WS_VA = WS_KA + 25 * MiB, WS_KB = WS_VA + 25 * MiB, WS_VB = WS_KB + 25 * MiB;
constexpr size_t WS_CKVN = WS_VB + 25 * MiB;
constexpr size_t WS_KROPE = WS_CKVN + 19 * MiB;
constexpr size_t WS_LOGF = WS_KROPE + 7 * MiB;
constexpr size_t WS_FBIAS = WS_LOGF + 1 * MiB;
constexpr size_t WS_QN = WS_FBIAS + 1 * MiB;
constexpr size_t WS_QC = WS_QN + 1 * MiB;
constexpr size_t WS_KC = WS_QC + 25 * MiB;
constexpr size_t WS_ATT = WS_KC + 37 * MiB;
constexpr size_t WS_MIX = WS_ATT + 49 * MiB;
constexpr size_t WS_R = WS_MIX + 53 * MiB;
constexpr size_t WS_PROJ = WS_R, WS_QCR = WS_R + 130 * MiB, WS_KVR = WS_QCR + 25 * MiB;
constexpr size_t WS_H = WS_R;
constexpr size_t WS_PO = WS_R + 204 * MiB;
constexpr size_t WS_PML = WS_PO + 64 * MiB;
constexpr size_t WS_RSSS = WS_PML + 2 * MiB;
constexpr size_t WS_YB = WS_RSSS + 1 * MiB;
constexpr size_t WS_KRSS = WS_YB + 64 * MiB;
constexpr size_t WS_CQSS = WS_KRSS + 1 * MiB;
constexpr size_t WS_END = WS_CQSS + 2 * MiB;
static_assert((size_t)M * LDX * 2 <= 70 * MiB && (size_t)M * 32 * 4 <= 3 * MiB && (size_t)M * 512 * 2 <= 17 * MiB && (size_t)M * LDCQ * 2 <= 21 * MiB && (size_t)NKRP * 512 * 2 <= 25 * MiB, "ws map 1");
static_assert((size_t)NKRP * LDCKV * 2 <= 19 * MiB && (size_t)NKRP * 64 * 4 <= 7 * MiB && (size_t)NKRP * 16 <= 1 * MiB && (size_t)M * 768 * 2 <= 25 * MiB && (size_t)NKRP * 768 * 2 <= 37 * MiB, "ws map 2");
static_assert((size_t)M * 1536 * 2 <= 49 * MiB && (size_t)M * LDMIX * 2 <= 53 * MiB && (size_t)M * 4096 * 2 <= 130 * MiB && (size_t)NKRP * 1024 * 2 <= 49 * MiB && (size_t)M * LDH * 2 <= 204 * MiB, "ws map 3");
static_assert((size_t)NPROJ * LDX * 2 <= 17 * MiB && (size_t)NQC * LDCQ * 2 <= MiB && (size_t)NKV * LDCKV * 2 <= MiB && (size_t)DM * LDMIX * 2 <= 7 * MiB && (size_t)2 * DFF * LDX * 2 <= 47 * MiB && (size_t)DM * LDH * 2 <= 23 * MiB, "ws map 4");
constexpr int CW_TMO = 0, CW_CODE = 1, CW_BAR = 4096, CW_AQ = 8192, CW_KMAX = 12288;
constexpr int RING_OFF = 0, RING_BYTES = 131072;
constexpr int LDSCTL_OFF = RING_BYTES, MISC_OFF = LDSCTL_OFF + 320;
constexpr int LDS_BYTES = 147456;
constexpr int RSTAB_OFF = RING_BYTES + 1024 + 8192;
static_assert(RSTAB_OFF + 4096 + 32 <= LDS_BYTES, "LDS map");

typedef float f32x2 __attribute__((ext_vector_type(2)));
__device__ __forceinline__ unsigned pkbf(float lo, float hi) { unsigned r; asm("v_cvt_pk_bf16_f32 %0, %1, %2" : "=v"(r) : "v"(lo), "v"(hi)); return r; }
__device__ __forceinline__ void unpack8(v4u w, float* x) {
    x[0] = __uint_as_float(w.x << 16); x[1] = __uint_as_float(w.x & 0xffff0000u); x[2] = __uint_as_float(w.y << 16); x[3] = __uint_as_float(w.y & 0xffff0000u);
    x[4] = __uint_as_float(w.z << 16); x[5] = __uint_as_float(w.z & 0xffff0000u); x[6] = __uint_as_float(w.w << 16); x[7] = __uint_as_float(w.w & 0xffff0000u); }
__device__ __forceinline__ v4u pack8(const float* y) { v4u w; w.x = pkbf(y[0], y[1]); w.y = pkbf(y[2], y[3]); w.z = pkbf(y[4], y[5]); w.w = pkbf(y[6], y[7]); return w; }
__device__ __forceinline__ void ld8f(const float* p, float* x) { const f32x4 a = *(const f32x4*)p, b = *(const f32x4*)(p + 4); x[0] = a[0]; x[1] = a[1]; x[2] = a[2]; x[3] = a[3]; x[4] = b[0]; x[5] = b[1]; x[6] = b[2]; x[7] = b[3]; }
__device__ __forceinline__ void st8f(float* p, const float* x) { *(f32x4*)p = (f32x4){x[0], x[1], x[2], x[3]}; *(f32x4*)(p + 4) = (f32x4){x[4], x[5], x[6], x[7]}; }
__device__ __forceinline__ void st8f_nt(float* p, const float* x) { __builtin_nontemporal_store((f32x4){x[0], x[1], x[2], x[3]}, (f32x4*)p); __builtin_nontemporal_store((f32x4){x[4], x[5], x[6], x[7]}, (f32x4*)(p + 4)); }
__device__ __forceinline__ float sumsq8(const float* x) { return ((x[0] * x[0] + x[1] * x[1]) + (x[2] * x[2] + x[3] * x[3])) + ((x[4] * x[4] + x[5] * x[5]) + (x[6] * x[6] + x[7] * x[7])); }
__device__ __forceinline__ float wsum16(float v) { v += __shfl_xor(v, 1); v += __shfl_xor(v, 2); v += __shfl_xor(v, 4); v += __shfl_xor(v, 8); return v; }
__device__ __forceinline__ float wsum32(float v) { v = wsum16(v); v += __shfl_xor(v, 16); return v; }
__device__ __forceinline__ float wsum64(float v) { v = wsum32(v); v += __shfl_xor(v, 32); return v; }
enum { I_XP = 0, I_XS, I_CFK, I_CFV, I_CFL, I_CSK, I_CSV, I_CCKV, I_CKR, I_NMIX, I_WIN, I_FBIAS, I_FQN, I_FKN, I_QAN, I_WUQ, I_KVAN, I_WUKV, I_QN, I_KN, I_ONA, I_ONB, I_ONC, I_WOUT, I_NFFN, I_WGU, I_WDOWN, N_INPUTS };
struct KArgs { const float* in[N_INPUTS]; float* out; unsigned char* ws; int ph_lo, ph_hi; };
static_assert(sizeof(KArgs) == N_INPUTS * 8 + 8 + 8 + 8, "KArgs has no padding");

template <int MAT> __device__ __forceinline__ int srccol(int n) {
    if (MAT == 0) { if (n < 1536) return n; if (n < 3904) return n + 4; if (n < 3908) return 1536 + (n - 3904); return -1; }
    if (MAT == 1) { const int pn = n >> 8, half = (n >> 7) & 1, j = n & 127; return half * DFF + pn * 128 + j; }
    return n;
}
__device__ __forceinline__ void p0_transpose_item(const float* W, int Nsrc, int Ndst, bf16* WT, int ldw, int mat, int item, int lane, const float* gain) {
    const int nblk = Ndst >> 6, kb = item / nblk, nb = item - kb * nblk, n = 64 * nb + 4 * (lane & 15), k = 64 * kb + 16 * (lane >> 4);
    const int sc0 = srccol<0>(n), sc1 = srccol<1>(n), sc = mat == 0 ? sc0 : mat == 1 ? sc1 : n;
    f32x4 v[16];
    const float* src = W + (size_t)k * Nsrc + (sc >= 0 ? sc : 0);
#pragma unroll
    for (int i = 0; i < 16; ++i) v[i] = __builtin_nontemporal_load((const f32x4*)(src + (size_t)i * Nsrc));
    if (sc < 0) {
#pragma unroll
        for (int i = 0; i < 16; ++i) v[i] = (f32x4){0.f, 0.f, 0.f, 0.f}; }
    if (gain) { const f32x4 g0 = *(const f32x4*)(gain + k), g1 = *(const f32x4*)(gain + k + 4), g2 = *(const f32x4*)(gain + k + 8), g3 = *(const f32x4*)(gain + k + 12);
#pragma unroll
        for (int i = 0; i < 4; ++i) { v[i] *= g0[i]; v[4 + i] *= g1[i]; v[8 + i] *= g2[i]; v[12 + i] *= g3[i]; } }
    bf16* dst = WT + (size_t)n * ldw + k;
#pragma unroll
    for (int j = 0; j < 4; ++j) { v4u o0, o1;
        o0.x = pkbf(v[0][j], v[1][j]); o0.y = pkbf(v[2][j], v[3][j]); o0.z = pkbf(v[4][j], v[5][j]); o0.w = pkbf(v[6][j], v[7][j]);
        o1.x = pkbf(v[8][j], v[9][j]); o1.y = pkbf(v[10][j], v[11][j]); o1.z = pkbf(v[12][j], v[13][j]); o1.w = pkbf(v[14][j], v[15][j]);
        *(GAS v4u*)(dst + (size_t)j * ldw) = o0; *(GAS v4u*)(dst + (size_t)j * ldw + 8) = o1; }
}
constexpr int CI_IN = (DM / 64) * (NPROJ / 64), CI_UQ = (512 / 64) * (NQC / 64), CI_UKV = (256 / 64) * (NKV / 64), CI_OUT = (MIXW / 64) * (DM / 64),
              CI_GU = (DM / 64) * (2 * DFF / 64), CI_DN = (DFF / 64) * (DM / 64), CI_LAYER = CI_IN + CI_UQ + CI_UKV + CI_OUT + CI_GU + CI_DN;
constexpr int CONV_PER_UNIT = 24, NCONV = (CI_LAYER + CONV_PER_UNIT - 1) / CONV_PER_UNIT;
__device__ __forceinline__ void p0_conv_item(const KArgs& a, int l, int r, int lane) {
    const float* W = a.in[I_WIN] + (size_t)l * DM * NIN; int Nsrc = NIN, Ndst = NPROJ, ldw = LDX, mat = 0; size_t wo = WO_IN;
    if (r >= CI_IN) { r -= CI_IN; W = a.in[I_WUQ] + (size_t)l * 512 * NQC; Nsrc = NQC; Ndst = NQC; ldw = LDCQ; mat = 2; wo = WO_UQ;
        if (r >= CI_UQ) { r -= CI_UQ; W = a.in[I_WUKV] + (size_t)l * 256 * NKV; Nsrc = NKV; Ndst = NKV; ldw = LDCKV; wo = WO_UKV;
            if (r >= CI_UKV) { r -= CI_UKV; W = a.in[I_WOUT] + (size_t)l * MIXW * DM; Nsrc = DM; Ndst = DM; ldw = LDMIX; wo = WO_OUT;
                if (r >= CI_OUT) { r -= CI_OUT; W = a.in[I_WGU] + (size_t)l * DM * 2 * DFF; Nsrc = 2 * DFF; Ndst = 2 * DFF; ldw = LDX; mat = 1; wo = WO_GU;
                    if (r >= CI_GU) { r -= CI_GU; W = a.in[I_WDOWN] + (size_t)l * DFF * DM; Nsrc = DM; Ndst = DM; ldw = LDH; mat = 2; wo = WO_DOWN; } } } } }
    p0_transpose_item(W, Nsrc, Ndst, (bf16*)(a.ws + WS_W + (size_t)l * W_LAYER + wo), ldw, mat, r, lane, mat == 0 ? a.in[I_NMIX] + l * DM : mat == 1 ? a.in[I_NFFN] + l * DM : nullptr);
}
__device__ __forceinline__ void p0_prologue(const KArgs& a, LAS unsigned char* lds, int gw, int NGW, int lane, int wave) {
    unsigned char* ws = a.ws;
    for (int it = gw; it < (CONV_IN_E ? 1 : DEPTH) * CI_LAYER; it += NGW) { const int l = it / CI_LAYER; p0_conv_item(a, l, it - l * CI_LAYER, lane); }
    bf16* XN = (bf16*)(ws + WS_XN); float* RSS = (float*)(ws + WS_RSS);
    for (int r = gw; r < M; r += NGW) {
        const float* xr = (r < SEQ ? a.in[I_XP] + (size_t)r * DM : a.in[I_XS] + (size_t)(r - SEQ) * DM) + 4 * lane; float ss = 0.f;
        f32x4 vv[8], gg[8];
#pragma unroll
        for (int j = 0; j < 8; ++j) { vv[j] = *(const f32x4*)(xr + 256 * j); gg[j] = (f32x4){1.f, 1.f, 1.f, 1.f}; }
        asm volatile("" ::: "memory");
#pragma unroll
        for (int j = 0; j < 8; ++j) { const f32x4 v = vv[j], g = gg[j];
            ss += (v[0] * v[0] + v[1] * v[1]) + (v[2] * v[2] + v[3] * v[3]);
            f32x2 o; o.x = __uint_as_float(pkbf(v[0] * g[0], v[1] * g[1])); o.y = __uint_as_float(pkbf(v[2] * g[2], v[3] * g[3]));
            *(f32x2*)(XN + (size_t)r * LDX + 4 * lane + 256 * j) = o; }
        ss = wsum64(ss);
        if (lane < 32) RSS[(size_t)r * 32 + lane] = lane == 0 ? ss : 0.f;
        if (r >= SEQ) { float* rs_ = (float*)(ws + WS_RSSS) + (size_t)(r - SEQ) * 128; rs_[lane] = lane == 0 ? ss : 0.f; rs_[64 + lane] = 0.f; }
    }
    f32x2* ROPE = (f32x2*)(ws + WS_ROPE);
    for (int e = gw * 64 + lane; e < SEQ * 32; e += NGW * 64) { const int pos = e >> 5, j = e & 31;
        const float inv = exp2f(-(float)j * 0.4152410118609203f); const float ang = (float)pos * inv;
        double rv = (double)ang * 0.15915494309189535; rv -= rint(rv);
        ROPE[e] = (f32x2){__builtin_amdgcn_cosf((float)rv), __builtin_amdgcn_sinf((float)rv)}; }
    for (int e = gw * 64 + lane; e < 128 * 64; e += NGW * 64) { const int pr = NKR + (e >> 6), c = (e & 63) * 8; const v4u z = {0u, 0u, 0u, 0u};
        *(v4u*)((bf16*)(ws + WS_KA) + (size_t)pr * 512 + c) = z; *(v4u*)((bf16*)(ws + WS_VA) + (size_t)pr * 512 + c) = z;
        *(v4u*)((bf16*)(ws + WS_KB) + (size_t)pr * 512 + c) = z; *(v4u*)((bf16*)(ws + WS_VB) + (size_t)pr * 512 + c) = z;
        *(v4u*)((bf16*)(ws + WS_KC) + (size_t)pr * 768 + c) = z; if (c < 256) *(v4u*)((bf16*)(ws + WS_KC) + (size_t)pr * 768 + 512 + c) = z;
        *(v4u*)((bf16*)(ws + WS_KVR) + (size_t)pr * 1024 + c) = z; *(v4u*)((bf16*)(ws + WS_KVR) + (size_t)pr * 1024 + 512 + c) = z;
        if (c < 4 * 8) ((float*)(ws + WS_FBIAS))[(size_t)(c >> 3) * NKRP + pr] = 0.f; }
}

__device__ __forceinline__ float log_sigmoid(float v) { return fminf(v, 0.f) - log1pf(__expf(-fabsf(v))); }
struct PbGains { float gq[8], gk[8], gqa[8], gkv[8]; f32x4 fb; };
__device__ __forceinline__ void pb_token_row(const KArgs& a, int l, int r, int lane, const v4u (&w)[8], const PbGains& G_, float& kmA, float& kmB) {
    unsigned char* ws = a.ws; float* out = a.out;
    const bool smp = r >= SEQ; const int rs_ = r - SEQ;
    const int kr = smp ? SEQ + (rs_ >> 5) * SKEYS + PAST + (rs_ & 31) : r;
    const size_t orow = smp ? (size_t)l * MS + rs_ : (size_t)l * SEQ + r;
    float x[8], y[8];
    { unpack8(w[0], x); const float rs = 1.0f / sqrtf(wsum16(sumsq8(x)) * (1.f / 128.f) + EPS);
#pragma unroll
      for (int i = 0; i < 8; ++i) y[i] = x[i] * rs * G_.gq[i] * QS_A;
      *(v4u*)((bf16*)(ws + WS_QA) + (size_t)r * 512 + lane * 8) = pack8(y); }
    { unpack8(w[1], x); const float rs = 1.0f / sqrtf(wsum16(sumsq8(x)) * (1.f / 128.f) + EPS);
#pragma unroll
      for (int i = 0; i < 8; ++i) y[i] = x[i] * rs * G_.gk[i];
      st8f_nt(out + (smp ? O_FKS : O_FKP) + orow * 512 + lane * 8, y); *(v4u*)((bf16*)(ws + WS_KA) + (size_t)kr * 512 + lane * 8) = pack8(y);
      kmA = fmaxf(kmA, wsum16(sumsq8(y))); }
    if (smp) {
    { unpack8(w[2], x); st8f_nt(out + O_FVS + orow * 512 + lane * 8, x); *(v4u*)((bf16*)(ws + WS_VA) + (size_t)kr * 512 + lane * 8) = w[2]; }
    { unpack8(w[3], x);
#pragma unroll
      for (int i = 0; i < 8; ++i) y[i] = x[i] * QS_B;
      *(v4u*)((bf16*)(ws + WS_QB) + (size_t)r * 512 + lane * 8) = pack8(y); }
    { unpack8(w[4], x); st8f_nt(out + O_SKS + orow * 512 + lane * 8, x); *(v4u*)((bf16*)(ws + WS_KB) + (size_t)kr * 512 + lane * 8) = w[4];
      kmB = fmaxf(kmB, wsum16(sumsq8(x))); }
    { unpack8(w[5], x); st8f_nt(out + O_SVS + orow * 512 + lane * 8, x); *(v4u*)((bf16*)(ws + WS_VB) + (size_t)kr * 512 + lane * 8) = w[5]; }
    }
    { unpack8(w[6], x); const float ssq = wsum64(sumsq8(x)); const float rs = FUSE_B ? 1.0f : 1.0f / sqrtf(ssq * (1.f / 512.f) + EPS);
#pragma unroll
      for (int i = 0; i < 8; ++i) y[i] = x[i] * rs * G_.gqa[i];
      *(v4u*)((bf16*)(ws + WS_CQ) + (size_t)r * LDCQ + lane * 8) = pack8(y);
      if (FUSE_B && lane < 16) ((float*)(ws + WS_CQSS))[(size_t)r * 16 + lane] = lane == 0 ? ssq : 0.f; }
    { unpack8(w[7], x);
      const float rs = 1.0f / sqrtf(wsum32(sumsq8(x)) * (1.f / 256.f) + EPS);
      if (lane < 32) {
#pragma unroll
          for (int i = 0; i < 8; ++i) y[i] = x[i] * rs * G_.gkv[i];
          st8f_nt(out + (smp ? O_CKS : O_CKP) + orow * 256 + lane * 8, y); *(v4u*)((bf16*)(ws + WS_CKVN) + (size_t)kr * LDCKV + lane * 8) = pack8(y); }
      else if (lane < 40) { st8f_nt(out + (smp ? O_KRS : O_KRP) + orow * 64 + (lane - 32) * 8, x); st8f((float*)(ws + WS_KROPE) + (size_t)kr * 64 + (lane - 32) * 8, x); }
      else if (lane == 40) { const f32x4 fb = G_.fb;
          const f32x4 lf = {log_sigmoid(x[0] + fb[0]), log_sigmoid(x[1] + fb[1]), log_sigmoid(x[2] + fb[2]), log_sigmoid(x[3] + fb[3])};
          *(f32x4*)(out + (smp ? O_FLS : O_FLP) + orow * 4) = lf; *(f32x4*)((float*)(ws + WS_LOGF) + (size_t)kr * 4) = lf; }
      { float k2 = (lane >= 32 && lane < 40) ? sumsq8(x) : 0.f; k2 += __shfl_xor(k2, 1); k2 += __shfl_xor(k2, 2); k2 += __shfl_xor(k2, 4); if (lane == 32) ((float*)(ws + WS_KRSS))[kr] = k2; }
    }
}
__device__ __forceinline__ void pb_tokens(const KArgs& a, int l, int gw, int NGW, int lane, float& kmA, float& kmB) {
    PbGains G_; ld8f(a.in[I_FQN] + l * 128 + (lane & 15) * 8, G_.gq); ld8f(a.in[I_FKN] + l * 128 + (lane & 15) * 8, G_.gk); ld8f(a.in[I_QAN] + l * 512 + lane * 8, G_.gqa);
    ld8f(a.in[I_KVAN] + l * 256 + (lane & 31) * 8, G_.gkv); G_.fb = *(const f32x4*)(a.in[I_FBIAS] + l * 4);
    const bf16* P = (const bf16*)(a.ws + WS_PROJ) + lane * 8;
    v4u cur[8], nxt[8];
    const int r0 = FUSE_B ? SEQ + gw : gw;
    if (r0 < M) {
#pragma unroll
        for (int s_ = 0; s_ < 8; ++s_) if (r0 >= SEQ || s_ < 2 || s_ > 5) cur[s_] = *(const v4u*)(P + (size_t)r0 * NPROJ + s_ * 512); }
    for (int r = r0; r < M; r += NGW) {
        const int rn = r + NGW < M ? r + NGW : r;
#pragma unroll
        for (int s_ = 0; s_ < 8; ++s_) if (rn >= SEQ || s_ < 2 || s_ > 5) nxt[s_] = *(const v4u*)(P + (size_t)rn * NPROJ + s_ * 512);
        __builtin_amdgcn_sched_barrier(0);
        pb_token_row(a, l, r, lane, cur, G_, kmA, kmB);
        __builtin_amdgcn_sched_barrier(0);
#pragma unroll
        for (int s_ = 0; s_ < 8; ++s_) cur[s_] = nxt[s_];
    }
}
__device__ __forceinline__ void pb_cache_row(const KArgs& a, int l, int cr, int lane, float& kmA, float& kmB) {
    unsigned char* ws = a.ws; const int b = cr >> 10, j = cr & 1023, kr = SEQ + b * SKEYS + j; const size_t src = (size_t)l * DB * PAST + cr;
    float x0[8], x1[8], x2[8], x3[8], x4[8];
    ld8f(a.in[I_CFK] + src * 512 + lane * 8, x0); ld8f(a.in[I_CFV] + src * 512 + lane * 8, x1); ld8f(a.in[I_CSK] + src * 512 + lane * 8, x2); ld8f(a.in[I_CSV] + src * 512 + lane * 8, x3);
    if (lane < 32) ld8f(a.in[I_CCKV] + src * 256 + lane * 8, x4); else if (lane < 40) ld8f(a.in[I_CKR] + src * 64 + (lane - 32) * 8, x4); else if (lane == 40) { const f32x4 t_ = *(const f32x4*)(a.in[I_CFL] + src * 4); x4[0] = t_[0]; x4[1] = t_[1]; x4[2] = t_[2]; x4[3] = t_[3]; }
    __builtin_amdgcn_sched_barrier(0);
    *(v4u*)((bf16*)(ws + WS_KA) + (size_t)kr * 512 + lane * 8) = pack8(x0); kmA = fmaxf(kmA, wsum16(sumsq8(x0)));
    *(v4u*)((bf16*)(ws + WS_VA) + (size_t)kr * 512 + lane * 8) = pack8(x1);
    *(v4u*)((bf16*)(ws + WS_KB) + (size_t)kr * 512 + lane * 8) = pack8(x2); kmB = fmaxf(kmB, wsum16(sumsq8(x2)));
    *(v4u*)((bf16*)(ws + WS_VB) + (size_t)kr * 512 + lane * 8) = pack8(x3);
    if (lane < 32) *(v4u*)((bf16*)(ws + WS_CKVN) + (size_t)kr * LDCKV + lane * 8) = pack8(x4);
    else if (lane < 40) st8f((float*)(ws + WS_KROPE) + (size_t)kr * 64 + (lane - 32) * 8, x4);
    else if (lane == 40) *(f32x4*)((float*)(ws + WS_LOGF) + (size_t)kr * 4) = (f32x4){x4[0], x4[1], x4[2], x4[3]};
    { float k2 = (lane >= 32 && lane < 40) ? sumsq8(x4) : 0.f; k2 += __shfl_xor(k2, 1); k2 += __shfl_xor(k2, 2); k2 += __shfl_xor(k2, 4); if (lane == 32) ((float*)(ws + WS_KRSS))[kr] = k2; }
}
__device__ __forceinline__ void scan_job(unsigned char* ws, LAS float* sm, int job, int tid, int wave, int lane) {
    const int h = job & 3, sq = job >> 2; const int krow0 = sq == 0 ? 0 : SEQ + (sq - 1) * SKEYS, n = sq == 0 ? SEQ : SKEYS, per = sq == 0 ? 32 : 3;
    const float* LOGF = (const float*)(ws + WS_LOGF) + (size_t)krow0 * 4 + h; float* FB = (float*)(ws + WS_FBIAS) + (size_t)h * NKRP + krow0;
    const int i0 = tid * per; float loc = 0.f, v_[32];
#pragma unroll
    for (int i = 0; i < 32; ++i) { v_[i] = (i < per && i0 + i < n) ? LOGF[(size_t)(i0 + i) * 4] : 0.f; loc += v_[i]; }
    float inc = loc;
#pragma unroll
    for (int o = 1; o < 64; o <<= 1) { const float t = __shfl_up(inc, o); if (lane >= o) inc += t; }
    if (lane == 63) sm[wave] = inc;
    __syncthreads();
    float run = inc - loc;
    for (int w = 0; w < wave; ++w) run += sm[w];
#pragma unroll
    for (int i = 0; i < 32; ++i) if (i < per && i0 + i < n) { run += v_[i]; FB[i0 + i] = -LOG2E * run; }
    __syncthreads();
}
template <int SRC> __device__ __forceinline__ void pd_row(const KArgs& a, int l, int r, int lane) {
    unsigned char* ws = a.ws; const int li = lane & 31, hh = lane >> 5;
    const int pos = SRC == 0 ? (r < SEQ ? r : PAST + ((r - SEQ) & 31)) : (r < SEQ ? r : (r - SEQ) % SKEYS);
    const f32x2* rope = (const f32x2*)(ws + WS_ROPE) + (size_t)pos * 32; const float* gn = a.in[SRC == 0 ? I_QN : I_KN] + l * QKD;
    const float qs = SRC == 0 ? QS_C : 1.0f;
    float x1[2][8], x2[2][8], g[8], g2[8]; f32x2 cs[8];
#pragma unroll
    for (int it = 0; it < 2; ++it) { const int head = it * 2 + hh;
        if (SRC == 0) { const bf16* src = (const bf16*)(ws + WS_QCR) + (size_t)r * NQC + head * QKD;
            if (li < 16) unpack8(*(const v4u*)(src + li * 8), x1[it]);
            else if (li < 20) { unpack8(*(const v4u*)(src + 128 + (li - 16) * 8), x1[it]); unpack8(*(const v4u*)(src + 160 + (li - 16) * 8), x2[it]); } }
        else { const bf16* src = (const bf16*)(ws + WS_KVR) + (size_t)r * NKV + head * 256; const float* kro = (const float*)(ws + WS_KROPE) + (size_t)r * 64;
            if (li < 16) unpack8(*(const v4u*)(src + li * 8), x1[it]);
            else if (li < 20) { ld8f(kro + (li - 16) * 8, x1[it]); ld8f(kro + 32 + (li - 16) * 8, x2[it]); } } }
    if (li < 16) ld8f(gn + li * 8, g);
    else if (li < 20) { ld8f(gn + 128 + (li - 16) * 8, g); ld8f(gn + 160 + (li - 16) * 8, g2);
#pragma unroll
        for (int i = 0; i < 8; ++i) cs[i] = rope[(li - 16) * 8 + i]; }
    __builtin_amdgcn_sched_barrier(0);
#pragma unroll
    for (int it = 0; it < 2; ++it) { const int head = it * 2 + hh;
        bf16* dst = (bf16*)(ws + (SRC == 0 ? WS_QC : WS_KC)) + (size_t)r * NQC + head * QKD;
        float ss = 0.f, y[8], y2[8];
        if (li < 16) ss = sumsq8(x1[it]); else if (li < 20) ss = sumsq8(x1[it]) + sumsq8(x2[it]);
        const float rs = 1.0f / sqrtf(wsum32(ss) * (1.f / 192.f) + EPS);
        if (li < 16) {
#pragma unroll
            for (int i = 0; i < 8; ++i) y[i] = x1[it][i] * rs * g[i] * qs;
            *(v4u*)(dst + li * 8) = pack8(y); }
        else if (li < 20) { const int m = li - 16;
#pragma unroll
            for (int i = 0; i < 8; ++i) { const float u1 = x1[it][i] * rs * g[i], u2 = x2[it][i] * rs * g2[i];
                y[i] = (u1 * cs[i].x - u2 * cs[i].y) * qs; y2[i] = (u2 * cs[i].x + u1 * cs[i].y) * qs; }
            *(v4u*)(dst + 128 + m * 8) = pack8(y); *(v4u*)(dst + 160 + m * 8) = pack8(y2); }
    }
}
struct PfRow { v4u w0, w1, w2, wp0, wp1, wp2, wp3; f32x2 ml0, ml1, ml2, ml3; };
__device__ __forceinline__ void pf_load(const KArgs& a, int r, int lane, PfRow& R) {
    unsigned char* ws = a.ws; const bf16* src = (const bf16*)(ws + WS_ATT) + (size_t)r * MIXW + lane * 8;
    const bool merged = r < SEQ && r >= MLA_G * 256;
    const int np = merged ? (MLA_G == 32 ? 2 : (r >> 12) + 1) : 0, head = lane >> 4;
    R.w0 = *(const v4u*)(src); R.w1 = *(const v4u*)(src + 512); R.w2 = (v4u){0u, 0u, 0u, 0u};
    if (!merged) R.w2 = *(const v4u*)(src + 1024);
#define PF_LD(p, WP, ML) if (p < np) { ML = *(const f32x2*)((const float*)(ws + WS_PML) + (((size_t)p * SEQ + r) * 4 + head) * 2); WP = *(const v4u*)((const bf16*)(ws + WS_PO) + ((size_t)p * SEQ + r) * 512 + lane * 8); }
    PF_LD(0, R.wp0, R.ml0) PF_LD(1, R.wp1, R.ml1) PF_LD(2, R.wp2, R.ml2) PF_LD(3, R.wp3, R.ml3)
#undef PF_LD
}
__device__ __forceinline__ void pf_compute(const KArgs& a, int r, int lane, const PfRow& R, const float (&g0)[8], const float (&g1)[8], const float (&g2)[8]) {
    bf16* dst = (bf16*)(a.ws + WS_MIX) + (size_t)r * LDMIX + lane * 8;
    const bool merged = r < SEQ && r >= MLA_G * 256; const int np = merged ? (MLA_G == 32 ? 2 : (r >> 12) + 1) : 0;
    float x[8], y[8];
    { unpack8(R.w0, x); const float rs = 1.0f / sqrtf(wsum64(sumsq8(x)) * (1.f / 512.f) + EPS);
#pragma unroll
      for (int i = 0; i < 8; ++i) y[i] = x[i] * rs * g0[i];
      *(v4u*)(dst) = pack8(y); }
    { unpack8(R.w1, x); const float rs = 1.0f / sqrtf(wsum64(sumsq8(x)) * (1.f / 512.f) + EPS);
#pragma unroll
      for (int i = 0; i < 8; ++i) y[i] = x[i] * rs * g1[i];
      *(v4u*)(dst + 512) = pack8(y); }
    { if (merged) { float mx = -3.0e38f, den = 0.f;
          if (0 < np) mx = fmaxf(mx, R.ml0.x); if (1 < np) mx = fmaxf(mx, R.ml1.x); if (2 < np) mx = fmaxf(mx, R.ml2.x); if (3 < np) mx = fmaxf(mx, R.ml3.x);
#pragma unroll
          for (int i = 0; i < 8; ++i) x[i] = 0.f;
#define PF_ACC(p, WP, ML) if (p < np) { const float w = __builtin_amdgcn_exp2f(ML.x - mx) * ML.y; den += w; float xp[8]; unpack8(WP, xp); _Pragma("unroll") for (int i = 0; i < 8; ++i) x[i] += w * xp[i]; }
          PF_ACC(0, R.wp0, R.ml0) PF_ACC(1, R.wp1, R.ml1) PF_ACC(2, R.wp2, R.ml2) PF_ACC(3, R.wp3, R.ml3)
#undef PF_ACC
          const float rd = 1.0f / den;
#pragma unroll
          for (int i = 0; i < 8; ++i) x[i] *= rd; }
      else unpack8(R.w2, x);
      const float rs = 1.0f / sqrtf(wsum64(sumsq8(x)) * (1.f / 512.f) + EPS);
#pragma unroll
      for (int i = 0; i < 8; ++i) y[i] = x[i] * rs * g2[i];
      *(v4u*)(dst + 1024) = pack8(y); }
}
__device__ __forceinline__ void pf_rows(const KArgs& a, int l, int gw, int NGW, int lane) {
    float g0[8], g1[8], g2[8];
    ld8f(a.in[I_ONA] + l * 512 + lane * 8, g0); ld8f(a.in[I_ONB] + l * 512 + lane * 8, g1); ld8f(a.in[I_ONC] + l * 512 + lane * 8, g2);
    for (int r = gw; r < M; r += 2 * NGW) {
        PfRow A, B; const int r2 = r + NGW; const bool two = r2 < M;
        pf_load(a, r, lane, A); if (two) pf_load(a, r2, lane, B);
        __builtin_amdgcn_sched_barrier(0);
        pf_compute(a, r, lane, A, g0, g1, g2); if (two) pf_compute(a, r2, lane, B, g0, g1, g2);
    }
}

namespace att {
typedef float f32x16 __attribute__((ext_vector_type(16)));
typedef short s16x4 __attribute__((ext_vector_type(4)));
constexpr int OFF_K = 0, OFF_V = 24576, OFF_B = 40960, BUF = 41216, WSC = 3 * BUF;
constexpr int FLG = WSC + NWAVES * 256, ATT_LDS = FLG + 64;
static_assert(ATT_LDS <= RING_BYTES, "attention LDS");
__device__ __forceinline__ int v_st(int k, int c) { const int kk = (k & ~0xC) | ((k & 4) << 1) | ((k & 8) >> 1); return ((kk >> 3) * 4 + (c >> 5)) * 512 + ((kk & 7) * 32 + (c & 31)) * 2; }
__device__ __forceinline__ int v_rd_base(int lane) { return ((lane & 3) << 3) | (((lane >> 2) & 3) << 6) | (((lane >> 4) & 1) << 5) | (((lane >> 5) & 1) << 8); }
constexpr int v_rd_off(int d0, int ks, int half) { return d0 * 512 + ks * 4096 + half * 2048; }
__device__ __forceinline__ int crow(int r, int hi) { return (r & 3) + 8 * (r >> 2) + 4 * hi; }
__device__ __forceinline__ bf16x8 mk8(s16x4 l, s16x4 h) { return (bf16x8){l[0], l[1], l[2], l[3], h[0], h[1], h[2], h[3]}; }
__device__ __forceinline__ void pv_tile(f32x16* o, unsigned vb, bf16x8 pa0, bf16x8 pa1, bf16x8 pa2, bf16x8 pa3) {
#define TRRD(dst, off) asm volatile("ds_read_b64_tr_b16 %0, %1 offset:%2" : "=&v"(dst) : "v"(vb), "i"(off) : "memory")
#define PV_D0(d0) do { s16x4 l0, l1, l2, l3, h0, h1, h2, h3; constexpr int b_ = v_rd_off(d0, 0, 0); \
        TRRD(l0, b_); TRRD(h0, b_ + 2048); TRRD(l1, b_ + 4096); TRRD(h1, b_ + 6144); TRRD(l2, b_ + 8192); TRRD(h2, b_ + 10240); TRRD(l3, b_ + 12288); TRRD(h3, b_ + 14336); \
        asm volatile("s_waitcnt lgkmcnt(0)" ::: "memory"); __builtin_amdgcn_sched_barrier(0); \
        o[d0] = __builtin_amdgcn_mfma_f32_32x32x16_bf16(pa0, mk8(l0, h0), o[d0], 0, 0, 0); \
        o[d0] = __builtin_amdgcn_mfma_f32_32x32x16_bf16(pa1, mk8(l1, h1), o[d0], 0, 0, 0); \
        o[d0] = __builtin_amdgcn_mfma_f32_32x32x16_bf16(pa2, mk8(l2, h2), o[d0], 0, 0, 0); \
        o[d0] = __builtin_amdgcn_mfma_f32_32x32x16_bf16(pa3, mk8(l3, h3), o[d0], 0, 0, 0); } while (0)
    __builtin_amdgcn_s_setprio(1); PV_D0(0); PV_D0(1); PV_D0(2); PV_D0(3); __builtin_amdgcn_s_setprio(0);
#undef PV_D0
#undef TRRD
}
__device__ __forceinline__ void glds16(const void* gsrc, unsigned lds_dst) { unsigned keep;
    asm volatile("s_mov_b32 %0, m0\n\ts_mov_b32 m0, %2\n\ts_nop 0\n\tglobal_load_lds_dwordx4 %1, off\n\ts_mov_b32 m0, %0" : "=&s"(keep) : "v"(gsrc), "s"(lds_dst) : "memory"); }
__device__ __forceinline__ void glds4(const void* gsrc, unsigned lds_dst) { unsigned keep;
    asm volatile("s_mov_b32 %0, m0\n\ts_mov_b32 m0, %2\n\ts_nop 0\n\tglobal_load_lds_dword %1, off\n\ts_mov_b32 m0, %0" : "=&s"(keep) : "v"(gsrc), "s"(lds_dst) : "memory"); }
typedef short v4i16_t __attribute__((ext_vector_type(4)));
__device__ __forceinline__ s16x4 vtr(const LAS unsigned char* p) { return __builtin_bit_cast(s16x4, __builtin_amdgcn_ds_read_tr16_b64_v4i16((LAS v4i16_t*)p)); }
__device__ __forceinline__ void pack_p(const f32x16& p0, const f32x16& p1, bf16x8& pa0, bf16x8& pa1, bf16x8& pa2, bf16x8& pa3) {
#define PK4(P, B_, OUT) do { unsigned a0 = pkbf(P[B_ + 0], P[B_ + 1]), a1 = pkbf(P[B_ + 2], P[B_ + 3]), b0 = pkbf(P[B_ + 4], P[B_ + 5]), b1 = pkbf(P[B_ + 6], P[B_ + 7]); \
        auto r0 = __builtin_amdgcn_permlane32_swap(a0, b0, false, false); auto r1 = __builtin_amdgcn_permlane32_swap(a1, b1, false, false); \
        v4u w = {r0[0], r1[0], r0[1], r1[1]}; OUT = __builtin_bit_cast(bf16x8, w); } while (0)
    PK4(p0, 0, pa0); PK4(p0, 8, pa1); PK4(p1, 0, pa2); PK4(p1, 8, pa3);
#undef PK4
}
struct UnitDesc { int h, qrow0, nq, krow0, qpos0, nkeys, t_lo, t_hi, part; };
template <int TYPE  >
__device__ __forceinline__ void attn_unit(LAS unsigned char* L, unsigned char* ws, const UnitDesc U, const float kmax, const int wid, const float* gq = nullptr) {
    constexpr int DK = TYPE == 2 ? QKD : HD, ND = DK / 16, NKC = DK / 64, CPR = DK / 8, KROWB = DK * 2;
    constexpr int QP = TYPE == 2 ? NQC : 512, KP = QP, VP = TYPE == 2 ? NKV : 512;
    const int lane = fresh_lane(), tid = wid * 64 + lane, r32 = lane & 31, hi = lane >> 5;
    const bf16* Qg = (const bf16*)(ws + (TYPE == 0 ? WS_QA : TYPE == 1 ? WS_QB : (FOLD_QC ? WS_QCR : WS_QC))) + (size_t)U.qrow0 * QP + U.h * DK;
    const bf16* Kg = (const bf16*)(ws + (TYPE == 0 ? WS_KA : TYPE == 1 ? WS_KB : WS_KC)) + (size_t)U.krow0 * KP + U.h * DK;
    const bf16* Vg = (const bf16*)(ws + (TYPE == 0 ? WS_VA : TYPE == 1 ? WS_VB : WS_KVR)) + (size_t)U.krow0 * VP + (TYPE == 2 ? U.h * 256 + 128 : U.h * HD);
    const float* FBh = (const float*)(ws + WS_FBIAS) + (size_t)U.h * NKRP + U.krow0;
    const bool wact = wid * 32 < U.nq;
    const int qlo = U.qpos0 + wid * 32, qpos = qlo + r32;
    const int NT = U.t_hi - U.t_lo;
    int kgoff[NKC], vgoff[2];
#pragma unroll
    for (int j = 0; j < NKC; ++j) { const int p = 64 * (wid + 8 * j) + lane, row = p / CPR, cpos = p % CPR, cc = CPR == 16 ? (cpos ^ (row & 15)) : ((cpos & ~7) | ((cpos ^ (row >> 1)) & 7)); kgoff[j] = row * KP + cc * 8; }
#pragma unroll
    for (int j = 0; j < 2; ++j) { const int p = 64 * (wid + 8 * j) + lane, st = p >> 5, q = p & 31, kk = ((st >> 2) << 3) | (q >> 2), c = (st & 3) * 32 + (q & 3) * 8;
        const int k = (kk & ~0xC) | ((kk & 4) << 1) | ((kk & 8) >> 1); vgoff[j] = k * VP + c; }
#define ST_DMA(t, bf) do { const int kb_ = (t) * 64; const unsigned B_ = (unsigned)__builtin_amdgcn_readfirstlane((int)(unsigned)(size_t)(L + (bf) * BUF)); \
        _Pragma("unroll") for (int j = 0; j < NKC; ++j) glds16(Kg + (size_t)kb_ * KP + kgoff[j], B_ + OFF_K + (wid + 8 * j) * 1024); \
        _Pragma("unroll") for (int j = 0; j < 2; ++j) glds16(Vg + (size_t)kb_ * VP + vgoff[j], B_ + OFF_V + (wid + 8 * j) * 1024); \
        if (TYPE == 0 && wid == 0) glds4(FBh + kb_ + lane, B_ + OFF_B); } while (0)
    constexpr int DIST = ATT_LAG ? 1 : 2;
    ST_DMA(U.t_hi - 1, 0); if (DIST == 2 && NT > 1) ST_DMA(U.t_hi - 2, 1);
    bf16x8 qr[ND];
    if (wact) {
#pragma unroll
        for (int d0 = 0; d0 < ND; ++d0) qr[d0] = *(const bf16x8*)(Qg + (size_t)(wid * 32 + r32) * QP + d0 * 16 + hi * 8);
        if constexpr (TYPE == 2 && FOLD_QC) {
            float ss = 0.f;
#pragma unroll
            for (int d0 = 0; d0 < ND; ++d0)
#pragma unroll
                for (int e = 0; e < 8; ++e) { const float f_ = __uint_as_float((unsigned)(unsigned short)qr[d0][e] << 16); ss += f_ * f_; }
            { auto rr = __builtin_amdgcn_permlane32_swap(__float_as_uint(ss), __float_as_uint(ss), false, false); ss = __uint_as_float(rr[0]) + __uint_as_float(rr[1]); }
            float rc = 1.f;
            if (FUSE_B) { const float* cs_ = (const float*)(ws + WS_CQSS) + (size_t)(U.qrow0 + wid * 32 + r32) * 16; float t_ = 0.f;
#pragma unroll
                for (int i = 0; i < 4; ++i) { const f32x4 v_ = *(const f32x4*)(cs_ + 4 * i); t_ += (v_[0] + v_[1]) + (v_[2] + v_[3]); }
                rc = 1.0f / sqrtf(t_ * (1.f / 512.f) + EPS); }
            const float rs = rc / sqrtf(ss * rc * rc * (1.f / 192.f) + EPS) * QS_C;
            const f32x2* rope = (const f32x2*)(ws + WS_ROPE) + (size_t)(U.qpos0 + wid * 32 + r32) * 32;
#pragma unroll
            for (int d0 = 0; d0 < 8; ++d0) { float g[8], y[8]; ld8f(gq + d0 * 16 + hi * 8, g);
#pragma unroll
                for (int e = 0; e < 8; ++e) y[e] = __uint_as_float((unsigned)(unsigned short)qr[d0][e] << 16) * rs * g[e];
                const v4u w_ = pack8(y); qr[d0] = __builtin_bit_cast(bf16x8, w_); }
#pragma unroll
            for (int d0 = 8; d0 < 10; ++d0) { float g1[8], g2[8], y1[8], y2[8]; ld8f(gq + d0 * 16 + hi * 8, g1); ld8f(gq + (d0 + 2) * 16 + hi * 8, g2);
#pragma unroll
                for (int e = 0; e < 8; ++e) { const f32x2 cs = rope[(d0 - 8) * 16 + hi * 8 + e];
                    const float u1 = __uint_as_float((unsigned)(unsigned short)qr[d0][e] << 16) * rs * g1[e], u2 = __uint_as_float((unsigned)(unsigned short)qr[d0 + 2][e] << 16) * rs * g2[e];
                    y1[e] = u1 * cs.x - u2 * cs.y; y2[e] = u2 * cs.x + u1 * cs.y; }
                const v4u w1_ = pack8(y1), w2_ = pack8(y2); qr[d0] = __builtin_bit_cast(bf16x8, w1_); qr[d0 + 2] = __builtin_bit_cast(bf16x8, w2_); }
        }
    } else {
#pragma unroll
        for (int d0 = 0; d0 < ND; ++d0) qr[d0] = (bf16x8){0, 0, 0, 0, 0, 0, 0, 0};
    }
    LAS float* wsc = (LAS float*)(L + WSC + wid * 256);
    constexpr bool NEGM = ATT_NEGM && TYPE != 1;
    float m_reg = NEGM ? 0.f : -1e30f, l_reg = 0.f, Rsum = 0.f; f32x16 o[4];
    f32x16 negm = (f32x16){}; bool fresh = true;
    constexpr float EXIT_FOX = -60.f, EXIT_SB = -42.f;
    float zb = 0.f; bool wdone = !wact; LAS int* flg = (LAS int*)(L + FLG);
    if (TYPE != 2 && wact) { float q2 = 0.f;
#pragma unroll
        for (int d0 = 0; d0 < ND; ++d0)
#pragma unroll
            for (int e = 0; e < 8; ++e) { const float f_ = __uint_as_float((unsigned)(unsigned short)qr[d0][e] << 16); q2 += f_ * f_; }
        { auto rr = __builtin_amdgcn_permlane32_swap(__float_as_uint(q2), __float_as_uint(q2), false, false); q2 = __uint_as_float(rr[0]) + __uint_as_float(rr[1]); }
        zb = sqrtf(q2) * kmax * 1.02f + 0.1f; }
#pragma unroll
    for (int d = 0; d < 4; ++d) o[d] = (f32x16){};
    int kbase[4];
#pragma unroll
    for (int dd = 0; dd < 4; ++dd) kbase[dd] = r32 * KROWB + (((dd * 2 + hi) ^ (CPR == 16 ? (r32 & 15) : ((r32 >> 1) & 7))) << 4);
    const unsigned vrd = (unsigned)(size_t)(L + OFF_V) + (unsigned)v_rd_base(lane);
    VM_WAIT(); __syncthreads();
    int bf = 0, bf2 = DIST;
    const bool lagw = ATT_LAG == 1 ? wid >= 4 : ATT_LAG == 2 ? (wid & 1) != 0 : false;
    bool have_prev = false; int bfp = 0; bf16x8 pa0, pa1, pa2, pa3;
    pa0 = pa1 = pa2 = pa3 = (bf16x8){0, 0, 0, 0, 0, 0, 0, 0};
    for (int i = 0; i < NT; ++i) {
        const int t = U.t_hi - 1 - i, kb = t * 64;
        if (TYPE != 2 && i > 0) { const LAS int* f_ = flg + ((i - 1) & 1) * 8; if ((f_[0] & f_[1] & f_[2] & f_[3] & f_[4] & f_[5] & f_[6] & f_[7]) != 0) break; }
        if (i + DIST < NT) ST_DMA(t - DIST, bf2);
        float bnext = 0.f; if (TYPE == 0) bnext = *(const LAS float*)(L + bf * BUF + OFF_B);
        bool act, needmask;
        if (TYPE == 0) { act = kb <= qlo + 31; needmask = kb + 63 > qlo; }
        else if (TYPE == 1) { act = kb < qlo + 31; needmask = kb + 63 >= qlo; }
        else { act = t <= (qlo >> 6); needmask = kb + 64 > U.nkeys; }
        act = act && !wdone;
        if (ATT_LAG && have_prev) { pv_tile(o, vrd + (unsigned)(bfp * BUF), pa0, pa1, pa2, pa3); have_prev = false; }
        if (ATT_PIPE && act && TYPE != 1 && !needmask) {
            LAS unsigned char* Bf = L + bf * BUF;
            f32x16 p0 = (f32x16){}, p1 = (f32x16){};
            bf16x8 kf[4]; float al0 = 1.f, al1 = 1.f, pmx = 0.f, mn_ = 0.f, ps_ = 0.f;
#define KFR(d0_, half_) (*(const LAS bf16x8*)(Bf + OFF_K + (CPR == 16 ? (kbase[(d0_) & 3] ^ (((d0_) >> 2) * 128)) : (kbase[(d0_) & 3] + ((d0_) >> 2) * 128)) + (half_) * 32 * KROWB))
#define SB0() __builtin_amdgcn_sched_barrier(0)
#define QK_MF(P, half_, j_) do { P = __builtin_amdgcn_mfma_f32_32x32x16_bf16(kf[(j_) & 3], qr[j_], P, 0, 0, 0); if ((j_) + 4 < ND) kf[(j_) & 3] = KFR((j_) + 4, half_); } while (0)
#define SMSTEP(k_, P, KOFF, AL, PA, PB) do { \
            if ((k_) == 0) { if (TYPE == 0) { _Pragma("unroll") for (int g = 0; g < 4; ++g) { const f32x4 b_ = *(const LAS f32x4*)(Bf + OFF_B + ((KOFF) + 8 * g + 4 * hi) * 4); \
                                 _Pragma("unroll") for (int e = 0; e < 4; ++e) P[4 * g + e] += b_[e]; } } } \
            else if ((k_) == 1) { pmx = fmaxf(fmaxf(fmaxf(P[0], P[1]), fmaxf(P[2], P[3])), fmaxf(fmaxf(P[4], P[5]), fmaxf(P[6], P[7]))); } \
            else if ((k_) == 2) { pmx = fmaxf(pmx, fmaxf(fmaxf(fmaxf(P[8], P[9]), fmaxf(P[10], P[11])), fmaxf(fmaxf(P[12], P[13]), fmaxf(P[14], P[15])))); \
                auto rr_ = __builtin_amdgcn_permlane32_swap(__float_as_uint(pmx), __float_as_uint(pmx), false, false); pmx = fmaxf(__uint_as_float(rr_[0]), __uint_as_float(rr_[1])); \
                mn_ = fmaxf(m_reg, pmx); AL = __builtin_amdgcn_exp2f(m_reg - mn_); m_reg = mn_; } \
            else if ((k_) == 3) { _Pragma("unroll") for (int r = 0; r < 6; ++r) P[r] = __builtin_amdgcn_exp2f(P[r] - mn_); } \
            else if ((k_) == 4) { _Pragma("unroll") for (int r = 6; r < 11; ++r) P[r] = __builtin_amdgcn_exp2f(P[r] - mn_); } \
            else if ((k_) == 5) { _Pragma("unroll") for (int r = 11; r < 16; ++r) P[r] = __builtin_amdgcn_exp2f(P[r] - mn_); } \
            else if ((k_) == 6) { ps_ = ((P[0] + P[1]) + (P[2] + P[3])) + ((P[4] + P[5]) + (P[6] + P[7])) + (((P[8] + P[9]) + (P[10] + P[11])) + ((P[12] + P[13]) + (P[14] + P[15]))); \
                auto rr_ = __builtin_amdgcn_permlane32_swap(__float_as_uint(ps_), __float_as_uint(ps_), false, false); ps_ = __uint_as_float(rr_[0]) + __uint_as_float(rr_[1]); l_reg = l_reg * AL + ps_; } \
            else if ((k_) == 7) { \
                { unsigned a0_ = pkbf(P[0], P[1]), a1_ = pkbf(P[2], P[3]), b0_ = pkbf(P[4], P[5]), b1_ = pkbf(P[6], P[7]); auto r0_ = __builtin_amdgcn_permlane32_swap(a0_, b0_, false, false); auto r1_ = __builtin_amdgcn_permlane32_swap(a1_, b1_, false, false); \
                  v4u w_ = {r0_[0], r1_[0], r0_[1], r1_[1]}; PA = __builtin_bit_cast(bf16x8, w_); } \
                { unsigned a0_ = pkbf(P[8], P[9]), a1_ = pkbf(P[10], P[11]), b0_ = pkbf(P[12], P[13]), b1_ = pkbf(P[14], P[15]); auto r0_ = __builtin_amdgcn_permlane32_swap(a0_, b0_, false, false); auto r1_ = __builtin_amdgcn_permlane32_swap(a1_, b1_, false, false); \
                  v4u w_ = {r0_[0], r1_[0], r0_[1], r1_[1]}; PB = __builtin_bit_cast(bf16x8, w_); } } } while (0)
#define RESC_O(AL) do { if (__any((AL) < 1.f)) { if (hi == 0) wsc[r32] = (AL); LDS_WAIT(); \
                _Pragma("unroll") for (int g = 0; g < 4; ++g) { const f32x4 al_ = *(const LAS f32x4*)(wsc + 8 * g + 4 * hi); \
                    _Pragma("unroll") for (int d = 0; d < 4; ++d) _Pragma("unroll") for (int e = 0; e < 4; ++e) o[d][4 * g + e] *= al_[e]; } } } while (0)
            kf[0] = KFR(0, 0); kf[1] = KFR(1, 0); kf[2] = KFR(2, 0); kf[3] = KFR(3, 0); SB0();
#pragma unroll
            for (int j = 0; j < ND; ++j) { QK_MF(p0, 0, j); SB0(); }
            kf[0] = KFR(0, 1); kf[1] = KFR(1, 1); kf[2] = KFR(2, 1); kf[3] = KFR(3, 1); SB0();
#pragma unroll
            for (int j = 0; j < ND; ++j) { QK_MF(p1, 1, j);
#pragma unroll
                for (int k = 0; k < 8; ++k) if ((k * ND) / 8 == j) SMSTEP(k, p0, 0, al0, pa0, pa1);
                SB0(); }
            RESC_O(al0);
            const LAS unsigned char* vb_ = L + OFF_V + bf * BUF + v_rd_base(lane);
            s16x4 vl[2][4];
#define VRD_(set_, d0_, h_) do { vl[set_][0] = vtr(vb_ + v_rd_off(d0_, 2 * (h_), 0)); vl[set_][1] = vtr(vb_ + v_rd_off(d0_, 2 * (h_), 1)); \
                                 vl[set_][2] = vtr(vb_ + v_rd_off(d0_, 2 * (h_) + 1, 0)); vl[set_][3] = vtr(vb_ + v_rd_off(d0_, 2 * (h_) + 1, 1)); } while (0)
            VRD_(0, 0, 0); SB0();
#pragma unroll
            for (int d0 = 0; d0 < 4; ++d0) { if (d0 + 1 < 4) VRD_((d0 + 1) & 1, d0 + 1, 0); SB0();
                o[d0] = __builtin_amdgcn_mfma_f32_32x32x16_bf16(pa0, mk8(vl[d0 & 1][0], vl[d0 & 1][1]), o[d0], 0, 0, 0); SMSTEP(2 * d0, p1, 32, al1, pa2, pa3); SB0();
                o[d0] = __builtin_amdgcn_mfma_f32_32x32x16_bf16(pa1, mk8(vl[d0 & 1][2], vl[d0 & 1][3]), o[d0], 0, 0, 0); SMSTEP(2 * d0 + 1, p1, 32, al1, pa2, pa3); SB0(); }
            RESC_O(al1);
            VRD_(0, 0, 1); SB0();
#pragma unroll
            for (int d0 = 0; d0 < 4; ++d0) { if (d0 + 1 < 4) VRD_((d0 + 1) & 1, d0 + 1, 1); SB0();
                o[d0] = __builtin_amdgcn_mfma_f32_32x32x16_bf16(pa2, mk8(vl[d0 & 1][0], vl[d0 & 1][1]), o[d0], 0, 0, 0);
                o[d0] = __builtin_amdgcn_mfma_f32_32x32x16_bf16(pa3, mk8(vl[d0 & 1][2], vl[d0 & 1][3]), o[d0], 0, 0, 0); SB0(); }
#undef KFR
#undef QK_MF
#undef SMSTEP
#undef RESC_O
#undef VRD_
#undef SB0
        } else if (act) {
            LAS unsigned char* Bf = L + bf * BUF;
            f32x16 p0 = (f32x16){}, p1 = (f32x16){};
            if (NEGM) { p0 = negm; p1 = negm; }
#define KFR(d0_, half_) (*(const LAS bf16x8*)(Bf + OFF_K + (CPR == 16 ? (kbase[(d0_) & 3] ^ (((d0_) >> 2) * 128)) : (kbase[(d0_) & 3] + ((d0_) >> 2) * 128)) + (half_) * 32 * KROWB))
            bf16x8 kA[4], kB[4];
            kA[0] = KFR(0, 0); kA[1] = KFR(0, 1); kA[2] = KFR(1, 0); kA[3] = KFR(1, 1);
            __builtin_amdgcn_s_setprio(1);
#pragma unroll
            for (int d0 = 0; d0 < ND; d0 += 4) {
                kB[0] = KFR(d0 + 2, 0); kB[1] = KFR(d0 + 2, 1); kB[2] = KFR(d0 + 3, 0); kB[3] = KFR(d0 + 3, 1);
                __builtin_amdgcn_sched_barrier(0);
                p0 = __builtin_amdgcn_mfma_f32_32x32x16_bf16(kA[0], qr[d0], p0, 0, 0, 0); p1 = __builtin_amdgcn_mfma_f32_32x32x16_bf16(kA[1], qr[d0], p1, 0, 0, 0);
                p0 = __builtin_amdgcn_mfma_f32_32x32x16_bf16(kA[2], qr[d0 + 1], p0, 0, 0, 0); p1 = __builtin_amdgcn_mfma_f32_32x32x16_bf16(kA[3], qr[d0 + 1], p1, 0, 0, 0);
                __builtin_amdgcn_sched_barrier(0);
                if (d0 + 4 < ND) { kA[0] = KFR(d0 + 4, 0); kA[1] = KFR(d0 + 4, 1); kA[2] = KFR(d0 + 5, 0); kA[3] = KFR(d0 + 5, 1); }
                __builtin_amdgcn_sched_barrier(0);
                p0 = __builtin_amdgcn_mfma_f32_32x32x16_bf16(kB[0], qr[d0 + 2], p0, 0, 0, 0); p1 = __builtin_amdgcn_mfma_f32_32x32x16_bf16(kB[1], qr[d0 + 2], p1, 0, 0, 0);
                p0 = __builtin_amdgcn_mfma_f32_32x32x16_bf16(kB[2], qr[d0 + 3], p0, 0, 0, 0); p1 = __builtin_amdgcn_mfma_f32_32x32x16_bf16(kB[3], qr[d0 + 3], p1, 0, 0, 0);
                __builtin_amdgcn_sched_barrier(0);
            }
            __builtin_amdgcn_s_setprio(0);
#undef KFR
            if (TYPE != 1) {
                if (TYPE == 0) {
#pragma unroll
                    for (int g = 0; g < 4; ++g) { const f32x4 b0 = *(const LAS f32x4*)(Bf + OFF_B + (8 * g + 4 * hi) * 4), b1 = *(const LAS f32x4*)(Bf + OFF_B + (32 + 8 * g + 4 * hi) * 4);
#pragma unroll
                        for (int e = 0; e < 4; ++e) { p0[4 * g + e] += b0[e]; p1[4 * g + e] += b1[e]; } }
                }
                if (needmask) { const float NEG = -__builtin_inff();
#pragma unroll
                    for (int r = 0; r < 16; ++r) { const int kv = kb + crow(r, hi);
                        if (TYPE == 0) { if (kv > qpos) p0[r] = NEG; if (kv + 32 > qpos) p1[r] = NEG; }
                        else { if (kv >= U.nkeys) p0[r] = NEG; if (kv + 32 >= U.nkeys) p1[r] = NEG; } } }
                float pmax = p0[0];
#pragma unroll
                for (int r = 1; r < 16; ++r) pmax = fmaxf(pmax, p0[r]);
#pragma unroll
                for (int r = 0; r < 16; ++r) pmax = fmaxf(pmax, p1[r]);
                { auto rr = __builtin_amdgcn_permlane32_swap(__float_as_uint(pmax), __float_as_uint(pmax), false, false); pmax = fmaxf(__uint_as_float(rr[0]), __uint_as_float(rr[1])); }
                float alpha = 1.f, ps = 0.f;
                if (NEGM) {
                    const bool upd = pmax > -__builtin_inff() && (fresh || pmax > 8.0f);
                    if (__any(upd)) { const float dl = upd ? pmax : 0.f; alpha = (upd && !fresh) ? __builtin_amdgcn_exp2f(-dl) : 1.f; m_reg += dl; fresh = fresh && !upd;
#pragma unroll
                        for (int r = 0; r < 16; ++r) { p0[r] -= dl; p1[r] -= dl; negm[r] = -m_reg; } }
#pragma unroll
                    for (int r = 0; r < 16; ++r) { p0[r] = __builtin_amdgcn_exp2f(p0[r]); p1[r] = __builtin_amdgcn_exp2f(p1[r]); ps += p0[r] + p1[r]; }
                } else {
                const float mn = pmax > m_reg + 8.0f ? pmax : m_reg; alpha = __builtin_amdgcn_exp2f(m_reg - mn); m_reg = mn;
#pragma unroll
                for (int r = 0; r < 16; ++r) { p0[r] = __builtin_amdgcn_exp2f(p0[r] - mn); p1[r] = __builtin_amdgcn_exp2f(p1[r] - mn); ps += p0[r] + p1[r]; }
                }
                { auto rr = __builtin_amdgcn_permlane32_swap(__float_as_uint(ps), __float_as_uint(ps), false, false); ps = __uint_as_float(rr[0]) + __uint_as_float(rr[1]); }
                l_reg = l_reg * alpha + ps;
                if (__any(alpha < 1.f)) { if (hi == 0) wsc[r32] = alpha; LDS_WAIT();
#pragma unroll
                    for (int g = 0; g < 4; ++g) { const f32x4 al = *(const LAS f32x4*)(wsc + 8 * g + 4 * hi);
#pragma unroll
                        for (int d = 0; d < 4; ++d)
#pragma unroll
                            for (int e = 0; e < 4; ++e) o[d][4 * g + e] *= al[e]; } }
            } else {
                f32x16 k0, k1;
#pragma unroll
                for (int r = 0; r < 16; ++r) { const int kv = kb + crow(r, hi); const bool v0 = !needmask || kv < qpos, v1 = !needmask || kv + 32 < qpos;
                    const float z0 = p0[r], z1 = p1[r];
                    const float s0 = fmaxf(z0, 0.f) + LN2 * __builtin_amdgcn_logf(1.0f + __builtin_amdgcn_exp2f(-LOG2E * fabsf(z0)));
                    const float s1 = fmaxf(z1, 0.f) + LN2 * __builtin_amdgcn_logf(1.0f + __builtin_amdgcn_exp2f(-LOG2E * fabsf(z1)));
                    k0[r] = v0 ? -s0 : 0.f; k1[r] = v1 ? -s1 : 0.f; }
                float G[8], T[8], X[8];
#pragma unroll
                for (int g = 0; g < 4; ++g) { G[g] = (k0[4 * g] + k0[4 * g + 1]) + (k0[4 * g + 2] + k0[4 * g + 3]); G[4 + g] = (k1[4 * g] + k1[4 * g + 1]) + (k1[4 * g + 2] + k1[4 * g + 3]); }
#pragma unroll
                for (int g = 0; g < 8; ++g) { auto rr = __builtin_amdgcn_permlane32_swap(__float_as_uint(G[g]), __float_as_uint(G[g]), false, false);
                    const float a_lo = __uint_as_float(rr[0]), a_hi = __uint_as_float(rr[1]);
                    T[g] = a_lo + a_hi; X[g] = hi == 0 ? a_hi : 0.f; }
                float later = Rsum;
#pragma unroll
                for (int g = 7; g >= 0; --g) { const float base = later + X[g];
                    if (g >= 4) { float s = base;
#pragma unroll
                        for (int e = 3; e >= 0; --e) { s += k1[4 * (g - 4) + e]; k1[4 * (g - 4) + e] = s; } }
                    else { float s = base;
#pragma unroll
                        for (int e = 3; e >= 0; --e) { s += k0[4 * g + e]; k0[4 * g + e] = s; } }
                    later += T[g]; }
                Rsum = later;
#pragma unroll
                for (int r = 0; r < 16; ++r) { const int kv = kb + crow(r, hi); const bool v0 = !needmask || kv < qpos, v1 = !needmask || kv + 32 < qpos;
                    const float a0 = __builtin_amdgcn_exp2f(LOG2E * (p0[r] + k0[r])), a1 = __builtin_amdgcn_exp2f(LOG2E * (p1[r] + k1[r]));
                    p0[r] = v0 ? a0 : 0.f; p1[r] = v1 ? a1 : 0.f; }
            }
            pack_p(p0, p1, pa0, pa1, pa2, pa3);
            if (ATT_LAG && lagw) { have_prev = true; bfp = bf; } else pv_tile(o, vrd + (unsigned)(bf * BUF), pa0, pa1, pa2, pa3);
        }
        if (TYPE != 2) { if (!wdone && kb > 0) wdone = TYPE == 1 ? __all(zb + Rsum < EXIT_SB) : __all(!(NEGM && fresh) && zb + bnext - m_reg < EXIT_FOX); if (lane == 0) flg[(i & 1) * 8 + wid] = wdone ? 1 : 0; }
        if (DIST == 2 && i + 2 < NT) { if (NKC == 2) asm volatile("s_waitcnt vmcnt(4)" ::: "memory"); else asm volatile("s_waitcnt vmcnt(5)" ::: "memory"); } else VM_WAIT();
        __syncthreads();
        bf = bf == 2 ? 0 : bf + 1; bf2 = bf2 == 2 ? 0 : bf2 + 1;
    }
    if (ATT_LAG && have_prev) pv_tile(o, vrd + (unsigned)(bfp * BUF), pa0, pa1, pa2, pa3);
    VM_WAIT(); __syncthreads();
#undef ST_DMA
    if (wact) {
        float rli[16];
        if (TYPE != 1) { if (hi == 0) wsc[r32] = l_reg; LDS_WAIT();
#pragma unroll
            for (int g = 0; g < 4; ++g) { const f32x4 lv = *(const LAS f32x4*)(wsc + 8 * g + 4 * hi);
#pragma unroll
                for (int e = 0; e < 4; ++e) rli[4 * g + e] = 1.0f / lv[e]; } }
        else {
#pragma unroll
            for (int r = 0; r < 16; ++r) rli[r] = 1.f; }
        const bool partial = TYPE == 2 && U.part >= 0;
        bf16* Ow = partial ? (bf16*)(ws + WS_PO) + ((size_t)U.part * SEQ + U.qrow0 + wid * 32) * 512 + U.h * HD
                           : (bf16*)(ws + WS_ATT) + (size_t)(U.qrow0 + wid * 32) * MIXW + TYPE * 512 + U.h * HD;
        const int opitch = partial ? 512 : MIXW;
        if (partial && hi == 0) *(f32x2*)((float*)(ws + WS_PML) + (((size_t)U.part * SEQ + U.qrow0 + wid * 32 + r32) * 4 + U.h) * 2) = (f32x2){m_reg, l_reg};
#pragma unroll
        for (int r = 0; r < 16; ++r) { const int orow = crow(r, hi);
#pragma unroll
            for (int d0 = 0; d0 < 4; ++d0) { const float v = o[d0][r] * rli[r]; const float vn = __shfl_xor(v, 1);
                if ((r32 & 1) == 0) *(unsigned*)(Ow + (size_t)orow * opitch + d0 * 32 + r32) = pkbf(v, vn); } }
    }
}
constexpr int NU_MLA_FULL = MLA_G == 32 ? 4 * 32 : 4 * 96, NU_MLA = NU_MLA_FULL + 4 * 64, NU_PROMPT = NU_MLA + 2 * 4 * (SEQ / 256), NU_SAMPLE = 3 * DB * 4, NU = NU_PROMPT + NU_SAMPLE;
}

__device__ __forceinline__ float rstd_sample(const float* rsss, int srow, int kq) {
    const float* p = rsss + (size_t)srow * 128 + kq * 32; float s = 0.f;
#pragma unroll
    for (int i = 0; i < 8; ++i) { const f32x4 v = *(const f32x4*)(p + 4 * i); s += (v[0] + v[1]) + (v[2] + v[3]); }
    s += __shfl_xor(s, 16); s += __shfl_xor(s, 32);
    return 1.0f / sqrtf(s * (1.f / DM) + EPS);
}
struct ThinArgs { const bf16* A; const bf16* Bt; int K, lda, ldb; int ncs; bf16* Ob; int ldo; const float* rsss_in; const float* xin; float* xout; bf16* xn; const float* gain; float* rsss_out; };
template <int MODE  , int NBF, int KC>
__device__ __forceinline__ void thin_gemm(const ThinArgs T, LAS unsigned char* L, int wave, int bx, const int f0o = -1, const int rho = 0) {
    constexpr int KSN = KC / 32, PITCH = KC * 2 + 16, BUFB = NBF * 16 * PITCH, PPR = KC / 8, NPT = NBF * KC / 256;
    static_assert(2 * BUFB <= RING_BYTES, "thin LDS");
    const int lane = fresh_lane(), tid = wave * 64 + lane, m16 = lane & 15, kq = lane >> 4, K = T.K, nch = K / KC;
    for (int q = f0o >= 0 ? 0 : bx; q < (f0o >= 0 ? 1 : T.ncs * 2); q += gridDim.x) {
        const int cs = q % T.ncs, rh = f0o >= 0 ? rho : q / T.ncs, row0 = rh * 128 + wave * 16, f0 = f0o >= 0 ? f0o : cs * (NBF / 2) * 16;
        const bf16* ap = T.A + (size_t)(row0 + m16) * T.lda + kq * 8;
        const bf16* bsrc[NPT]; int bdst[NPT];
#pragma unroll
        for (int i = 0; i < NPT; ++i) { const int p = tid + 512 * i, row = p / PPR, kc = p % PPR, b = row >> 4, m = row & 15; size_t brow;
            if (MODE == 1) { const int f = f0 + (b % (NBF / 2)) * 16 + m; brow = (size_t)(f >> 7) * 256 + (f & 127) + (b >= NBF / 2 ? 128 : 0); }
            else brow = (size_t)cs * NBF * 16 + row;
            bsrc[i] = T.Bt + brow * T.ldb + kc * 8; bdst[i] = row * PITCH + kc * 16; }
        f32x4 acc[NBF];
#pragma unroll
        for (int b = 0; b < NBF; ++b) acc[b] = (f32x4){0.f, 0.f, 0.f, 0.f};
        bf16x8 fa[3][KSN]; v4u stb[3][NPT];
#define T2_LOAD(S_, k0) do { _Pragma("unroll") for (int i = 0; i < NPT; ++i) stb[S_][i] = *(const v4u*)(bsrc[i] + (k0)); \
            _Pragma("unroll") for (int j = 0; j < KSN; ++j) fa[S_][j] = *(const bf16x8*)(ap + (k0) + 32 * j); } while (0)
#define T2_WRITE(S_, cc_) do { _Pragma("unroll") for (int i = 0; i < NPT; ++i) *(LAS v4u*)(L + ((cc_) & 1) * BUFB + bdst[i]) = stb[S_][i]; } while (0)
#define T2_MMA(S_, cc_) do { _Pragma("unroll") for (int j = 0; j < KSN; ++j) _Pragma("unroll") for (int b = 0; b < NBF; ++b) \
            acc[b] = __builtin_amdgcn_mfma_f32_16x16x32_bf16(*(const LAS bf16x8*)(L + ((cc_) & 1) * BUFB + (b * 16 + m16) * PITCH + j * 64 + kq * 16), fa[S_][j], acc[b], 0, 0, 0); } while (0)
#define T2_BAR() asm volatile("s_waitcnt lgkmcnt(0)\n\ts_barrier" ::: "memory")
#define T2_STEP(cc, SC, SN, SL) do { if ((cc) + 2 < nch) { T2_LOAD(SL, ((cc) + 2) * KC); } __builtin_amdgcn_sched_barrier(0); \
            T2_MMA(SC, cc); __builtin_amdgcn_sched_barrier(0); \
            if ((cc) + 1 < nch) { T2_WRITE(SN, (cc) + 1); } T2_BAR(); } while (0)
        T2_LOAD(0, 0); if (nch > 1) { T2_LOAD(1, KC); } __builtin_amdgcn_sched_barrier(0);
        T2_WRITE(0, 0); T2_BAR();
#pragma unroll 1
        for (int c = 0; c < nch; c += 3) {
            T2_STEP(c, 0, 1, 2);
            if (c + 1 < nch) T2_STEP(c + 1, 1, 2, 0);
            if (c + 2 < nch) T2_STEP(c + 2, 2, 0, 1);
        }
#undef T2_LOAD
#undef T2_WRITE
#undef T2_MMA
#undef T2_BAR
#undef T2_STEP
        const int srow = row0 + m16; const size_t grow = (size_t)SEQ + srow;
        if (MODE == 0) { const float rs = rstd_sample(T.rsss_in, srow, kq);
#pragma unroll
            for (int b = 0; b < NBF; ++b) { const int col = (cs * NBF + b) * 16 + 4 * kq; const f32x4 v = acc[b] * rs;
                f32x2 o; o.x = __uint_as_float(pkbf(v[0], v[1])); o.y = __uint_as_float(pkbf(v[2], v[3])); *(f32x2*)(T.Ob + grow * T.ldo + col) = o; } }
        else if (MODE == 1) { const float rs = rstd_sample(T.rsss_in, srow, kq);
#pragma unroll
            for (int b = 0; b < NBF / 2; ++b) { const int col = f0 + b * 16 + 4 * kq; const f32x4 g = acc[b] * rs, u = acc[b + NBF / 2] * rs;
                f32x2 o; o.x = __uint_as_float(pkbf(pg8::silu_mul(g[0], u[0]), pg8::silu_mul(g[1], u[1]))); o.y = __uint_as_float(pkbf(pg8::silu_mul(g[2], u[2]), pg8::silu_mul(g[3], u[3])));
                *(f32x2*)(T.Ob + grow * T.ldo + col) = o; } }
        else {
#pragma unroll
            for (int b = 0; b < NBF; ++b) { const int cg = cs * NBF + b, col = cg * 16 + 4 * kq;
                const f32x4 x1 = *(const f32x4*)(T.xin + (size_t)srow * DM + col) + acc[b]; *(f32x4*)(T.xout + (size_t)srow * DM + col) = x1;
                const f32x4 y = x1;
                f32x2 o; o.x = __uint_as_float(pkbf(y[0], y[1])); o.y = __uint_as_float(pkbf(y[2], y[3])); *(f32x2*)(T.xn + grow * LDX + col) = o;
                float ss = (x1[0] * x1[0] + x1[1] * x1[1]) + (x1[2] * x1[2] + x1[3] * x1[3]); ss += __shfl_xor(ss, 16); ss += __shfl_xor(ss, 32);
                if (kq == 0) T.rsss_out[(size_t)srow * 128 + cg] = ss; } }
    }
}

template <int KC>
__device__ __forceinline__ void thin_gemm_ks(const ThinArgs T, LAS unsigned char* L, int wave, int bx) {
    constexpr int NBF = 2, VB = 2 * NBF, KSN = KC / 32, PITCH = KC * 2 + 16, BUFB = VB * 16 * PITCH, PPR = KC / 8, NPT = VB * KC / 256, NCS = DM / (NBF * 16);
    static_assert(2 * BUFB + 4 * NBF * 64 * 16 <= RING_BYTES, "thin LDS");
    const int lane = fresh_lane(), tid = wave * 64 + lane, m16 = lane & 15, kq = lane >> 4, KH = T.K / 2, nch = KH / KC, wh = wave >> 2, w4 = wave & 3;
    LAS f32x4* red = (LAS f32x4*)(L + 2 * BUFB);
    for (int q = bx; q < NCS * 4; q += gridDim.x) {
        const int cs = q % NCS, rg = q / NCS, row0 = rg * 64 + w4 * 16;
        const bf16* ap = T.A + (size_t)(row0 + m16) * T.lda + wh * KH + kq * 8;
        const bf16* bsrc[NPT]; int bdst[NPT];
#pragma unroll
        for (int i = 0; i < NPT; ++i) { const int p = tid + 512 * i, row = p / PPR, kc = p % PPR, vb = row >> 4, m = row & 15;
            bsrc[i] = T.Bt + (size_t)(cs * NBF * 16 + (vb % NBF) * 16 + m) * T.ldb + (vb / NBF) * KH + kc * 8; bdst[i] = row * PITCH + kc * 16; }
        f32x4 acc[NBF];
#pragma unroll
        for (int b = 0; b < NBF; ++b) acc[b] = (f32x4){0.f, 0.f, 0.f, 0.f};
        bf16x8 fa[3][KSN]; v4u stb[3][NPT];
#define T3_LOAD(S_, k0) do { _Pragma("unroll") for (int i = 0; i < NPT; ++i) stb[S_][i] = *(const v4u*)(bsrc[i] + (k0)); \
            _Pragma("unroll") for (int j = 0; j < KSN; ++j) fa[S_][j] = *(const bf16x8*)(ap + (k0) + 32 * j); } while (0)
#define T3_WRITE(S_, cc_) do { _Pragma("unroll") for (int i = 0; i < NPT; ++i) *(LAS v4u*)(L + ((cc_) & 1) * BUFB + bdst[i]) = stb[S_][i]; } while (0)
#define T3_MMA(S_, cc_) do { _Pragma("unroll") for (int j = 0; j < KSN; ++j) _Pragma("unroll") for (int b = 0; b < NBF; ++b) \
            acc[b] = __builtin_amdgcn_mfma_f32_16x16x32_bf16(*(const LAS bf16x8*)(L + ((cc_) & 1) * BUFB + ((wh * NBF + b) * 16 + m16) * PITCH + j * 64 + kq * 16), fa[S_][j], acc[b], 0, 0, 0); } while (0)
#define T3_BAR() asm volatile("s_waitcnt lgkmcnt(0)\n\ts_barrier" ::: "memory")
#define T3_STEP(cc, SC, SN, SL) do { if ((cc) + 2 < nch) { T3_LOAD(SL, ((cc) + 2) * KC); } __builtin_amdgcn_sched_barrier(0); \
            T3_MMA(SC, cc); __builtin_amdgcn_sched_barrier(0); \
            if ((cc) + 1 < nch) { T3_WRITE(SN, (cc) + 1); } T3_BAR(); } while (0)
        T3_LOAD(0, 0); if (nch > 1) { T3_LOAD(1, KC); } __builtin_amdgcn_sched_barrier(0);
        T3_WRITE(0, 0); T3_BAR();
#pragma unroll 1
        for (int c = 0; c < nch; c += 3) {
            T3_STEP(c, 0, 1, 2);
            if (c + 1 < nch) T3_STEP(c + 1, 1, 2, 0);
            if (c + 2 < nch) T3_STEP(c + 2, 2, 0, 1);
        }
#undef T3_LOAD
#undef T3_WRITE
#undef T3_MMA
#undef T3_STEP
        if (wh == 1) {
#pragma unroll
            for (int b = 0; b < NBF; ++b) red[(w4 * NBF + b) * 64 + lane] = acc[b]; }
        T3_BAR();
#undef T3_BAR
        if (wh == 0) {
            const int srow = row0 + m16; const size_t grow = (size_t)SEQ + srow;
#pragma unroll
            for (int b = 0; b < NBF; ++b) { const int cg = cs * NBF + b, col = cg * 16 + 4 * kq;
                const f32x4 x1 = *(const f32x4*)(T.xin + (size_t)srow * DM + col) + (acc[b] + red[(w4 * NBF + b) * 64 + lane]); *(f32x4*)(T.xout + (size_t)srow * DM + col) = x1;
                f32x2 o; o.x = __uint_as_float(pkbf(x1[0], x1[1])); o.y = __uint_as_float(pkbf(x1[2], x1[3])); *(f32x2*)(T.xn + grow * LDX + col) = o;
                float ss = (x1[0] * x1[0] + x1[1] * x1[1]) + (x1[2] * x1[2] + x1[3] * x1[3]); ss += __shfl_xor(ss, 16); ss += __shfl_xor(ss, 32);
                if (kq == 0) T.rsss_out[(size_t)srow * 128 + cg] = ss; } }
    }
}

static_assert(USE_THIN == 1, "the residual epilogue carries only the prompt rows' stream (bf16)");
constexpr int MG = USE_THIN ? SEQ : M;
constexpr int NPH = 1 + 9 * DEPTH;
__global__ void __launch_bounds__(NWAVES * 64, 2) trunk_fwd(KArgs a) {
    extern __shared__ __attribute__((aligned(16))) unsigned char lds_raw[];
    LAS unsigned char* lds = (LAS unsigned char*)lds_raw;
    volatile LAS unsigned* MISC = (volatile LAS unsigned*)(lds + MISC_OFF);
    const int wave = __builtin_amdgcn_readfirstlane(threadIdx.x >> 6);
    const int G = gridDim.x, gw = blockIdx.x * NWAVES + wave, NGW = G * NWAVES;
    unsigned char* ws = a.ws;
    gu32* ctl = (gu32*)(ws + WS_CTL);
    for (int u = wave * 64 + fresh_lane(); u < (LDS_BYTES - LDSCTL_OFF) / 4; u += NWAVES * 64) ((LAS unsigned*)(lds + LDSCTL_OFF))[u] = 0u;
    __syncthreads();
    XcdBarrier bar; bar.bar = (unsigned*)(ctl + CW_BAR); bar.x = 0; bar.st = nullptr;
    if (MK_ONE_LAUNCH) bar = xcd_barrier_post((unsigned*)(ctl + CW_BAR), MISC + 8, wave == 0 && fresh_lane() == 0);
    const int lo = a.ph_lo, hi = a.ph_hi;
#define IN(k) (lo <= (k) && (k) < hi)
#define SEAM(k) do { if (IN(k) && IN((k) + 1)) xcd_barrier(bar, wave == 0 && fresh_lane() == 0); } while (0)

    if (IN(0)) { p0_prologue(a, lds, gw, NGW, fresh_lane(), wave); SEAM(0); }

    for (int l = 0; l < DEPTH; ++l) {
        const int pb = 1 + 9 * l;
        int bx = (int)blockIdx.x, wv = wave; asm volatile("" : "+s"(bx), "+s"(wv));
        unsigned char* wl = ws + WS_W + (size_t)l * W_LAYER;
        if (IN(pb + 0)) {
            pg8::Gemm g{(const bf16*)(ws + WS_XN), (const bf16*)(wl + WO_IN), MG, NPROJ, DM, LDX, LDX}; pg8::StaticOrder S; S.init(MG, NPROJ, G, bx, WGM_A);
            pg8::EpiProj E{(bf16*)(ws + WS_PROJ), NPROJ, (const float*)(ws + WS_RSS), 1.f / DM, a.out + O_FVP + (size_t)l * SEQ * 512, a.out + O_SKP + (size_t)l * SEQ * 512, a.out + O_SVP + (size_t)l * SEQ * 512,
                           (bf16*)(ws + WS_VA), (bf16*)(ws + WS_QB), (bf16*)(ws + WS_KB), (bf16*)(ws + WS_VB), (unsigned*)(ctl + CW_KMAX + 64 * l + 8), QS_B,
                           FUSE_B, a.out + O_FKP + (size_t)l * SEQ * 512, a.out + O_CKP + (size_t)l * SEQ * 256, a.out + O_KRP + (size_t)l * SEQ * 64, a.out + O_FLP + (size_t)l * SEQ * 4,
                           (bf16*)(ws + WS_QA), (bf16*)(ws + WS_KA), (bf16*)(ws + WS_CQ), (bf16*)(ws + WS_CKVN), (float*)(ws + WS_KROPE), (float*)(ws + WS_LOGF), (float*)(ws + WS_KRSS), (float*)(ws + WS_CQSS),
                           a.in[I_FQN] + l * 128, a.in[I_FKN] + l * 128, a.in[I_QAN] + l * 512, a.in[I_KVAN] + l * 256, a.in[I_FBIAS] + l * 4, (LAS float*)(lds + RING_BYTES + 1024), (unsigned*)(ctl + CW_KMAX + 64 * l + 24), QS_A, LDCQ, LDCKV, (LAS float*)(lds + RSTAB_OFF), (unsigned)(pb + 0) << 8};
            pg8::gemm_phase<pg8::EpiProj, pg8::StaticOrder, true, true>(lds + RING_OFF, g, S, E, wv);
            __syncthreads();
            { const ThinArgs T{(const bf16*)(ws + WS_XN) + (size_t)SEQ * LDX, (const bf16*)(wl + WO_IN), DM, LDX, LDX, NPROJ / 32, (bf16*)(ws + WS_PROJ), NPROJ, (const float*)(ws + WS_RSSS), nullptr, nullptr, nullptr, nullptr, nullptr};
              if (USE_THIN) thin_gemm<0, 2, 256>(T, lds + RING_OFF, wv, bx); }
            SEAM(pb + 0);
        }
        if (IN(pb + 1)) {
            const int ln = fresh_lane();
            float kmA = 0.f, kmB = 0.f;
            for (int rep_ = 0; rep_ < 1 + PROBE_DUP_ROW; ++rep_)
            { pb_tokens(a, l, gw, NGW, ln, kmA, kmB); for (int r = gw; r < DB * PAST; r += NGW) pb_cache_row(a, l, r, ln, kmA, kmB); }
            { LAS float* km = (LAS float*)(lds + RING_OFF);
              if ((ln & 15) == 0) { km[wv * 8 + (ln >> 4)] = kmA; km[wv * 8 + 4 + (ln >> 4)] = kmB; }
              __syncthreads();
              if (wv == 0 && ln < 8) { float m = km[ln];
#pragma unroll
                  for (int w = 1; w < NWAVES; ++w) m = fmaxf(m, km[w * 8 + ln]);
                  __hip_atomic_fetch_max(ctl + CW_KMAX + 64 * l + ln, __float_as_uint(m), RLX_AGENT); }
              __syncthreads(); }
            SEAM(pb + 1);
        }
        if (IN(pb + 2)) {
          for (int rep_ = 0; rep_ < 1 + PROBE_DUP_C; ++rep_) {
            { const int ln_ = fresh_lane(); for (int j = G >= 72 ? bx - (G - 36) : bx; j < 36; j += G) if (j >= 0) scan_job(ws, (LAS float*)(lds + RING_OFF), j, wv * 64 + ln_, wv, ln_); }
            { pg8::Gemm g{(const bf16*)(ws + WS_CQ), (const bf16*)(wl + WO_UQ), M, NQC, 512, LDCQ, LDCQ}; pg8::StaticOrder S; S.init(M, NQC, G, bx, WGM_C);
              pg8::EpiPlain E{(bf16*)(ws + WS_QCR), NQC};
              pg8::gemm_phase<pg8::EpiPlain, pg8::StaticOrder, true, true>(lds + RING_OFF, g, S, E, wv); }
            __syncthreads();
            { pg8::Gemm g{(const bf16*)(ws + WS_CKVN), (const bf16*)(wl + WO_UKV), NKR, NKV, 256, LDCKV, LDCKV}; pg8::StaticOrder S; S.init(NKR, NKV, G, bx, WGM_C);
              if (FOLD_KC) { pg8::EpiKV E{(bf16*)(ws + WS_KC), (bf16*)(ws + WS_KVR), (const float*)(ws + WS_KRSS), (const float*)(ws + WS_KROPE), (const float*)(ws + WS_ROPE), a.in[I_KN] + l * QKD, (LAS float*)(lds + RING_BYTES + 1024), SEQ, SKEYS};
                  pg8::gemm_phase<pg8::EpiKV, pg8::StaticOrder, true, true>(lds + RING_OFF, g, S, E, wv); }
              else { pg8::EpiPlain E{(bf16*)(ws + WS_KVR), NKV};
                  pg8::gemm_phase<pg8::EpiPlain, pg8::StaticOrder, true, true>(lds + RING_OFF, g, S, E, wv); } }
            if (PROBE_DUP_C) __syncthreads();
          }
            SEAM(pb + 2);
        }
        if (IN(pb + 3) && !(FOLD_QC && FOLD_KC)) {
            const int ln = fresh_lane();
            for (int rep_ = 0; rep_ < 1 + PROBE_DUP_ROW; ++rep_)
            for (int r = gw + (FOLD_QC ? M : 0); r < M + NKR; r += NGW) { if (r < M) pd_row<0>(a, l, r, ln); else pd_row<1>(a, l, r - M, ln); }
            SEAM(pb + 3);
        }
        if (IN(pb + 4)) {
          for (int rep_ = 0; rep_ < 1 + PROBE_DUP_E; ++rep_) {
            gu32* head = ctl + CW_AQ + 64 * l + 16 * rep_;
            const int nconv = (CONV_IN_E && l + 1 < DEPTH) ? NCONV : 0; static_assert(2 * NCONV <= att::NU && NCONV * CONV_PER_UNIT >= CI_LAYER && CONV_PER_UNIT % NWAVES == 0, "conversion units fit between the attention units");
            for (;;) {
                if (wv == 0 && fresh_lane() == 0) MISC[12] = __hip_atomic_fetch_add(head, 1u, RLX_AGENT);
                __syncthreads();
                const int t_ = (int)MISC[12];
                __syncthreads();
                if (t_ >= att::NU + nconv) break;
                int u = t_ - nconv;
                if (t_ < 3 * nconv) {
                    if (t_ % 3 == 2) { const int c_ = t_ / 3, ln_ = fresh_lane();
#pragma unroll 1
                        for (int j_ = 0; j_ < CONV_PER_UNIT / NWAVES; ++j_) { const int it_ = (c_ * (CONV_PER_UNIT / NWAVES) + j_) * NWAVES + wv; if (it_ < CI_LAYER) p0_conv_item(a, l + 1, it_, ln_); }
                        continue; }
                    u = t_ - t_ / 3; }
                att::UnitDesc U; int type;
                U.part = -1; U.t_lo = 0;
                if (u < att::NU_MLA) { type = 2; U.h = u & 3; int qb, p;
#if MLA_G == 32
                    if (u < att::NU_MLA_FULL) { qb = 63 - (u >> 2); p = 0; U.t_lo = 0; U.t_hi = 128; U.part = 0; }
                    else { const int k = (u - att::NU_MLA_FULL) >> 2; qb = (k & 1) * 32 + 31 - (k >> 1); p = qb >> 5; U.t_lo = 128 * p; U.t_hi = 4 * (qb + 1); U.part = p > 0 ? p : -1; }
#else
                    if (u < att::NU_MLA_FULL) { const int idx = u >> 2; if (idx < 48) { qb = 63 - idx / 3; p = idx % 3; } else if (idx < 80) { qb = 47 - (idx - 48) / 2; p = (idx - 48) & 1; } else { qb = 31 - (idx - 80); p = 0; }
                        U.t_lo = 64 * p; U.t_hi = 64 * p + 64; U.part = p; }
                    else { const int k = (u - att::NU_MLA_FULL) >> 2; qb = (k & 3) * 16 + 15 - (k >> 2); p = qb >> 4; U.t_lo = 64 * p; U.t_hi = 4 * (qb + 1); U.part = p > 0 ? p : -1; }
#endif
                    U.qrow0 = qb * 256; U.nq = 256; U.krow0 = 0; U.qpos0 = qb * 256; U.nkeys = SEQ; }
                else if (u < att::NU_PROMPT) { const int v = u - att::NU_MLA; type = v >> 8;
                    U.h = v & 3; const int qb = 63 - ((v & 255) >> 2); U.qrow0 = qb * 256; U.nq = 256; U.krow0 = 0; U.qpos0 = qb * 256; U.nkeys = SEQ; U.t_hi = 4 * (qb + 1); }
                else { const int v = u - att::NU_PROMPT; const int k = v >> 5, b = (v & 31) >> 2; type = k == 0 ? 2 : k == 1 ? 0 : 1;
                    U.h = v & 3; U.qrow0 = SEQ + b * DS; U.nq = DS; U.krow0 = SEQ + b * SKEYS; U.qpos0 = PAST; U.nkeys = SKEYS; U.t_hi = (PAST + DS - 1) / 64 + 1; }
                if (type == 2) att::attn_unit<2>(lds + RING_OFF, ws, U, 0.f, wv, a.in[I_QN] + l * QKD);
                else if (type == 0) { const gu32* ks_ = ctl + CW_KMAX + 64 * l + 24 + U.h * 4;
                    const float ka2 = (__uint_as_float(__hip_atomic_load(ks_, RLX_AGENT)) + __uint_as_float(__hip_atomic_load(ks_ + 1, RLX_AGENT))) + (__uint_as_float(__hip_atomic_load(ks_ + 2, RLX_AGENT)) + __uint_as_float(__hip_atomic_load(ks_ + 3, RLX_AGENT)));
                    att::attn_unit<0>(lds + RING_OFF, ws, U, sqrtf(fmaxf(ka2, __uint_as_float(__hip_atomic_load(ctl + CW_KMAX + 64 * l + U.h, RLX_AGENT)))), wv); }
                else { const gu32* ks_ = ctl + CW_KMAX + 64 * l + 8 + U.h * 4;
                    const float kb2 = (__uint_as_float(__hip_atomic_load(ks_, RLX_AGENT)) + __uint_as_float(__hip_atomic_load(ks_ + 1, RLX_AGENT))) + (__uint_as_float(__hip_atomic_load(ks_ + 2, RLX_AGENT)) + __uint_as_float(__hip_atomic_load(ks_ + 3, RLX_AGENT)));
                    att::attn_unit<1>(lds + RING_OFF, ws, U, sqrtf(fmaxf(kb2, __uint_as_float(__hip_atomic_load(ctl + CW_KMAX + 64 * l + 4 + U.h, RLX_AGENT)))), wv); }
            }
            if (PROBE_DUP_E) xcd_barrier(bar, wv == 0 && fresh_lane() == 0);
          }
            SEAM(pb + 4);
        }
        if (IN(pb + 5)) {
            const int ln = fresh_lane();
            for (int rep_ = 0; rep_ < 1 + PROBE_DUP_ROW; ++rep_)
            pf_rows(a, l, gw, NGW, ln);
            SEAM(pb + 5);
        }
        if (IN(pb + 6)) {
            pg8::Gemm g{(const bf16*)(ws + WS_MIX), (const bf16*)(wl + WO_OUT), MG, DM, MIXW, LDMIX, LDMIX}; pg8::StaticOrder S; S.init(MG, DM, G, bx, WGM_G);
            pg8::EpiResid E{l == 0 ? a.in[I_XP] : nullptr, nullptr, (bf16*)(ws + WS_XN), LDX, (float*)(ws + WS_RSS), DM};
            pg8::gemm_phase<pg8::EpiResid, pg8::StaticOrder, true, true>(lds + RING_OFF, g, S, E, wv);
            __syncthreads();
            { const ThinArgs T{(const bf16*)(ws + WS_MIX) + (size_t)SEQ * LDMIX, (const bf16*)(wl + WO_OUT), MIXW, LDMIX, LDMIX, DM / 16, nullptr, 0, nullptr, l == 0 ? a.in[I_XS] : a.out + O_Y + (size_t)SEQ * DM, a.out + O_Y + (size_t)SEQ * DM,
                               (bf16*)(ws + WS_XN), a.in[I_NFFN] + l * DM, (float*)(ws + WS_RSSS)};
              if (USE_THIN) thin_gemm_ks<256>(T, lds + RING_OFF, wv, bx); }
            SEAM(pb + 6);
        }
        if (IN(pb + 7)) {
            pg8::Gemm g{(const bf16*)(ws + WS_XN), (const bf16*)(wl + WO_GU), MG, 2 * DFF, DM, LDX, LDX}; pg8::StaticOrder S; S.init(MG, 2 * DFF, G, bx, WGM_H);
            pg8::EpiSwiGlu E{(bf16*)(ws + WS_H), LDH, (const float*)(ws + WS_RSS), 1.f / DM, (LAS float*)(lds + RSTAB_OFF), (unsigned)(pb + 7) << 8};
            for (int rep_ = 0; rep_ < 1 + PROBE_DUP_H; ++rep_) { pg8::gemm_phase<pg8::EpiSwiGlu, pg8::StaticOrder, true, true>(lds + RING_OFF, g, S, E, wv); if (PROBE_DUP_H) xcd_barrier(bar, wv == 0 && fresh_lane() == 0); }
            __syncthreads();
            { const ThinArgs T{(const bf16*)(ws + WS_XN) + (size_t)SEQ * LDX, (const bf16*)(wl + WO_GU), DM, LDX, LDX, DFF / 32, (bf16*)(ws + WS_H), LDH, (const float*)(ws + WS_RSSS), nullptr, nullptr, nullptr, nullptr, nullptr};
              if (USE_THIN) { const bool mixed = G == 256; const int rh_ = bx >> 7, j_ = bx & 127;
                  if (mixed && j_ < 96) thin_gemm<1, 6, 256>(T, lds + RING_OFF, wv, bx, j_ * 48, rh_);
                  else thin_gemm<1, 4, 256>(T, lds + RING_OFF, wv, bx, mixed ? 4608 + (j_ - 96) * 32 : -1, rh_); } }
            SEAM(pb + 7);
        }
        if (IN(pb + 8)) {
            pg8::Gemm g{(const bf16*)(ws + WS_H), (const bf16*)(wl + WO_DOWN), MG, DM, DFF, LDH, LDH}; pg8::StaticOrder S; S.init(MG, DM, G, bx, WGM_I);
            pg8::EpiResid E{nullptr, l + 1 == DEPTH ? a.out + O_Y : nullptr, (bf16*)(ws + WS_XN), LDX, (float*)(ws + WS_RSS), DM};
            pg8::gemm_phase<pg8::EpiResid, pg8::StaticOrder, true, true>(lds + RING_OFF, g, S, E, wv);
            __syncthreads();
            { const ThinArgs T{(const bf16*)(ws + WS_H) + (size_t)SEQ * LDH, (const bf16*)(wl + WO_DOWN), DFF, LDH, LDH, DM / 16, nullptr, 0, nullptr, a.out + O_Y + (size_t)SEQ * DM, a.out + O_Y + (size_t)SEQ * DM,
                               (bf16*)(ws + WS_XN), a.in[I_NMIX] + (l + 1 < DEPTH ? l + 1 : l) * DM, (float*)(ws + WS_RSSS)};
              if (USE_THIN) thin_gemm_ks<256>(T, lds + RING_OFF, wv, bx); }
            SEAM(pb + 8);
        }
    }
#undef IN
#undef SEAM
}

extern "C" void kernel_launch(void* const* d_in, const int* in_sizes, int n_in, void* d_out, int out_size, void* d_ws, size_t ws_size, hipStream_t stream) {
    static int grid = 0;
    if (grid == 0) {
        if (n_in != N_INPUTS || (size_t)out_size != O_END || ws_size < WS_END) { fprintf(stderr, "kernel_launch: unexpected shapes (n_in %d, out %d, ws %zu; need ws >= %zu)\n", n_in, out_size, ws_size, (size_t)WS_END); grid = -1; return; }
        int dev = 0, cus = 0, per_cu = 0;
        if (hipGetDevice(&dev) != hipSuccess || hipDeviceGetAttribute(&cus, hipDeviceAttributeMultiprocessorCount, dev) != hipSuccess) { grid = -1; return; }
        if (hipFuncSetAttribute((const void*)trunk_fwd, hipFuncAttributeMaxDynamicSharedMemorySize, LDS_BYTES) != hipSuccess) { fprintf(stderr, "kernel_launch: hipFuncSetAttribute failed\n"); grid = -1; return; }
        if (hipOccupancyMaxActiveBlocksPerMultiprocessor(&per_cu, (const void*)trunk_fwd, NWAVES * 64, LDS_BYTES) != hipSuccess || per_cu < 1) { fprintf(stderr, "kernel_launch: occupancy query says %d blocks per CU\n", per_cu); }
        (void)hipGetLastError();
        grid = cus;
    }
    if (grid < 0) return;
    (void)in_sizes;
    if (hipMemsetAsync((char*)d_ws + WS_CTL, 0, CTL_ZERO_BYTES, stream) != hipSuccess) { fprintf(stderr, "kernel_launch: memset failed\n"); return; }
    KArgs a{};
    for (int i = 0; i < N_INPUTS; ++i) a.in[i] = (const float*)d_in[i];
    a.out = (float*)d_out; a.ws = (unsigned char*)d_ws;
#if MK_ONE_LAUNCH
    a.ph_lo = 0; a.ph_hi = NPH;
    hipLaunchKernelGGL(trunk_fwd, dim3(grid), dim3(NWAVES * 64), LDS_BYTES, stream, a);
#else
    for (int p = 0; p < NPH; ++p) { a.ph_lo = p; a.ph_hi = p + 1; hipLaunchKernelGGL(trunk_fwd, dim3(grid), dim3(NWAVES * 64), LDS_BYTES, stream, a); }
#endif
    const hipError_t le = hipPeekAtLastError();
    if (le != hipSuccess) fprintf(stderr, "kernel_launch: launch failed: %s\n", hipGetErrorName(le));
}
```
